# Optimizing an MI355X kernel written in HIP

```python
import jax, jax.numpy as jnp
from jax import lax
import numpy as np

D_MODEL = 1024
BATCH = 16
SEQ = 4096
DEPTH = 4

CHUNK = 64
N_MIXERS = 2
POOL_WINDOWS = (2, 4, 8, 16)
N_POOL_GROUPS = len(POOL_WINDOWS)
POOL_GROUP_DIM = D_MODEL // N_POOL_GROUPS
SGU_BLOCK = 128
SGU_GROUPS = 4
SGU_DIM = D_MODEL
SGU_GROUP_DIM = SGU_DIM // SGU_GROUPS
N_MEM = 256
MEM_HEADS = 4
MEM_HEAD_DIM = D_MODEL // MEM_HEADS
D_FF = 4 * D_MODEL
EPS = 1e-6
N_A_LAYERS = (DEPTH + 1) // 2
N_B_LAYERS = DEPTH // 2

kernel_name = "hybrid_pool_sgu_memory_trunk"


def rmsnorm(x, g):
    xf = x.astype(jnp.float32)
    y = xf * lax.rsqrt(jnp.mean(xf * xf, axis=-1, keepdims=True) + EPS)
    return (y * g.astype(jnp.float32)).astype(x.dtype)


def layernorm(x, g, b):
    xf = x.astype(jnp.float32)
    mu = jnp.mean(xf, axis=-1, keepdims=True)
    var = jnp.mean(jnp.square(xf - mu), axis=-1, keepdims=True)
    y = (xf - mu) * lax.rsqrt(var + EPS)
    return (y * g.astype(jnp.float32) + b.astype(jnp.float32)).astype(x.dtype)


def pool_mixer(h, w_grp, scale):
    B, S, D = h.shape
    hf = h.astype(jnp.float32)
    cs = jnp.pad(jnp.cumsum(hf, axis=1), ((0, 0), (1, 0), (0, 0)))
    csg = cs.reshape(B, S + 1, N_POOL_GROUPS, POOL_GROUP_DIM)
    hg = hf.reshape(B, S, N_POOL_GROUPS, POOL_GROUP_DIM)
    t = jnp.arange(S)
    outs = []
    for g, w in enumerate(POOL_WINDOWS):
        c = csg[:, :, g]
        lo = jnp.maximum(t + 1 - w, 0)
        count = jnp.minimum(t + 1, w).astype(jnp.float32)
        mean = (c[:, t + 1] - c[:, lo]) / count[None, :, None]
        outs.append(mean - hg[:, :, g])
    pooled = jnp.stack(outs, axis=2)
    mixed = jnp.einsum('bsgc,gcd->bsgd', pooled, w_grp.astype(jnp.float32)).reshape(B, S, D)
    return (mixed * scale.astype(jnp.float32)).astype(h.dtype)


def sgu_mask():
    p = jnp.arange(SGU_BLOCK)
    return (p[:, None] // CHUNK) >= (p[None, :] // CHUNK)


def sgu_mixer(h, w_in, ln_g, ln_b, w_s, b_s, w_out):
    B, S, D = h.shape
    z = jax.nn.gelu(h @ w_in)
    u, v = jnp.split(z, 2, axis=-1)
    v = layernorm(v, ln_g, ln_b)
    nblk = S // SGU_BLOCK
    v = v.reshape(B, nblk, SGU_BLOCK, SGU_GROUPS, SGU_GROUP_DIM)
    ws = jnp.where(sgu_mask()[None], w_s, jnp.zeros_like(w_s))
    s = jnp.einsum('gpq,bnqgc->bnpgc', ws, v) + b_s.T[None, None, :, :, None]
    s = s.reshape(B, S, SGU_DIM)
    return (u * s) @ w_out


def mem_attention(h, m, w_q, w_kv, w_o):
    B, S, D = h.shape
    q = (h @ w_q).reshape(B, S, MEM_HEADS, MEM_HEAD_DIM)
    k, v = jnp.split(m @ w_kv, 2, axis=-1)
    k = k.reshape(B, N_MEM, MEM_HEADS, MEM_HEAD_DIM)
    v = v.reshape(B, N_MEM, MEM_HEADS, MEM_HEAD_DIM)
    scores = jnp.einsum('bshd,bnhd->bhsn', q, k).astype(jnp.float32) * (MEM_HEAD_DIM ** -0.5)
    p = jax.nn.softmax(scores, axis=-1).astype(v.dtype)
    o = jnp.einsum('bhsn,bnhd->bshd', p, v).reshape(B, S, D)
    return o @ w_o


def squared_relu_mlp(h, w1, w2):
    return jnp.square(jax.nn.relu(h @ w1)) @ w2


def setup_inputs(seed: int = 0) -> dict:
    key = jax.random.key(seed)
    ks = jax.random.split(key, 24)
    f32 = jnp.float32

    def nrm(k, shape, scale):
        return jax.random.normal(k, shape, f32) * scale

    def gain(k, shape):
        return 1.0 + 0.05 * jax.random.normal(k, shape, f32)

    out_scale = 0.5
    return {
        "x": jax.random.normal(ks[0], (BATCH, SEQ, D_MODEL), f32),
        "mem": jax.random.normal(ks[1], (BATCH, N_MEM, D_MODEL), f32),
        "norm_mix_g": gain(ks[2], (DEPTH, D_MODEL)),
        "norm_mem_g": gain(ks[3], (DEPTH, D_MODEL)),
        "norm_memkv_g": gain(ks[4], (DEPTH, D_MODEL)),
        "norm_ffn_g": gain(ks[5], (DEPTH, D_MODEL)),
        "final_norm_g": gain(ks[6], (D_MODEL,)),
        "pool_w": nrm(ks[7], (N_A_LAYERS, N_POOL_GROUPS, POOL_GROUP_DIM, POOL_GROUP_DIM), POOL_GROUP_DIM ** -0.5),
        "pool_scale": 0.5 + 0.05 * jax.random.normal(ks[8], (N_A_LAYERS, D_MODEL), f32),
        "sgu_w_in": nrm(ks[9], (N_B_LAYERS, D_MODEL, 2 * SGU_DIM), D_MODEL ** -0.5),
        "sgu_ln_g": gain(ks[10], (N_B_LAYERS, SGU_DIM)),
        "sgu_ln_b": nrm(ks[11], (N_B_LAYERS, SGU_DIM), 0.02),
        "sgu_w_s": nrm(ks[12], (N_B_LAYERS, SGU_GROUPS, SGU_BLOCK, SGU_BLOCK), 0.5 * SGU_BLOCK ** -0.5),
        "sgu_b_s": gain(ks[13], (N_B_LAYERS, SGU_GROUPS, SGU_BLOCK)),
        "sgu_w_out": nrm(ks[14], (N_B_LAYERS, SGU_DIM, D_MODEL), out_scale * SGU_DIM ** -0.5),
        "mem_w_q": nrm(ks[15], (DEPTH, D_MODEL, D_MODEL), D_MODEL ** -0.5),
        "mem_w_kv": nrm(ks[16], (DEPTH, D_MODEL, 2 * D_MODEL), D_MODEL ** -0.5),
        "mem_w_o": nrm(ks[17], (DEPTH, D_MODEL, D_MODEL), out_scale * D_MODEL ** -0.5),
        "ffn_w1": nrm(ks[18], (DEPTH, D_MODEL, D_FF), D_MODEL ** -0.5),
        "ffn_w2": nrm(ks[19], (DEPTH, D_FF, D_MODEL), out_scale * D_FF ** -0.5),
    }


def reference(x, mem, norm_mix_g, norm_mem_g, norm_memkv_g, norm_ffn_g, final_norm_g,
              pool_w, pool_scale, sgu_w_in, sgu_ln_g, sgu_ln_b, sgu_w_s, sgu_b_s, sgu_w_out,
              mem_w_q, mem_w_kv, mem_w_o, ffn_w1, ffn_w2):
    for i in range(DEPTH):
        h = rmsnorm(x, norm_mix_g[i])
        j = i // N_MIXERS
        if i % N_MIXERS == 0:
            x = x + pool_mixer(h, pool_w[j], pool_scale[j])
        else:
            x = x + sgu_mixer(h, sgu_w_in[j], sgu_ln_g[j], sgu_ln_b[j],
                              sgu_w_s[j], sgu_b_s[j], sgu_w_out[j])
        h = rmsnorm(x, norm_mem_g[i])
        m = rmsnorm(mem, norm_memkv_g[i])
        x = x + mem_attention(h, m, mem_w_q[i], mem_w_kv[i], mem_w_o[i])
        h = rmsnorm(x, norm_ffn_g[i])
        x = x + squared_relu_mlp(h, ffn_w1[i], ffn_w2[i])
    return rmsnorm(x, final_norm_g)
```

```cpp
#include <hip/hip_runtime.h>
#include <hip/hip_cooperative_groups.h>
#include <cstdio>
#include <cstdint>
namespace cg = cooperative_groups;

#ifndef MK_SINGLE
#define MK_SINGLE 1
#endif

#define LAS __attribute__((address_space(3)))
typedef unsigned short bf16_t;
typedef short bf16x8 __attribute__((ext_vector_type(8)));
typedef float f32x4 __attribute__((ext_vector_type(4)));
typedef float f32x2 __attribute__((ext_vector_type(2)));
typedef float f32x16 __attribute__((ext_vector_type(16)));
typedef unsigned u32x4 __attribute__((ext_vector_type(4)));
typedef unsigned u32x2 __attribute__((ext_vector_type(2)));

constexpr int D = 1024, BATCH = 16, SEQ = 4096, DEPTH = 4, FF = 4096, NMEM = 256;
constexpr int M = BATCH * SEQ;
constexpr int MR = BATCH * NMEM;
constexpr float EPS = 1e-6f;
constexpr float QSCALE = 0.0625f * 1.4426950408889634f;

constexpr size_t MiB = 1u << 20;
constexpr size_t WS_H = 0, WS_T1 = 0, WS_O = 128 * MiB, WS_Z = 256 * MiB;
constexpr size_t WS_XB = 512 * MiB;
constexpr size_t WS_KALL = 640 * MiB, WS_VTALL = 672 * MiB, WS_MEMB = 704 * MiB;
constexpr size_t WS_SSQ0 = 712 * MiB, WS_SSQ1 = 716 * MiB, WS_VSTAT = 720 * MiB, WS_RSTDMEM = 728 * MiB;
constexpr size_t WS_WQ = 736 * MiB, WS_WO = 744 * MiB, WS_W1 = 752 * MiB, WS_W2 = 784 * MiB, WS_WK = 816 * MiB, WS_WV = 824 * MiB;
constexpr size_t WS_WIN = 832 * MiB, WS_WOUT = 840 * MiB, WS_PW = 844 * MiB, WS_END = 845 * MiB;

constexpr int LDS_BYTES = 147456;

struct Params {
    const float* in[20];
    float* out;
    unsigned char* ws;
    int ph_lo, ph_hi;
};

__device__ __forceinline__ unsigned cvt_pk_bf16(float lo, float hi) { unsigned r; asm volatile("v_cvt_pk_bf16_f32 %0, %1, %2" : "=v"(r) : "v"(lo), "v"(hi)); return r; }
__device__ __forceinline__ float wave_sum(float v) {
#pragma unroll
    for (int o = 1; o < 64; o <<= 1) v += __shfl_xor(v, o);
    return v;
}
__device__ __forceinline__ float gelu_tanh(float x) {
    const float y = 0.7978845608028654f * (x + 0.044715f * x * x * x);
    const float e = __builtin_amdgcn_exp2f(-2.0f * 1.4426950408889634f * y);
    return x * __builtin_amdgcn_rcpf(1.0f + e);
}

namespace pg8 {
constexpr int BM = 256, BK = 64, HALF = 128, HTB = HALF * BK * 2, STAGE_BYTES = 8 * HTB, NXCD = 8, WGM = 8;
__host__ __device__ __forceinline__ int lds_byte(int r, int c) { const int st = (r >> 4) * 2 + (c >> 5), rr = r & 15, cc = c & 31, ob = rr * 64 + cc * 2; return st * 1024 + (ob ^ (((ob >> 9) & 1) << 5)); }
__host__ __device__ __forceinline__ void stage_rc(int b, int& R, int& C) { const int st = b / 1024, sb = b % 1024, swz = sb ^ (((sb >> 9) & 1) << 5); R = (st >> 1) * 16 + swz / 64; C = (st & 1) * 32 + (swz % 64) / 2; }
__host__ __device__ __forceinline__ int perm32(int rho) { const int n = rho >> 4, i = rho & 15; return 8 * (i >> 2) + 4 * n + (i & 3); }

struct Unit { int pm, pn; };
struct Gemm { const bf16_t* A; const bf16_t* Bt; int M, N, K, lda, ldb, acol; };

struct StaticOrder {
    int nM, nN, nwg, G, c;
    __device__ void init(int M_, int N_, int G_, int c_) { nM = M_ / BM; nN = N_ / BM; nwg = nM * nN; G = G_; c = c_; }
    __device__ bool next(int i, Unit& u) const {
        const long L = (long)i * G + c; if (L >= nwg) return false;
        int wgid = (int)L; { const int q = nwg / NXCD, r = nwg % NXCD, xcd = wgid % NXCD, off = wgid / NXCD; wgid = (xcd < r ? xcd * (q + 1) : r * (q + 1) + (xcd - r) * q) + off; }
        const int nig = WGM * nN, gid = wgid / nig, fm = gid * WGM, gsz = (nM - fm) < WGM ? (nM - fm) : WGM;
        u.pm = fm + ((wgid % nig) % gsz); u.pn = (wgid % nig) / gsz; return true;
    }
};

__device__ __forceinline__ float rstd_from_slots(const float* ssq, int row, int fq) {
    const f32x4 v = *(const f32x4*)(ssq + (size_t)row * 16 + fq * 4);
    float s = (v[0] + v[1]) + (v[2] + v[3]);
    s += __shfl_xor(s, 16); s += __shfl_xor(s, 32);
    return __builtin_amdgcn_rsqf(s * (1.0f / 1024.0f) + EPS);
}

template <int MODE> struct EpiAct {
    bf16_t* O; int ldc; const float* ssq; float scale; const float* rvec; float* vstat;
    __device__ __forceinline__ void operator()(const f32x4 (&acc)[2][2][4][2], const Unit& u, int wr, int wc, int fr, int fq) const {
        const int row0 = u.pm * BM + wr * 64 + fr, col0 = u.pn * BM + wc * 32 + 8 * fq;
        f32x4 cs[2][2];
        if (MODE == 3) {
#pragma unroll
            for (int bj = 0; bj < 2; ++bj) { cs[bj][0] = *(const f32x4*)(rvec + col0 + bj * HALF); cs[bj][1] = *(const f32x4*)(rvec + col0 + bj * HALF + 4); }
        }
#pragma unroll
        for (int ai = 0; ai < 2; ++ai)
#pragma unroll
            for (int m = 0; m < 4; ++m) {
                const int row = row0 + ai * HALF + m * 16;
                float rs = 1.f;
                if (MODE == 0 || MODE == 1 || MODE == 2) rs = rstd_from_slots(ssq, row, fq);
                if (MODE == 0) rs *= scale;
                if (MODE == 4) rs = rvec[row];
                bf16_t* rowp = O + (size_t)row * ldc + col0;
                float s1 = 0.f, s2 = 0.f;
#pragma unroll
                for (int bj = 0; bj < 2; ++bj) {
                    f32x4 v0 = acc[ai][bj][m][0] * rs, v1 = acc[ai][bj][m][1] * rs;
                    if (MODE == 3) { v0 = acc[ai][bj][m][0] * cs[bj][0]; v1 = acc[ai][bj][m][1] * cs[bj][1]; }
                    if (MODE == 1) {
#pragma unroll
                        for (int j = 0; j < 4; ++j) { const float a = v0[j] > 0.f ? v0[j] : 0.f, b = v1[j] > 0.f ? v1[j] : 0.f; v0[j] = a * a; v1[j] = b * b; }
                    }
                    if (MODE == 2) {
#pragma unroll
                        for (int j = 0; j < 4; ++j) { v0[j] = gelu_tanh(v0[j]); v1[j] = gelu_tanh(v1[j]); }
#pragma unroll
                        for (int j = 0; j < 4; ++j) { s1 += v0[j] + v1[j]; s2 += v0[j] * v0[j] + v1[j] * v1[j]; }
                    }
                    u32x4 w; w.x = cvt_pk_bf16(v0[0], v0[1]); w.y = cvt_pk_bf16(v0[2], v0[3]); w.z = cvt_pk_bf16(v1[0], v1[1]); w.w = cvt_pk_bf16(v1[2], v1[3]);
                    *(u32x4*)(rowp + bj * HALF) = w;
                }
                if (MODE == 2) {
                    s1 += __shfl_xor(s1, 16); s1 += __shfl_xor(s1, 32); s2 += __shfl_xor(s2, 16); s2 += __shfl_xor(s2, 32);
                    if (u.pn >= 4 && fq == 0) { vstat[(size_t)row * 32 + (u.pn - 4) * 4 + wc] = s1; vstat[(size_t)row * 32 + 16 + (u.pn - 4) * 4 + wc] = s2; }
                }
            }
    }
};
struct EpiResid {
    const float* xin; float* xout; bf16_t* xb; float* ssq;
    __device__ __forceinline__ void operator()(const f32x4 (&acc)[2][2][4][2], const Unit& u, int wr, int wc, int fr, int fq) const {
        const int row0 = u.pm * BM + wr * 64 + fr, col0 = u.pn * BM + wc * 32 + 8 * fq;
#pragma unroll
        for (int ai = 0; ai < 2; ++ai)
#pragma unroll
            for (int m = 0; m < 4; ++m) {
                const int row = row0 + ai * HALF + m * 16; const size_t off = (size_t)row * D + col0;
                float ss = 0.f;
#pragma unroll
                for (int bj = 0; bj < 2; ++bj) {
                    const f32x4 a0 = *(const f32x4*)(xin + off + bj * HALF), a1 = *(const f32x4*)(xin + off + bj * HALF + 4);
                    const f32x4 v0 = a0 + acc[ai][bj][m][0], v1 = a1 + acc[ai][bj][m][1];
                    *(f32x4*)(xout + off + bj * HALF) = v0; *(f32x4*)(xout + off + bj * HALF + 4) = v1;
                    u32x4 w; w.x = cvt_pk_bf16(v0[0], v0[1]); w.y = cvt_pk_bf16(v0[2], v0[3]); w.z = cvt_pk_bf16(v1[0], v1[1]); w.w = cvt_pk_bf16(v1[2], v1[3]);
                    *(u32x4*)(xb + off + bj * HALF) = w;
#pragma unroll
                    for (int j = 0; j < 4; ++j) ss += v0[j] * v0[j] + v1[j] * v1[j];
                }
                ss += __shfl_xor(ss, 16); ss += __shfl_xor(ss, 32);
                if (fq == 0) ssq[(size_t)row * 16 + u.pn * 4 + wc] = ss;
                asm volatile("" ::: "memory");
            }
    }
};

template <class Epi>
__device__ __forceinline__ void gemm_phase(LAS unsigned char* lds, const Gemm g, const StaticOrder& S, const Epi& E) {
    int tid_ = threadIdx.x; asm volatile("" : "+v"(tid_));
    const int tid = tid_, wid = __builtin_amdgcn_readfirstlane(tid >> 6), lane = tid & 63, wr = wid >> 2, wc = wid & 3, fr = lane & 15, fq = lane >> 4;
    const int nt = g.K / BK;
    unsigned voffA[2], voffB[2];
#pragma unroll
    for (int i = 0; i < 2; ++i) { int R, C; stage_rc(tid * 16 + i * 8192, R, C); const int Rb = (R & ~31) + perm32(R & 31);
        voffA[i] = (unsigned)(R * g.lda + C) * 2u; voffB[i] = (unsigned)(Rb * g.ldb + C) * 2u; }
    const size_t kstep = (size_t)(BK * 2);
    const size_t hstepA = (size_t)HALF * g.lda * 2, hstepB = (size_t)HALF * g.ldb * 2;
    const size_t tstepA = 2 * hstepA, tstepB = 2 * hstepB, cstepA = (size_t)g.acol * 2;
    const unsigned ldsw = (unsigned)wid * 1024u;
    const int aoff = lds_byte(wr * 64 + fr, fq * 8), boff = lds_byte(wc * 32 + fr, fq * 8);
#define PG8_SA(b, h) (((b) * 2 + (h)) * HTB)
#define PG8_SB(b, h) ((4 + (b) * 2 + (h)) * HTB)
#define PG8_STAGE(bufoff, gbase, voff) do { _Pragma("unroll") for (int _i = 0; _i < 2; ++_i) \
        __builtin_amdgcn_global_load_lds((const unsigned*)((const char*)(gbase) + (voff)[_i]), (LAS unsigned*)(lds + (bufoff) + ldsw + _i * 8192), 16, 0, 0); } while (0)
#define PG8_LDA(dst, b, h) do { _Pragma("unroll") for (int m = 0; m < 4; ++m) _Pragma("unroll") for (int k = 0; k < 2; ++k) dst[m][k] = *(const LAS bf16x8*)(lds + PG8_SA(b, h) + aoff + m * 2048 + k * 1024); } while (0)
#define PG8_LDB(dst, b, h) do { _Pragma("unroll") for (int n = 0; n < 2; ++n) _Pragma("unroll") for (int k = 0; k < 2; ++k) dst[n][k] = *(const LAS bf16x8*)(lds + PG8_SB(b, h) + boff + n * 2048 + k * 1024); } while (0)
#define PG8_MMA(ai, bj, At, Bt) do { __builtin_amdgcn_s_setprio(1); _Pragma("unroll") for (int m = 0; m < 4; ++m) _Pragma("unroll") for (int n = 0; n < 2; ++n) _Pragma("unroll") for (int k = 0; k < 2; ++k) \
        acc[ai][bj][m][n] = __builtin_amdgcn_mfma_f32_16x16x32_bf16(Bt[n][k], At[m][k], acc[ai][bj][m][n], 0, 0, 0); __builtin_amdgcn_s_setprio(0); } while (0)
#define PG8_WAIT_V(n) asm volatile("s_waitcnt vmcnt(" #n ")" ::: "memory")
#define PG8_WAIT_L(n) asm volatile("s_waitcnt lgkmcnt(" #n ")" ::: "memory")
#define PG8_BAR __builtin_amdgcn_s_barrier()
#define PG8_SCHED __builtin_amdgcn_sched_barrier(0)
    Unit cur, nxt; int ui = 0;
    if (!S.next(0, cur)) return;
    f32x4 acc[2][2][4][2];
#pragma unroll
    for (int a = 0; a < 2; ++a)
#pragma unroll
        for (int b = 0; b < 2; ++b)
#pragma unroll
            for (int m = 0; m < 4; ++m)
#pragma unroll
                for (int n = 0; n < 2; ++n) acc[a][b][m][n] = (f32x4){0.f, 0.f, 0.f, 0.f};
    bf16x8 At[4][2], B0[2][2], B1[2][2];
    const char* cA = (const char*)g.A + (size_t)cur.pm * tstepA + (size_t)cur.pn * cstepA; const char* cB = (const char*)g.Bt + (size_t)cur.pn * tstepB;
    PG8_STAGE(PG8_SB(0, 0), cB, voffB); PG8_STAGE(PG8_SB(0, 1), cB + hstepB, voffB); PG8_STAGE(PG8_SA(0, 0), cA, voffA); PG8_STAGE(PG8_SA(0, 1), cA + hstepA, voffA);
    if (wr == 1) PG8_BAR;
    PG8_WAIT_V(2); PG8_BAR;
    PG8_STAGE(PG8_SB(1, 0), cB + kstep, voffB); PG8_STAGE(PG8_SA(1, 0), cA + kstep, voffA); PG8_STAGE(PG8_SB(1, 1), cB + hstepB + kstep, voffB);
    PG8_WAIT_V(6); PG8_BAR;
    for (;;) {
        const bool has_next = S.next(ui + 1, nxt);
        const char* nA = has_next ? (const char*)g.A + (size_t)nxt.pm * tstepA + (size_t)nxt.pn * cstepA : cA; const char* nB = has_next ? (const char*)g.Bt + (size_t)nxt.pn * tstepB : cB;
        for (int t = 0; t < nt; t += 2) {
            const bool last = (t == nt - 2);
            const char* a1 = cA + (size_t)(t + 1) * kstep;
            const char* a2 = last ? nA : cA + (size_t)(t + 2) * kstep; const char* b2 = last ? nB : cB + (size_t)(t + 2) * kstep;
            const char* a3 = a2 + kstep; const char* b3 = b2 + kstep;
            PG8_LDB(B0, 0, 0); PG8_LDB(B1, 0, 1); PG8_SCHED; PG8_LDA(At, 0, 0); PG8_STAGE(PG8_SA(1, 1), a1 + hstepA, voffA);
            PG8_WAIT_V(8); PG8_WAIT_L(0); PG8_BAR; PG8_MMA(0, 0, At, B0); PG8_MMA(0, 1, At, B1); PG8_BAR; PG8_SCHED;
            PG8_LDA(At, 0, 1); PG8_STAGE(PG8_SB(0, 0), b2, voffB); PG8_STAGE(PG8_SB(0, 1), b2 + hstepB, voffB); PG8_STAGE(PG8_SA(0, 0), a2, voffA);
            PG8_WAIT_V(8); PG8_WAIT_L(0); PG8_BAR; PG8_MMA(1, 0, At, B0); PG8_MMA(1, 1, At, B1); PG8_BAR; PG8_SCHED;
            PG8_LDB(B0, 1, 0); PG8_LDB(B1, 1, 1); PG8_SCHED; PG8_LDA(At, 1, 0); PG8_STAGE(PG8_SA(0, 1), a2 + hstepA, voffA);
            PG8_WAIT_V(8); PG8_WAIT_L(0); PG8_BAR; PG8_MMA(0, 0, At, B0); PG8_MMA(0, 1, At, B1); PG8_BAR; PG8_SCHED;
            PG8_LDA(At, 1, 1); PG8_STAGE(PG8_SB(1, 0), b3, voffB); PG8_STAGE(PG8_SB(1, 1), b3 + hstepB, voffB); PG8_STAGE(PG8_SA(1, 0), a3, voffA);
            PG8_WAIT_V(8); PG8_WAIT_L(0); PG8_BAR; PG8_MMA(1, 0, At, B0); PG8_MMA(1, 1, At, B1); PG8_BAR; PG8_SCHED;
        }
        if (wr == 0) PG8_BAR;
        E(acc, cur, wr, wc, fr, fq);
        if (!has_next) break;
#pragma unroll
        for (int a = 0; a < 2; ++a)
#pragma unroll
            for (int b = 0; b < 2; ++b)
#pragma unroll
                for (int m = 0; m < 4; ++m)
#pragma unroll
                    for (int n = 0; n < 2; ++n) acc[a][b][m][n] = (f32x4){0.f, 0.f, 0.f, 0.f};
        cur = nxt; cA = nA; cB = nB; ++ui;
        if (wr == 1) PG8_BAR;
    }
    PG8_WAIT_V(0);
    PG8_BAR;
#undef PG8_SA
#undef PG8_SB
#undef PG8_STAGE
#undef PG8_LDA
#undef PG8_LDB
#undef PG8_MMA
#undef PG8_WAIT_V
#undef PG8_WAIT_L
#undef PG8_BAR
#undef PG8_SCHED
}
}

struct MatDesc { const float* src; int ldw, K, N; bf16_t* dst; int ldt; const float* ks; const float* ns; };

__device__ __forceinline__ void transpose_item(const MatDesc& d, LAS float* scr, int item, int lane) {
    const int nblk = d.N / 32, kb = item / nblk, nb = item % nblk, k0 = 64 * kb, n0 = 32 * nb;
    const float nsv = d.ns ? d.ns[n0 + (lane & 31)] : 1.f;
#pragma unroll 8
    for (int i = 0; i < 32; ++i) { const int kk = 2 * i + (lane >> 5); float v = d.src[(size_t)(k0 + kk) * d.ldw + n0 + (lane & 31)] * nsv; if (d.ks) v *= d.ks[k0 + kk]; scr[kk * 33 + (lane & 31)] = v; }
    asm volatile("s_waitcnt lgkmcnt(0)" ::: "memory");
    const int c = lane & 7;
#pragma unroll
    for (int j = 0; j < 4; ++j) { const int n = (lane >> 3) + 8 * j; const LAS float* s = scr + (8 * c) * 33 + n;
        u32x4 o; o.x = cvt_pk_bf16(s[0 * 33], s[1 * 33]); o.y = cvt_pk_bf16(s[2 * 33], s[3 * 33]); o.z = cvt_pk_bf16(s[4 * 33], s[5 * 33]); o.w = cvt_pk_bf16(s[6 * 33], s[7 * 33]);
        *(u32x4*)(d.dst + (size_t)(n0 + n) * d.ldt + k0 + 8 * c) = o; }
    asm volatile("s_waitcnt lgkmcnt(0)" ::: "memory");
}

enum { I_X = 0, I_MEM, I_G_MIX, I_G_MEM, I_G_MEMKV, I_G_FFN, I_G_FINAL, I_POOL_W, I_POOL_SCALE, I_SGU_WIN, I_SGU_LNG, I_SGU_LNB, I_SGU_WS, I_SGU_BS, I_SGU_WOUT, I_WQ, I_WKV, I_WO, I_W1, I_W2 };

__device__ __forceinline__ MatDesc get_mat(const Params& P, int id) {
    MatDesc d; d.ks = nullptr; d.ns = nullptr;
    unsigned char* ws = P.ws;
    if (id < 24) {
        const int L = id / 6, t = id % 6;
        if (t == 0)      { d.src = P.in[I_WQ] + (size_t)L * D * D; d.ldw = D; d.K = D; d.N = D; d.dst = (bf16_t*)(ws + WS_WQ) + (size_t)L * D * D; d.ldt = D; d.ks = P.in[I_G_MEM] + L * D; }
        else if (t == 1) { d.src = P.in[I_WKV] + (size_t)L * D * 2 * D; d.ldw = 2 * D; d.K = D; d.N = D; d.dst = (bf16_t*)(ws + WS_WK) + (size_t)L * D * D; d.ldt = D; d.ks = P.in[I_G_MEMKV] + L * D; }
        else if (t == 2) { d.src = P.in[I_WKV] + (size_t)L * D * 2 * D + D; d.ldw = 2 * D; d.K = D; d.N = D; d.dst = (bf16_t*)(ws + WS_WV) + (size_t)L * D * D; d.ldt = D; d.ks = P.in[I_G_MEMKV] + L * D; }
        else if (t == 3) { d.src = P.in[I_WO] + (size_t)L * D * D; d.ldw = D; d.K = D; d.N = D; d.dst = (bf16_t*)(ws + WS_WO) + (size_t)L * D * D; d.ldt = D; }
        else if (t == 4) { d.src = P.in[I_W1] + (size_t)L * D * FF; d.ldw = FF; d.K = D; d.N = FF; d.dst = (bf16_t*)(ws + WS_W1) + (size_t)L * D * FF; d.ldt = D; d.ks = P.in[I_G_FFN] + L * D; }
        else             { d.src = P.in[I_W2] + (size_t)L * D * FF; d.ldw = D; d.K = FF; d.N = D; d.dst = (bf16_t*)(ws + WS_W2) + (size_t)L * D * FF; d.ldt = FF; }
    } else if (id < 28) {
        const int j = (id - 24) >> 1, t = (id - 24) & 1;
        if (t == 0) { d.src = P.in[I_SGU_WIN] + (size_t)j * D * 2 * D; d.ldw = 2 * D; d.K = D; d.N = 2 * D; d.dst = (bf16_t*)(ws + WS_WIN) + (size_t)j * D * 2 * D; d.ldt = D; d.ks = P.in[I_G_MIX] + (2 * j + 1) * D; }
        else        { d.src = P.in[I_SGU_WOUT] + (size_t)j * D * D; d.ldw = D; d.K = D; d.N = D; d.dst = (bf16_t*)(ws + WS_WOUT) + (size_t)j * D * D; d.ldt = D; }
    } else {
        const int jg = id - 28, j = jg >> 2, g = jg & 3;
        d.src = P.in[I_POOL_W] + (size_t)jg * 256 * 256; d.ldw = 256; d.K = 256; d.N = 256; d.dst = (bf16_t*)(ws + WS_PW) + (size_t)jg * 256 * 256; d.ldt = 256;
        d.ks = P.in[I_G_MIX] + (2 * j) * D + g * 256; d.ns = P.in[I_POOL_SCALE] + j * D + g * 256;
    }
    return d;
}
__device__ __forceinline__ int mat_items(int id) {
    if (id < 24) { const int t = id % 6; return (t >= 4) ? 2048 : 512; }
    if (id < 28) return ((id - 24) & 1) ? 512 : 1024;
    return 32;
}

__device__ __forceinline__ void prologue_phase(const Params& P, LAS unsigned char* lds, int G) {
    int tid_ = threadIdx.x; asm volatile("" : "+v"(tid_));
    const int tid = tid_, lane = tid & 63, wave = __builtin_amdgcn_readfirstlane(tid >> 6);
    LAS float* scr = (LAS float*)(lds + wave * 16384);
    const int gw = blockIdx.x * 8 + wave, NGW = G * 8;
    constexpr int NITEMS = 4 * (4 * 512 + 2 * 2048) + 2 * (1024 + 512) + 8 * 32;
    for (int it = gw; it < NITEMS; it += NGW) {
        int r = it, id = 0;
        for (; id < 36; ++id) { const int n = mat_items(id); if (r < n) break; r -= n; }
        const MatDesc d = get_mat(P, id);
        transpose_item(d, scr, r, lane);
    }
    const float* mem = P.in[I_MEM]; bf16_t* memb = (bf16_t*)(P.ws + WS_MEMB); float* rstd_mem = (float*)(P.ws + WS_RSTDMEM);
    for (int r = gw; r < MR; r += NGW) {
        const f32x4* xr = (const f32x4*)(mem + (size_t)r * D) + lane; f32x4 v[4]; float s = 0.f;
#pragma unroll
        for (int j = 0; j < 4; ++j) { v[j] = xr[64 * j]; s += (v[j][0] * v[j][0] + v[j][1] * v[j][1]) + (v[j][2] * v[j][2] + v[j][3] * v[j][3]); }
        s = wave_sum(s);
        if (lane == 0) rstd_mem[r] = 1.0f / sqrtf(s * (1.0f / D) + EPS);
        u32x2* o = (u32x2*)(memb + (size_t)r * D) + lane;
#pragma unroll
        for (int j = 0; j < 4; ++j) { u32x2 w; w.x = cvt_pk_bf16(v[j][0], v[j][1]); w.y = cvt_pk_bf16(v[j][2], v[j][3]); o[64 * j] = w; }
    }
    const float* x = P.in[I_X]; float* ssq0 = (float*)(P.ws + WS_SSQ0);
    for (int r = gw; r < M; r += NGW) {
        const f32x4* xr = (const f32x4*)(x + (size_t)r * D) + lane; float s = 0.f;
#pragma unroll
        for (int j = 0; j < 4; ++j) { const f32x4 v = xr[64 * j]; s += (v[0] * v[0] + v[1] * v[1]) + (v[2] * v[2] + v[3] * v[3]); }
        s = wave_sum(s);
        if (lane < 16) ssq0[(size_t)r * 16 + lane] = (lane == 0) ? s : 0.f;
    }
}

template <int W>
__device__ __forceinline__ void pool_block(const f32x2 (&prev)[16], const f32x2 (&cur)[16], bool seq_start, bf16_t* outp  ) {
#pragma unroll
    for (int i = 0; i < 16; ++i) {
        f32x2 s = cur[i];
#pragma unroll
        for (int j = 1; j < W; ++j) { s += (i - j >= 0) ? cur[(i - j) & 15] : prev[(16 + i - j) & 15]; }
        float inv = 1.0f / (float)W;
        if (i < W - 1 && seq_start) inv = 1.0f / (float)(i + 1);
        const f32x2 o = s * inv - cur[i];
        *(unsigned*)(outp + (size_t)i * D) = cvt_pk_bf16(o[0], o[1]);
    }
}
__device__ __forceinline__ void pool_a_phase(LAS unsigned char* lds, const float* x, const float* ssq, bf16_t* PA, int G) {
    LAS float* rs = (LAS float*)lds;
    int tid_ = threadIdx.x; asm volatile("" : "+v"(tid_));
    const int tid = tid_, ch = 2 * tid, group = __builtin_amdgcn_readfirstlane(tid >> 7);
    for (int chunk = blockIdx.x; chunk < M / 64; chunk += G) {
        const int t0 = chunk * 64; const bool sstart = (t0 & (SEQ - 1)) == 0;
        __syncthreads();
        if (tid < 80) {
            float r = 0.f;
            if (!(sstart && tid < 16)) { const f32x4* p = (const f32x4*)(ssq + (size_t)(t0 - 16 + tid) * 16); const f32x4 a = p[0], b = p[1], c = p[2], d = p[3];
                const float s = (((a[0] + a[1]) + (a[2] + a[3])) + ((b[0] + b[1]) + (b[2] + b[3]))) + (((c[0] + c[1]) + (c[2] + c[3])) + ((d[0] + d[1]) + (d[2] + d[3])));
                r = 1.0f / sqrtf(s * (1.0f / D) + EPS); }
            rs[tid] = r;
        }
        __syncthreads();
        f32x2 prev[16], cur[16];
        if (sstart) {
#pragma unroll
            for (int i = 0; i < 16; ++i) prev[i] = (f32x2){0.f, 0.f};
        } else {
#pragma unroll
            for (int i = 0; i < 16; ++i) prev[i] = *(const f32x2*)(x + (size_t)(t0 - 16 + i) * D + ch) * rs[i];
        }
        for (int blk = 0; blk < 4; ++blk) {
#pragma unroll
            for (int i = 0; i < 16; ++i) cur[i] = *(const f32x2*)(x + (size_t)(t0 + blk * 16 + i) * D + ch) * rs[16 + blk * 16 + i];
            bf16_t* outp = PA + (size_t)(t0 + blk * 16) * D + ch;
            const bool ss = sstart && blk == 0;
            if (group == 0) pool_block<2>(prev, cur, ss, outp);
            else if (group == 1) pool_block<4>(prev, cur, ss, outp);
            else if (group == 2) pool_block<8>(prev, cur, ss, outp);
            else pool_block<16>(prev, cur, ss, outp);
#pragma unroll
            for (int i = 0; i < 16; ++i) prev[i] = cur[i];
        }
    }
}

__device__ __forceinline__ void sgu_spatial_phase(LAS unsigned char* lds, const bf16_t* Z, const float* vstat, const float* wsf, const float* bsf, const float* lng, const float* lnb, bf16_t* T1, int G) {
    constexpr int APITCH = 272;
    LAS unsigned char* Aimg = lds;
    LAS unsigned char* VT = lds + 34816;
    LAS float* mu = (LAS float*)(lds + 34816 + 65536); LAS float* rsd = mu + 128;
    int tid_ = threadIdx.x; asm volatile("" : "+v"(tid_));
    const int tid = tid_, lane = tid & 63, wave = __builtin_amdgcn_readfirstlane(tid >> 6);
    const int g = blockIdx.x & 3;
    bool first = true;
    for (int u = blockIdx.x; u < (M / 128) * 4; u += G) {
        const int nb = u >> 2; const size_t rowb = (size_t)nb * 128;
        __syncthreads();
        if (tid < 128) {
            const f32x4* p = (const f32x4*)(vstat + (rowb + tid) * 32); float s1 = 0.f, s2 = 0.f;
#pragma unroll
            for (int i = 0; i < 4; ++i) { const f32x4 a = p[i], b = p[4 + i]; s1 += (a[0] + a[1]) + (a[2] + a[3]); s2 += (b[0] + b[1]) + (b[2] + b[3]); }
            const float m = s1 * (1.0f / D), var = s2 * (1.0f / D) - m * m;
            mu[tid] = m; rsd[tid] = 1.0f / sqrtf(fmaxf(var, 0.f) + EPS);
        }
        if (first) {
            first = false;
            const float* wg = wsf + (size_t)g * 128 * 128;
#pragma unroll
            for (int i = 0; i < 8; ++i) { const int e = (tid + 512 * i) * 4, p = e >> 7, q = e & 127; f32x4 v = *(const f32x4*)(wg + e);
                if ((p >> 6) < (q >> 6)) v = (f32x4){0.f, 0.f, 0.f, 0.f};
                u32x2 w; w.x = cvt_pk_bf16(v[0], v[1]); w.y = cvt_pk_bf16(v[2], v[3]); *(LAS u32x2*)(Aimg + p * APITCH + q * 2) = w; }
        }
        __syncthreads();
        {
            const int cp = tid & 31, c0 = 8 * cp; float gg[8], bb[8];
#pragma unroll
            for (int e = 0; e < 8; ++e) { gg[e] = lng[g * 256 + c0 + e]; bb[e] = lnb[g * 256 + c0 + e]; }
#pragma unroll 2
            for (int i = 0; i < 8; ++i) {
                const int q = (tid >> 5) + 16 * i;
                const u32x4 raw = *(const u32x4*)(Z + (rowb + q) * 2048 + 1024 + g * 256 + c0);
                const float m = mu[q], r = rsd[q];
                const unsigned wv[4] = {raw.x, raw.y, raw.z, raw.w};
#pragma unroll
                for (int e = 0; e < 8; ++e) {
                    const float v = __uint_as_float((e & 1) ? (wv[e >> 1] & 0xffff0000u) : (wv[e >> 1] << 16));
                    const float y = (v - m) * r * gg[e] + bb[e];
                    const unsigned pk = cvt_pk_bf16(y, y);
                    const int c = c0 + e, chunk = (q >> 3) ^ ((c >> 3) & 15) ^ (c & 7);
                    *(LAS unsigned short*)(VT + c * 256 + chunk * 16 + (q & 7) * 2) = (unsigned short)pk;
                }
            }
        }
        __syncthreads();
        f32x4 acc[2][8];
#pragma unroll
        for (int ct = 0; ct < 2; ++ct)
#pragma unroll
            for (int pt = 0; pt < 8; ++pt) acc[ct][pt] = (f32x4){0.f, 0.f, 0.f, 0.f};
        const int l16 = lane & 15, l4 = lane >> 4;
#pragma unroll
        for (int ks = 0; ks < 4; ++ks) {
            bf16x8 af[2], bfr[8];
#pragma unroll
            for (int ct = 0; ct < 2; ++ct) { const int c = wave * 32 + ct * 16 + l16, chunk = (4 * ks + l4) ^ ((c >> 3) & 15) ^ (c & 7); af[ct] = *(const LAS bf16x8*)(VT + c * 256 + chunk * 16); }
#pragma unroll
            for (int pt = 0; pt < 8; ++pt) bfr[pt] = *(const LAS bf16x8*)(Aimg + (pt * 16 + l16) * APITCH + (32 * ks + 8 * l4) * 2);
#pragma unroll
            for (int ct = 0; ct < 2; ++ct)
#pragma unroll
                for (int pt = 0; pt < 8; ++pt) acc[ct][pt] = __builtin_amdgcn_mfma_f32_16x16x32_bf16(af[ct], bfr[pt], acc[ct][pt], 0, 0, 0);
        }
#pragma unroll
        for (int pt = 0; pt < 8; ++pt) {
            const int p = pt * 16 + l16; const float bsv = bsf[g * 128 + p];
#pragma unroll
            for (int ct = 0; ct < 2; ++ct) {
                const int c = g * 256 + wave * 32 + ct * 16 + 4 * l4;
                const u32x2 uu = *(const u32x2*)(Z + (rowb + p) * 2048 + c);
                const float u0 = __uint_as_float(uu.x << 16), u1 = __uint_as_float(uu.x & 0xffff0000u), u2 = __uint_as_float(uu.y << 16), u3 = __uint_as_float(uu.y & 0xffff0000u);
                const f32x4 s = acc[ct][pt] + bsv;
                u32x2 w; w.x = cvt_pk_bf16(u0 * s[0], u1 * s[1]); w.y = cvt_pk_bf16(u2 * s[2], u3 * s[3]);
                *(u32x2*)(T1 + (rowb + p) * D + c) = w;
            }
        }
    }
}

constexpr int ATT_BUF = 36864;
__device__ __forceinline__ int sig23(int r) { return (r & ~12) | ((r & 4) << 1) | ((r & 8) >> 1); }

__device__ __forceinline__ void attn_issue(int st, int first_unit, int L, const bf16_t* Q, const bf16_t* Kall, const bf16_t* Vtall, u32x4 (&pre)[4], bf16x8 (&qpre)[4], int tid) {
    const int unit = first_unit + (st >> 3), chn = st & 7, pm = unit >> 2, h = unit & 3, b = pm >> 4;
    const int lane = tid & 63, wave = tid >> 6;
    if (chn < 4) {
#pragma unroll
        for (int i = 0; i < 4; ++i) { const int p = tid + 512 * i, rho = p >> 3, part = p & 7;
            pre[i] = *(const u32x4*)(Kall + (size_t)(b * 256 + sig23(rho)) * 4096 + L * 1024 + h * 256 + chn * 64 + part * 8); }
        const bf16_t* qp = Q + (size_t)(pm * 256 + wave * 32 + (lane & 31)) * D + h * 256 + chn * 64 + (lane >> 5) * 8;
#pragma unroll
        for (int ks = 0; ks < 4; ++ks) qpre[ks] = *(const bf16x8*)(qp + ks * 16);
    } else {
        const int vc = chn - 4;
#pragma unroll
        for (int i = 0; i < 4; ++i) { const int p = tid + 512 * i, r = p >> 5, part = p & 31;
            pre[i] = *(const u32x4*)(Vtall + (size_t)(L * 1024 + h * 256 + vc * 64 + r) * 4096 + b * 256 + part * 8); }
    }
}
__device__ __forceinline__ void attn_commit(int st, LAS unsigned char* lds, const u32x4 (&pre)[4], int tid) {
    LAS unsigned char* buf = lds + (st & 1) * ATT_BUF; const int chn = st & 7;
    if (chn < 4) {
#pragma unroll
        for (int i = 0; i < 4; ++i) { const int p = tid + 512 * i, rho = p >> 3, part = p & 7; *(LAS u32x4*)(buf + rho * 144 + part * 16) = pre[i]; }
    } else {
#pragma unroll
        for (int i = 0; i < 4; ++i) { const int p = tid + 512 * i, r = p >> 5, part = p & 31; *(LAS u32x4*)(buf + r * 528 + part * 16) = pre[i]; }
    }
}

__device__ __forceinline__ void attn_phase(LAS unsigned char* lds, const bf16_t* Q, const bf16_t* Kall, const bf16_t* Vtall, bf16_t* O, int L, int G) {
    int tid_ = threadIdx.x; asm volatile("" : "+v"(tid_));
    const int tid = tid_, lane = tid & 63, wave = __builtin_amdgcn_readfirstlane(tid >> 6), l32 = lane & 31, half = lane >> 5;
    const int bx = blockIdx.x, vcu = (G % 8 == 0) ? (bx % 8) * (G / 8) + bx / 8 : bx;
    const int nper = (1024 + G - 1) / G, first_unit = vcu * nper;
    int nunits = 1024 - first_unit; if (nunits > nper) nunits = nper; if (nunits <= 0) return;
    const int nsteps = nunits * 8;
    u32x4 pre[4]; bf16x8 qpre[4], qcur[4];
    __syncthreads();
    attn_issue(0, first_unit, L, Q, Kall, Vtall, pre, qpre, tid);
    attn_commit(0, lds, pre, tid);
#pragma unroll
    for (int ks = 0; ks < 4; ++ks) qcur[ks] = qpre[ks];
    __syncthreads();
    int st = 0;
    for (int ui = 0; ui < nunits; ++ui) {
        const int unit = first_unit + ui, pm = unit >> 2, h = unit & 3;
        f32x16 S[8];
#pragma unroll
        for (int mt = 0; mt < 8; ++mt)
#pragma unroll
            for (int i = 0; i < 16; ++i) S[mt][i] = 0.f;
        for (int kc = 0; kc < 4; ++kc, ++st) {
            if (st + 1 < nsteps) attn_issue(st + 1, first_unit, L, Q, Kall, Vtall, pre, qpre, tid);
            const LAS unsigned char* buf = lds + (st & 1) * ATT_BUF;
#pragma unroll
            for (int ks = 0; ks < 4; ++ks)
#pragma unroll
                for (int mt = 0; mt < 8; ++mt) {
                    const bf16x8 kf = *(const LAS bf16x8*)(buf + (32 * mt + l32) * 144 + ks * 32 + half * 16);
                    S[mt] = __builtin_amdgcn_mfma_f32_32x32x16_bf16(kf, qcur[ks], S[mt], 0, 0, 0);
                }
            if (st + 1 < nsteps) attn_commit(st + 1, lds, pre, tid);
#pragma unroll
            for (int ks = 0; ks < 4; ++ks) qcur[ks] = qpre[ks];
            __syncthreads();
        }
        float mx = -3.0e38f;
#pragma unroll
        for (int mt = 0; mt < 8; ++mt)
#pragma unroll
            for (int i = 0; i < 16; ++i) mx = fmaxf(mx, S[mt][i]);
        mx = fmaxf(mx, __shfl_xor(mx, 32));
        float lsum = 0.f;
        bf16x8 pf[8][2];
#pragma unroll
        for (int mt = 0; mt < 8; ++mt) {
#pragma unroll
            for (int i = 0; i < 16; ++i) { const float p = __builtin_amdgcn_exp2f(S[mt][i] - mx); S[mt][i] = p; lsum += p; }
#pragma unroll
            for (int s2 = 0; s2 < 2; ++s2) { u32x4 w; w.x = cvt_pk_bf16(S[mt][8 * s2 + 0], S[mt][8 * s2 + 1]); w.y = cvt_pk_bf16(S[mt][8 * s2 + 2], S[mt][8 * s2 + 3]);
                w.z = cvt_pk_bf16(S[mt][8 * s2 + 4], S[mt][8 * s2 + 5]); w.w = cvt_pk_bf16(S[mt][8 * s2 + 6], S[mt][8 * s2 + 7]); pf[mt][s2] = __builtin_bit_cast(bf16x8, w); }
        }
        lsum += __shfl_xor(lsum, 32);
        const float inv = 1.0f / lsum;
        bf16_t* orow = O + (size_t)(pm * 256 + wave * 32 + l32) * D + h * 256;
        for (int vc = 0; vc < 4; ++vc, ++st) {
            if (st + 1 < nsteps) attn_issue(st + 1, first_unit, L, Q, Kall, Vtall, pre, qpre, tid);
            const LAS unsigned char* buf = lds + (st & 1) * ATT_BUF;
            f32x16 o[2];
#pragma unroll
            for (int ht = 0; ht < 2; ++ht)
#pragma unroll
                for (int i = 0; i < 16; ++i) o[ht][i] = 0.f;
#pragma unroll
            for (int mt = 0; mt < 8; ++mt)
#pragma unroll
                for (int s2 = 0; s2 < 2; ++s2)
#pragma unroll
                    for (int ht = 0; ht < 2; ++ht) {
                        const bf16x8 vf = *(const LAS bf16x8*)(buf + (32 * ht + l32) * 528 + (32 * mt + 16 * s2 + 8 * half) * 2);
                        o[ht] = __builtin_amdgcn_mfma_f32_32x32x16_bf16(vf, pf[mt][s2], o[ht], 0, 0, 0);
                    }
#pragma unroll
            for (int ht = 0; ht < 2; ++ht)
#pragma unroll
                for (int i4 = 0; i4 < 4; ++i4) {
                    u32x2 w; w.x = cvt_pk_bf16(o[ht][4 * i4 + 0] * inv, o[ht][4 * i4 + 1] * inv); w.y = cvt_pk_bf16(o[ht][4 * i4 + 2] * inv, o[ht][4 * i4 + 3] * inv);
                    *(u32x2*)(orow + vc * 64 + ht * 32 + i4 * 8 + half * 4) = w;
                }
            if (st + 1 < nsteps) attn_commit(st + 1, lds, pre, tid);
#pragma unroll
            for (int ks = 0; ks < 4; ++ks) qcur[ks] = qpre[ks];
            __syncthreads();
        }
    }
}

__device__ __forceinline__ void final_norm_phase(float* x, const float* gain, int G) {
    int tid_ = threadIdx.x; asm volatile("" : "+v"(tid_));
    const int tid = tid_, lane = tid & 63, wave = tid >> 6, gw = blockIdx.x * 8 + wave, NGW = G * 8;
    f32x4 gv[4];
#pragma unroll
    for (int j = 0; j < 4; ++j) gv[j] = ((const f32x4*)gain)[lane + 64 * j];
    for (int r = gw; r < M; r += NGW) {
        f32x4* xr = (f32x4*)(x + (size_t)r * D) + lane; f32x4 v[4]; float s = 0.f;
#pragma unroll
        for (int j = 0; j < 4; ++j) { v[j] = xr[64 * j]; s += (v[j][0] * v[j][0] + v[j][1] * v[j][1]) + (v[j][2] * v[j][2] + v[j][3] * v[j][3]); }
        s = wave_sum(s);
        const float rs = 1.0f / sqrtf(s * (1.0f / D) + EPS);
#pragma unroll
        for (int j = 0; j < 4; ++j) xr[64 * j] = v[j] * rs * gv[j];
    }
}

constexpr int NPHASES = 35;
__host__ __device__ inline bool phase_empty(int ph) { if (ph < 2 || ph >= 34) return false; const int L = (ph - 2) >> 3, k = (ph - 2) & 7; return k == 2 && (L & 1) == 0; }

__global__ void __launch_bounds__(512, 2) fwd_megakernel(Params P) {
    extern __shared__ __attribute__((aligned(16))) unsigned char lds_raw[];
    LAS unsigned char* lds = (LAS unsigned char*)lds_raw;
    cg::grid_group grid = cg::this_grid();
    const int G = gridDim.x;
    unsigned char* ws = P.ws;
    bf16_t* T1 = (bf16_t*)(ws + WS_T1); bf16_t* OB = (bf16_t*)(ws + WS_O); bf16_t* ZB = (bf16_t*)(ws + WS_Z); bf16_t* HB = (bf16_t*)(ws + WS_H);
    bf16_t* XB = (bf16_t*)(ws + WS_XB); bf16_t* KALL = (bf16_t*)(ws + WS_KALL); bf16_t* VTALL = (bf16_t*)(ws + WS_VTALL); bf16_t* MEMB = (bf16_t*)(ws + WS_MEMB);
    float* SSQ[2] = {(float*)(ws + WS_SSQ0), (float*)(ws + WS_SSQ1)};
    float* VSTAT = (float*)(ws + WS_VSTAT); float* RSTDMEM = (float*)(ws + WS_RSTDMEM);
    float* X = P.out;

    for (int ph = P.ph_lo; ph < P.ph_hi; ++ph) {
        if (phase_empty(ph)) continue;
        if (ph == 0) {
            prologue_phase(P, lds, G);
        } else if (ph == 1) {
            pg8::StaticOrder S; S.init(MR, 4096, G, (int)blockIdx.x);
            { pg8::Gemm g{MEMB, (const bf16_t*)(ws + WS_WK), MR, 4096, D, D, D, 0}; pg8::EpiAct<4> E{KALL, 4096, nullptr, 1.f, RSTDMEM, nullptr}; pg8::gemm_phase(lds, g, S, E); }
            { pg8::Gemm g{(const bf16_t*)(ws + WS_WV), MEMB, 4096, MR, D, D, D, 0}; pg8::EpiAct<3> E{VTALL, 4096, nullptr, 1.f, RSTDMEM, nullptr}; pg8::gemm_phase(lds, g, S, E); }
        } else if (ph == 34) {
            final_norm_phase(X, P.in[I_G_FINAL], G);
        } else {
            const int L = (ph - 2) >> 3, k = (ph - 2) & 7, j = L >> 1; const bool odd = (L & 1) != 0;
            if (k == 0) {
                const float* ssq_r = SSQ[(3 * L) & 1];
                if (!odd) { pool_a_phase(lds, (L == 0) ? P.in[I_X] : X, ssq_r, T1, G); }
                else { pg8::Gemm g{XB, (const bf16_t*)(ws + WS_WIN) + (size_t)j * D * 2 * D, M, 2 * D, D, D, D, 0}; pg8::StaticOrder S; S.init(M, 2 * D, G, (int)blockIdx.x);
                    pg8::EpiAct<2> E{ZB, 2 * D, ssq_r, 1.f, nullptr, VSTAT}; pg8::gemm_phase(lds, g, S, E); }
            } else if (k == 1 && odd) {
                sgu_spatial_phase(lds, ZB, VSTAT, P.in[I_SGU_WS] + (size_t)j * 4 * 128 * 128, P.in[I_SGU_BS] + j * 512, P.in[I_SGU_LNG] + j * D, P.in[I_SGU_LNB] + j * D, T1, G);
            } else if (k == 3) {
                pg8::Gemm g{XB, (const bf16_t*)(ws + WS_WQ) + (size_t)L * D * D, M, D, D, D, D, 0}; pg8::StaticOrder S; S.init(M, D, G, (int)blockIdx.x);
                pg8::EpiAct<0> E{T1, D, SSQ[(3 * L + 1) & 1], QSCALE, nullptr, nullptr}; pg8::gemm_phase(lds, g, S, E);
            } else if (k == 4) {
                attn_phase(lds, T1, KALL, VTALL, OB, L, G);
            } else if (k == 6) {
                pg8::Gemm g{XB, (const bf16_t*)(ws + WS_W1) + (size_t)L * D * FF, M, FF, D, D, D, 0}; pg8::StaticOrder S; S.init(M, FF, G, (int)blockIdx.x);
                pg8::EpiAct<1> E{HB, FF, SSQ[(3 * L + 2) & 1], 1.f, nullptr, nullptr}; pg8::gemm_phase(lds, g, S, E);
            } else {
                pg8::Gemm g; const float* xin = X; int upd;
                if (k == 1)      { g = pg8::Gemm{T1, (const bf16_t*)(ws + WS_PW) + (size_t)j * 4 * 256 * 256, M, D, 256, D, 256, 256}; upd = 3 * L; if (L == 0) xin = P.in[I_X]; }
                else if (k == 2) { g = pg8::Gemm{T1, (const bf16_t*)(ws + WS_WOUT) + (size_t)j * D * D, M, D, D, D, D, 0}; upd = 3 * L; }
                else if (k == 5) { g = pg8::Gemm{OB, (const bf16_t*)(ws + WS_WO) + (size_t)L * D * D, M, D, D, D, D, 0}; upd = 3 * L + 1; }
                else             { g = pg8::Gemm{HB, (const bf16_t*)(ws + WS_W2) + (size_t)L * D * FF, M, D, FF, FF, FF, 0}; upd = 3 * L + 2; }
                pg8::StaticOrder S; S.init(M, D, G, (int)blockIdx.x);
                pg8::EpiResid E{xin, X, XB, SSQ[(upd + 1) & 1]}; pg8::gemm_phase(lds, g, S, E);
            }
        }
        if (ph + 1 < P.ph_hi) grid.sync();
    }
}

extern "C" void kernel_launch(void* const* d_in, const int* in_sizes, int n_in, void* d_out, int out_size, void* d_ws, size_t ws_size, hipStream_t stream) {
    static int grid = 0;
    if (grid == 0) {
        if (n_in != 20 || in_sizes[0] != M * D || out_size != M * D || ws_size < WS_END) { fprintf(stderr, "kernel_launch: unexpected shapes (n_in %d, in0 %d, out %d, ws %zu); nothing launched\n", n_in, n_in > 0 ? in_sizes[0] : -1, out_size, ws_size); grid = -1; return; }
        int dev = 0, cus = 0, per_cu = 0;
        if (hipGetDevice(&dev) != hipSuccess || hipDeviceGetAttribute(&cus, hipDeviceAttributeMultiprocessorCount, dev) != hipSuccess) { grid = -1; return; }
        if (hipFuncSetAttribute((const void*)fwd_megakernel, hipFuncAttributeMaxDynamicSharedMemorySize, LDS_BYTES) != hipSuccess) { fprintf(stderr, "kernel_launch: hipFuncSetAttribute failed\n"); grid = -1; return; }
        if (hipOccupancyMaxActiveBlocksPerMultiprocessor(&per_cu, (const void*)fwd_megakernel, 512, LDS_BYTES) != hipSuccess || per_cu < 1) { fprintf(stderr, "kernel_launch: occupancy query gave %d\n", per_cu); per_cu = 1; }
        (void)hipGetLastError();
        grid = cus * per_cu;
        if (grid > 256) grid = 256;
        grid &= ~7;
        if (grid < 8) { grid = -1; return; }
    }
    if (grid < 0) return;
    Params p{};
    for (int i = 0; i < 20; ++i) p.in[i] = (const float*)d_in[i];
    p.out = (float*)d_out; p.ws = (unsigned char*)d_ws;
#if MK_SINGLE
    p.ph_lo = 0; p.ph_hi = NPHASES;
    void* args[] = {&p};
    hipError_t e = hipLaunchCooperativeKernel((const void*)fwd_megakernel, dim3(grid), dim3(512), args, LDS_BYTES, stream);
    if (e != hipSuccess) fprintf(stderr, "kernel_launch: cooperative launch failed: %s (grid %d)\n", hipGetErrorString(e), grid);
#else
    for (int ph = 0; ph < NPHASES; ++ph) {
        if (phase_empty(ph)) continue;
        p.ph_lo = ph; p.ph_hi = ph + 1;
        hipLaunchKernelGGL(fwd_megakernel, dim3(grid), dim3(512), LDS_BYTES, stream, p);
    }
#endif
}
```

```cpp
#include <hip/hip_runtime.h>
#include <hip/hip_cooperative_groups.h>
#include <cstdio>
#include <cstdint>
namespace cg = cooperative_groups;

#ifndef MK_SINGLE
#define MK_SINGLE 1
#endif

#define LAS __attribute__((address_space(3)))
typedef unsigned short bf16_t;
typedef short bf16x8 __attribute__((ext_vector_type(8)));
typedef float f32x4 __attribute__((ext_vector_type(4)));
typedef float f32x2 __attribute__((ext_vector_type(2)));
typedef float f32x16 __attribute__((ext_vector_type(16)));
typedef unsigned u32x4 __attribute__((ext_vector_type(4)));
typedef unsigned u32x2 __attribute__((ext_vector_type(2)));

constexpr int D = 1024, BATCH = 16, SEQ = 4096, DEPTH = 4, FF = 4096, NMEM = 256;
constexpr int M = BATCH * SEQ;
constexpr int MR = BATCH * NMEM;
constexpr float EPS = 1e-6f;
constexpr float QSCALE = 0.0625f * 1.4426950408889634f;

constexpr size_t MiB = 1u << 20;
constexpr size_t WS_H = 0, WS_T1 = 0, WS_O = 128 * MiB, WS_Z = 256 * MiB;
constexpr size_t WS_XB = 512 * MiB;
constexpr size_t WS_KALL = 640 * MiB, WS_VTALL = 672 * MiB, WS_MEMB = 704 * MiB;
constexpr size_t WS_SSQ0 = 712 * MiB, WS_SSQ1 = 716 * MiB, WS_VSTAT = 720 * MiB, WS_RSTDMEM = 728 * MiB;
constexpr size_t WS_CTL = 730 * MiB, CTL_BYTES = 16384;
constexpr size_t WS_WQ = 736 * MiB, WS_WO = 744 * MiB, WS_W1 = 752 * MiB, WS_W2 = 784 * MiB, WS_WK = 816 * MiB, WS_WV = 824 * MiB;
constexpr size_t WS_WIN = 832 * MiB, WS_WOUT = 840 * MiB, WS_PW = 844 * MiB, WS_END = 845 * MiB;

constexpr int LDS_BYTES = 147456;

struct Params {
    const float* in[20];
    float* out;
    unsigned char* ws;
    int ph_lo, ph_hi;
};

__device__ __forceinline__ unsigned cvt_pk_bf16(float lo, float hi) { unsigned r; asm volatile("v_cvt_pk_bf16_f32 %0, %1, %2" : "=v"(r) : "v"(lo), "v"(hi)); return r; }
__device__ __forceinline__ float wave_sum(float v) {
#pragma unroll
    for (int o = 1; o < 64; o <<= 1) v += __shfl_xor(v, o);
    return v;
}
__device__ __forceinline__ float gelu_tanh(float x) {
    const float y = 0.7978845608028654f * (x + 0.044715f * x * x * x);
    const float e = __builtin_amdgcn_exp2f(-2.0f * 1.4426950408889634f * y);
    return x * __builtin_amdgcn_rcpf(1.0f + e);
}

namespace pg8 {
constexpr int BM = 256, BK = 64, HALF = 128, HTB = HALF * BK * 2, STAGE_BYTES = 8 * HTB, NXCD = 8, WGM = 8;
__host__ __device__ __forceinline__ int lds_byte(int r, int c) { const int st = (r >> 4) * 2 + (c >> 5), rr = r & 15, cc = c & 31, ob = rr * 64 + cc * 2; return st * 1024 + (ob ^ (((ob >> 9) & 1) << 5)); }
__host__ __device__ __forceinline__ void stage_rc(int b, int& R, int& C) { const int st = b / 1024, sb = b % 1024, swz = sb ^ (((sb >> 9) & 1) << 5); R = (st >> 1) * 16 + swz / 64; C = (st & 1) * 32 + (swz % 64) / 2; }
__host__ __device__ __forceinline__ int perm32(int rho) { const int n = rho >> 4, i = rho & 15; return 8 * (i >> 2) + 4 * n + (i & 3); }

struct Unit { int pm, pn; };
struct Gemm { const bf16_t* A; const bf16_t* Bt; int M, N, K, lda, ldb, acol; };

struct StaticOrder {
    int nM, nN, nwg, G, c;
    __device__ void init(int M_, int N_, int G_, int c_) { nM = M_ / BM; nN = N_ / BM; nwg = nM * nN; G = G_; c = c_; }
    __device__ bool next(int i, Unit& u) const {
        const long L = (long)i * G + c; if (L >= nwg) return false;
        int wgid = (int)L; { const int q = nwg / NXCD, r = nwg % NXCD, xcd = wgid % NXCD, off = wgid / NXCD; wgid = (xcd < r ? xcd * (q + 1) : r * (q + 1) + (xcd - r) * q) + off; }
        const int nig = WGM * nN, gid = wgid / nig, fm = gid * WGM, gsz = (nM - fm) < WGM ? (nM - fm) : WGM;
        u.pm = fm + ((wgid % nig) % gsz); u.pn = (wgid % nig) / gsz; return true;
    }
};

__device__ __forceinline__ float rstd_from_slots(const float* ssq, int row, int fq) {
    const f32x4 v = *(const f32x4*)(ssq + (size_t)row * 16 + fq * 4);
    float s = (v[0] + v[1]) + (v[2] + v[3]);
    s += __shfl_xor(s, 16); s += __shfl_xor(s, 32);
    return __builtin_amdgcn_rsqf(s * (1.0f / 1024.0f) + EPS);
}

template <int MODE> struct EpiAct {
    bf16_t* O; int ldc; const float* ssq; float scale; const float* rvec; float* vstat;
    __device__ __forceinline__ void operator()(const f32x4 (&acc)[2][2][4][2], const Unit& u, int wr, int wc, int fr, int fq) const {
        const int row0 = u.pm * BM + wr * 64 + fr, col0 = u.pn * BM + wc * 32 + 8 * fq;
        f32x4 cs[2][2];
        if (MODE == 3) {
#pragma unroll
            for (int bj = 0; bj < 2; ++bj) { cs[bj][0] = *(const f32x4*)(rvec + col0 + bj * HALF); cs[bj][1] = *(const f32x4*)(rvec + col0 + bj * HALF + 4); }
        }
#pragma unroll
        for (int ai = 0; ai < 2; ++ai)
#pragma unroll
            for (int m = 0; m < 4; ++m) {
                const int row = row0 + ai * HALF + m * 16;
                float rs = 1.f;
                if (MODE == 0 || MODE == 1 || MODE == 2) rs = rstd_from_slots(ssq, row, fq);
                if (MODE == 0) rs *= scale;
                if (MODE == 4) rs = rvec[row];
                bf16_t* rowp = O + (size_t)row * ldc + col0;
                float s1 = 0.f, s2 = 0.f;
#pragma unroll
                for (int bj = 0; bj < 2; ++bj) {
                    f32x4 v0 = acc[ai][bj][m][0] * rs, v1 = acc[ai][bj][m][1] * rs;
                    if (MODE == 3) { v0 = acc[ai][bj][m][0] * cs[bj][0]; v1 = acc[ai][bj][m][1] * cs[bj][1]; }
                    if (MODE == 1) {
#pragma unroll
                        for (int j = 0; j < 4; ++j) { const float a = v0[j] > 0.f ? v0[j] : 0.f, b = v1[j] > 0.f ? v1[j] : 0.f; v0[j] = a * a; v1[j] = b * b; }
                    }
                    if (MODE == 2) {
#pragma unroll
                        for (int j = 0; j < 4; ++j) { v0[j] = gelu_tanh(v0[j]); v1[j] = gelu_tanh(v1[j]); }
#pragma unroll
                        for (int j = 0; j < 4; ++j) { s1 += v0[j] + v1[j]; s2 += v0[j] * v0[j] + v1[j] * v1[j]; }
                    }
                    u32x4 w; w.x = cvt_pk_bf16(v0[0], v0[1]); w.y = cvt_pk_bf16(v0[2], v0[3]); w.z = cvt_pk_bf16(v1[0], v1[1]); w.w = cvt_pk_bf16(v1[2], v1[3]);
                    *(u32x4*)(rowp + bj * HALF) = w;
                }
                if (MODE == 2) {
                    s1 += __shfl_xor(s1, 16); s1 += __shfl_xor(s1, 32); s2 += __shfl_xor(s2, 16); s2 += __shfl_xor(s2, 32);
                    if (u.pn >= 4 && fq == 0) { vstat[(size_t)row * 32 + (u.pn - 4) * 4 + wc] = s1; vstat[(size_t)row * 32 + 16 + (u.pn - 4) * 4 + wc] = s2; }
                }
            }
    }
};
struct EpiResid {
    const float* xin; float* xout; bf16_t* xb; float* ssq;
    __device__ __forceinline__ void operator()(const f32x4 (&acc)[2][2][4][2], const Unit& u, int wr, int wc, int fr, int fq) const {
        const int row0 = u.pm * BM + wr * 64 + fr, col0 = u.pn * BM + wc * 32 + 8 * fq;
#pragma unroll
        for (int ai = 0; ai < 2; ++ai)
#pragma unroll
            for (int m = 0; m < 4; ++m) {
                const int row = row0 + ai * HALF + m * 16; const size_t off = (size_t)row * D + col0;
                float ss = 0.f;
#pragma unroll
                for (int bj = 0; bj < 2; ++bj) {
                    const f32x4 a0 = *(const f32x4*)(xin + off + bj * HALF), a1 = *(const f32x4*)(xin + off + bj * HALF + 4);
                    const f32x4 v0 = a0 + acc[ai][bj][m][0], v1 = a1 + acc[ai][bj][m][1];
                    *(f32x4*)(xout + off + bj * HALF) = v0; *(f32x4*)(xout + off + bj * HALF + 4) = v1;
                    u32x4 w; w.x = cvt_pk_bf16(v0[0], v0[1]); w.y = cvt_pk_bf16(v0[2], v0[3]); w.z = cvt_pk_bf16(v1[0], v1[1]); w.w = cvt_pk_bf16(v1[2], v1[3]);
                    *(u32x4*)(xb + off + bj * HALF) = w;
#pragma unroll
                    for (int j = 0; j < 4; ++j) ss += v0[j] * v0[j] + v1[j] * v1[j];
                }
                ss += __shfl_xor(ss, 16); ss += __shfl_xor(ss, 32);
                if (fq == 0) ssq[(size_t)row * 16 + u.pn * 4 + wc] = ss;
                asm volatile("" ::: "memory");
            }
    }
};

template <class Epi>
__device__ __forceinline__ void gemm_phase(LAS unsigned char* lds, const Gemm g, const StaticOrder& S, const Epi& E) {
    int tid_ = threadIdx.x; asm volatile("" : "+v"(tid_));
    const int tid = tid_, wid = __builtin_amdgcn_readfirstlane(tid >> 6), lane = tid & 63, wr = wid >> 2, wc = wid & 3, fr = lane & 15, fq = lane >> 4;
    const int nt = g.K / BK;
    unsigned voffA[2], voffB[2];
#pragma unroll
    for (int i = 0; i < 2; ++i) { int R, C; stage_rc(tid * 16 + i * 8192, R, C); const int Rb = (R & ~31) + perm32(R & 31);
        voffA[i] = (unsigned)(R * g.lda + C) * 2u; voffB[i] = (unsigned)(Rb * g.ldb + C) * 2u; }
    const size_t kstep = (size_t)(BK * 2);
    const size_t hstepA = (size_t)HALF * g.lda * 2, hstepB = (size_t)HALF * g.ldb * 2;
    const size_t tstepA = 2 * hstepA, tstepB = 2 * hstepB, cstepA = (size_t)g.acol * 2;
    const unsigned ldsw = (unsigned)wid * 1024u;
    const int aoff = lds_byte(wr * 64 + fr, fq * 8), boff = lds_byte(wc * 32 + fr, fq * 8);
#define PG8_SA(b, h) (((b) * 2 + (h)) * HTB)
#define PG8_SB(b, h) ((4 + (b) * 2 + (h)) * HTB)
#define PG8_STAGE(bufoff, gbase, voff) do { _Pragma("unroll") for (int _i = 0; _i < 2; ++_i) \
        __builtin_amdgcn_global_load_lds((const unsigned*)((const char*)(gbase) + (voff)[_i]), (LAS unsigned*)(lds + (bufoff) + ldsw + _i * 8192), 16, 0, 0); } while (0)
#define PG8_LDA(dst, b, h) do { _Pragma("unroll") for (int m = 0; m < 4; ++m) _Pragma("unroll") for (int k = 0; k < 2; ++k) dst[m][k] = *(const LAS bf16x8*)(lds + PG8_SA(b, h) + aoff + m * 2048 + k * 1024); } while (0)
#define PG8_LDB(dst, b, h) do { _Pragma("unroll") for (int n = 0; n < 2; ++n) _Pragma("unroll") for (int k = 0; k < 2; ++k) dst[n][k] = *(const LAS bf16x8*)(lds + PG8_SB(b, h) + boff + n * 2048 + k * 1024); } while (0)
#define PG8_MMA(ai, bj, At, Bt) do { __builtin_amdgcn_s_setprio(1); _Pragma("unroll") for (int m = 0; m < 4; ++m) _Pragma("unroll") for (int n = 0; n < 2; ++n) _Pragma("unroll") for (int k = 0; k < 2; ++k) \
        acc[ai][bj][m][n] = __builtin_amdgcn_mfma_f32_16x16x32_bf16(Bt[n][k], At[m][k], acc[ai][bj][m][n], 0, 0, 0); __builtin_amdgcn_s_setprio(0); } while (0)
#define PG8_WAIT_V(n) asm volatile("s_waitcnt vmcnt(" #n ")" ::: "memory")
#define PG8_WAIT_L(n) asm volatile("s_waitcnt lgkmcnt(" #n ")" ::: "memory")
#define PG8_BAR __builtin_amdgcn_s_barrier()
#define PG8_SCHED __builtin_amdgcn_sched_barrier(0)
    Unit cur, nxt; int ui = 0;
    if (!S.next(0, cur)) return;
    f32x4 acc[2][2][4][2];
#pragma unroll
    for (int a = 0; a < 2; ++a)
#pragma unroll
        for (int b = 0; b < 2; ++b)
#pragma unroll
            for (int m = 0; m < 4; ++m)
#pragma unroll
                for (int n = 0; n < 2; ++n) acc[a][b][m][n] = (f32x4){0.f, 0.f, 0.f, 0.f};
    bf16x8 At[4][2], B0[2][2], B1[2][2];
    const char* cA = (const char*)g.A + (size_t)cur.pm * tstepA + (size_t)cur.pn * cstepA; const char* cB = (const char*)g.Bt + (size_t)cur.pn * tstepB;
    PG8_STAGE(PG8_SB(0, 0), cB, voffB); PG8_STAGE(PG8_SB(0, 1), cB + hstepB, voffB); PG8_STAGE(PG8_SA(0, 0), cA, voffA); PG8_STAGE(PG8_SA(0, 1), cA + hstepA, voffA);
    if (wr == 1) PG8_BAR;
    PG8_WAIT_V(2); PG8_BAR;
    PG8_STAGE(PG8_SB(1, 0), cB + kstep, voffB); PG8_STAGE(PG8_SA(1, 0), cA + kstep, voffA); PG8_STAGE(PG8_SB(1, 1), cB + hstepB + kstep, voffB);
    PG8_WAIT_V(6); PG8_BAR;
    for (;;) {
        const bool has_next = S.next(ui + 1, nxt);
        const char* nA = has_next ? (const char*)g.A + (size_t)nxt.pm * tstepA + (size_t)nxt.pn * cstepA : cA; const char* nB = has_next ? (const char*)g.Bt + (size_t)nxt.pn * tstepB : cB;
        for (int t = 0; t < nt; t += 2) {
            const bool last = (t == nt - 2);
            const char* a1 = cA + (size_t)(t + 1) * kstep;
            const char* a2 = last ? nA : cA + (size_t)(t + 2) * kstep; const char* b2 = last ? nB : cB + (size_t)(t + 2) * kstep;
            const char* a3 = a2 + kstep; const char* b3 = b2 + kstep;
            PG8_LDB(B0, 0, 0); PG8_LDB(B1, 0, 1); PG8_SCHED; PG8_LDA(At, 0, 0); PG8_STAGE(PG8_SA(1, 1), a1 + hstepA, voffA);
            PG8_WAIT_V(8); PG8_WAIT_L(0); PG8_BAR; PG8_MMA(0, 0, At, B0); PG8_MMA(0, 1, At, B1); PG8_BAR; PG8_SCHED;
            PG8_LDA(At, 0, 1); PG8_STAGE(PG8_SB(0, 0), b2, voffB); PG8_STAGE(PG8_SB(0, 1), b2 + hstepB, voffB); PG8_STAGE(PG8_SA(0, 0), a2, voffA);
            PG8_WAIT_V(8); PG8_WAIT_L(0); PG8_BAR; PG8_MMA(1, 0, At, B0); PG8_MMA(1, 1, At, B1); PG8_BAR; PG8_SCHED;
            PG8_LDB(B0, 1, 0); PG8_LDB(B1, 1, 1); PG8_SCHED; PG8_LDA(At, 1, 0); PG8_STAGE(PG8_SA(0, 1), a2 + hstepA, voffA);
            PG8_WAIT_V(8); PG8_WAIT_L(0); PG8_BAR; PG8_MMA(0, 0, At, B0); PG8_MMA(0, 1, At, B1); PG8_BAR; PG8_SCHED;
            PG8_LDA(At, 1, 1); PG8_STAGE(PG8_SB(1, 0), b3, voffB); PG8_STAGE(PG8_SB(1, 1), b3 + hstepB, voffB); PG8_STAGE(PG8_SA(1, 0), a3, voffA);
            PG8_WAIT_V(8); PG8_WAIT_L(0); PG8_BAR; PG8_MMA(1, 0, At, B0); PG8_MMA(1, 1, At, B1); PG8_BAR; PG8_SCHED;
        }
        if (wr == 0) PG8_BAR;
        E(acc, cur, wr, wc, fr, fq);
        if (!has_next) break;
#pragma unroll
        for (int a = 0; a < 2; ++a)
#pragma unroll
            for (int b = 0; b < 2; ++b)
#pragma unroll
                for (int m = 0; m < 4; ++m)
#pragma unroll
                    for (int n = 0; n < 2; ++n) acc[a][b][m][n] = (f32x4){0.f, 0.f, 0.f, 0.f};
        cur = nxt; cA = nA; cB = nB; ++ui;
        if (wr == 1) PG8_BAR;
    }
    PG8_WAIT_V(0);
    PG8_BAR;
#undef PG8_SA
#undef PG8_SB
#undef PG8_STAGE
#undef PG8_LDA
#undef PG8_LDB
#undef PG8_MMA
#undef PG8_WAIT_V
#undef PG8_WAIT_L
#undef PG8_BAR
#undef PG8_SCHED
}
}

struct MatDesc { const float* src; int ldw, K, N; bf16_t* dst; int ldt; const float* ks; const float* ns; };

__device__ __forceinline__ void transpose_item(const MatDesc& d, LAS float* scr, int item, int lane) {
    const int nblk = d.N / 32, kb = item / nblk, nb = item % nblk, k0 = 64 * kb, n0 = 32 * nb;
    const float nsv = d.ns ? d.ns[n0 + (lane & 31)] : 1.f;
#pragma unroll 8
    for (int i = 0; i < 32; ++i) { const int kk = 2 * i + (lane >> 5); float v = d.src[(size_t)(k0 + kk) * d.ldw + n0 + (lane & 31)] * nsv; if (d.ks) v *= d.ks[k0 + kk]; scr[kk * 33 + (lane & 31)] = v; }
    asm volatile("s_waitcnt lgkmcnt(0)" ::: "memory");
    const int c = lane & 7;
#pragma unroll
    for (int j = 0; j < 4; ++j) { const int n = (lane >> 3) + 8 * j; const LAS float* s = scr + (8 * c) * 33 + n;
        u32x4 o; o.x = cvt_pk_bf16(s[0 * 33], s[1 * 33]); o.y = cvt_pk_bf16(s[2 * 33], s[3 * 33]); o.z = cvt_pk_bf16(s[4 * 33], s[5 * 33]); o.w = cvt_pk_bf16(s[6 * 33], s[7 * 33]);
        *(u32x4*)(d.dst + (size_t)(n0 + n) * d.ldt + k0 + 8 * c) = o; }
    asm volatile("s_waitcnt lgkmcnt(0)" ::: "memory");
}

enum { I_X = 0, I_MEM, I_G_MIX, I_G_MEM, I_G_MEMKV, I_G_FFN, I_G_FINAL, I_POOL_W, I_POOL_SCALE, I_SGU_WIN, I_SGU_LNG, I_SGU_LNB, I_SGU_WS, I_SGU_BS, I_SGU_WOUT, I_WQ, I_WKV, I_WO, I_W1, I_W2 };

__device__ __forceinline__ MatDesc get_mat(const Params& P, int id) {
    MatDesc d; d.ks = nullptr; d.ns = nullptr;
    unsigned char* ws = P.ws;
    if (id < 24) {
        const int L = id / 6, t = id % 6;
        if (t == 0)      { d.src = P.in[I_WQ] + (size_t)L * D * D; d.ldw = D; d.K = D; d.N = D; d.dst = (bf16_t*)(ws + WS_WQ) + (size_t)L * D * D; d.ldt = D; d.ks = P.in[I_G_MEM] + L * D; }
        else if (t == 1) { d.src = P.in[I_WKV] + (size_t)L * D * 2 * D; d.ldw = 2 * D; d.K = D; d.N = D; d.dst = (bf16_t*)(ws + WS_WK) + (size_t)L * D * D; d.ldt = D; d.ks = P.in[I_G_MEMKV] + L * D; }
        else if (t == 2) { d.src = P.in[I_WKV] + (size_t)L * D * 2 * D + D; d.ldw = 2 * D; d.K = D; d.N = D; d.dst = (bf16_t*)(ws + WS_WV) + (size_t)L * D * D; d.ldt = D; d.ks = P.in[I_G_MEMKV] + L * D; }
        else if (t == 3) { d.src = P.in[I_WO] + (size_t)L * D * D; d.ldw = D; d.K = D; d.N = D; d.dst = (bf16_t*)(ws + WS_WO) + (size_t)L * D * D; d.ldt = D; }
        else if (t == 4) { d.src = P.in[I_W1] + (size_t)L * D * FF; d.ldw = FF; d.K = D; d.N = FF; d.dst = (bf16_t*)(ws + WS_W1) + (size_t)L * D * FF; d.ldt = D; d.ks = P.in[I_G_FFN] + L * D; }
        else             { d.src = P.in[I_W2] + (size_t)L * D * FF; d.ldw = D; d.K = FF; d.N = D; d.dst = (bf16_t*)(ws + WS_W2) + (size_t)L * D * FF; d.ldt = FF; }
    } else if (id < 28) {
        const int j = (id - 24) >> 1, t = (id - 24) & 1;
        if (t == 0) { d.src = P.in[I_SGU_WIN] + (size_t)j * D * 2 * D; d.ldw = 2 * D; d.K = D; d.N = 2 * D; d.dst = (bf16_t*)(ws + WS_WIN) + (size_t)j * D * 2 * D; d.ldt = D; d.ks = P.in[I_G_MIX] + (2 * j + 1) * D; }
        else        { d.src = P.in[I_SGU_WOUT] + (size_t)j * D * D; d.ldw = D; d.K = D; d.N = D; d.dst = (bf16_t*)(ws + WS_WOUT) + (size_t)j * D * D; d.ldt = D; }
    } else {
        const int jg = id - 28, j = jg >> 2, g = jg & 3;
        d.src = P.in[I_POOL_W] + (size_t)jg * 256 * 256; d.ldw = 256; d.K = 256; d.N = 256; d.dst = (bf16_t*)(ws + WS_PW) + (size_t)jg * 256 * 256; d.ldt = 256;
        d.ks = P.in[I_G_MIX] + (2 * j) * D + g * 256; d.ns = P.in[I_POOL_SCALE] + j * D + g * 256;
    }
    return d;
}
__device__ __forceinline__ int mat_items(int id) {
    if (id < 24) { const int t = id % 6; return (t >= 4) ? 2048 : 512; }
    if (id < 28) return ((id - 24) & 1) ? 512 : 1024;
    return 32;
}

__device__ __forceinline__ void prologue_phase(const Params& P, LAS unsigned char* lds, int G) {
    int tid_ = threadIdx.x; asm volatile("" : "+v"(tid_));
    const int tid = tid_, lane = tid & 63, wave = __builtin_amdgcn_readfirstlane(tid >> 6);
    LAS float* scr = (LAS float*)(lds + wave * 16384);
    const int gw = blockIdx.x * 8 + wave, NGW = G * 8;
    constexpr int NITEMS = 4 * (4 * 512 + 2 * 2048) + 2 * (1024 + 512) + 8 * 32;
    for (int it = gw; it < NITEMS; it += NGW) {
        int r = it, id = 0;
        for (; id < 36; ++id) { const int n = mat_items(id); if (r < n) break; r -= n; }
        const MatDesc d = get_mat(P, id);
        transpose_item(d, scr, r, lane);
    }
    const float* mem = P.in[I_MEM]; bf16_t* memb = (bf16_t*)(P.ws + WS_MEMB); float* rstd_mem = (float*)(P.ws + WS_RSTDMEM);
    for (int r = gw; r < MR; r += NGW) {
        const f32x4* xr = (const f32x4*)(mem + (size_t)r * D) + lane; f32x4 v[4]; float s = 0.f;
#pragma unroll
        for (int j = 0; j < 4; ++j) { v[j] = xr[64 * j]; s += (v[j][0] * v[j][0] + v[j][1] * v[j][1]) + (v[j][2] * v[j][2] + v[j][3] * v[j][3]); }
        s = wave_sum(s);
        if (lane == 0) rstd_mem[r] = 1.0f / sqrtf(s * (1.0f / D) + EPS);
        u32x2* o = (u32x2*)(memb + (size_t)r * D) + lane;
#pragma unroll
        for (int j = 0; j < 4; ++j) { u32x2 w; w.x = cvt_pk_bf16(v[j][0], v[j][1]); w.y = cvt_pk_bf16(v[j][2], v[j][3]); o[64 * j] = w; }
    }
    const float* x = P.in[I_X]; float* ssq0 = (float*)(P.ws + WS_SSQ0);
    for (int r = gw; r < M; r += NGW) {
        const f32x4* xr = (const f32x4*)(x + (size_t)r * D) + lane; float s = 0.f;
#pragma unroll
        for (int j = 0; j < 4; ++j) { const f32x4 v = xr[64 * j]; s += (v[0] * v[0] + v[1] * v[1]) + (v[2] * v[2] + v[3] * v[3]); }
        s = wave_sum(s);
        if (lane < 16) ssq0[(size_t)r * 16 + lane] = (lane == 0) ? s : 0.f;
    }
}

template <int W>
__device__ __forceinline__ void pool_block(const f32x2 (&prev)[16], const f32x2 (&cur)[16], bool seq_start, bf16_t* outp  ) {
#pragma unroll
    for (int i = 0; i < 16; ++i) {
        f32x2 s = cur[i];
#pragma unroll
        for (int j = 1; j < W; ++j) { s += (i - j >= 0) ? cur[(i - j) & 15] : prev[(16 + i - j) & 15]; }
        float inv = 1.0f / (float)W;
        if (i < W - 1 && seq_start) inv = 1.0f / (float)(i + 1);
        const f32x2 o = s * inv - cur[i];
        *(unsigned*)(outp + (size_t)i * D) = cvt_pk_bf16(o[0], o[1]);
    }
}
__device__ __forceinline__ void pool_a_phase(LAS unsigned char* lds, const float* x, const float* ssq, bf16_t* PA, int G) {
    LAS float* rs = (LAS float*)lds;
    int tid_ = threadIdx.x; asm volatile("" : "+v"(tid_));
    const int tid = tid_, ch = 2 * tid, group = __builtin_amdgcn_readfirstlane(tid >> 7);
    for (int chunk = blockIdx.x; chunk < M / 64; chunk += G) {
        const int t0 = chunk * 64; const bool sstart = (t0 & (SEQ - 1)) == 0;
        __syncthreads();
        if (tid < 80) {
            float r = 0.f;
            if (!(sstart && tid < 16)) { const f32x4* p = (const f32x4*)(ssq + (size_t)(t0 - 16 + tid) * 16); const f32x4 a = p[0], b = p[1], c = p[2], d = p[3];
                const float s = (((a[0] + a[1]) + (a[2] + a[3])) + ((b[0] + b[1]) + (b[2] + b[3]))) + (((c[0] + c[1]) + (c[2] + c[3])) + ((d[0] + d[1]) + (d[2] + d[3])));
                r = 1.0f / sqrtf(s * (1.0f / D) + EPS); }
            rs[tid] = r;
        }
        __syncthreads();
        f32x2 prev[16], cur[16];
        if (sstart) {
#pragma unroll
            for (int i = 0; i < 16; ++i) prev[i] = (f32x2){0.f, 0.f};
        } else {
#pragma unroll
            for (int i = 0; i < 16; ++i) prev[i] = *(const f32x2*)(x + (size_t)(t0 - 16 + i) * D + ch) * rs[i];
        }
        for (int blk = 0; blk < 4; ++blk) {
#pragma unroll
            for (int i = 0; i < 16; ++i) cur[i] = *(const f32x2*)(x + (size_t)(t0 + blk * 16 + i) * D + ch) * rs[16 + blk * 16 + i];
            bf16_t* outp = PA + (size_t)(t0 + blk * 16) * D + ch;
            const bool ss = sstart && blk == 0;
            if (group == 0) pool_block<2>(prev, cur, ss, outp);
            else if (group == 1) pool_block<4>(prev, cur, ss, outp);
            else if (group == 2) pool_block<8>(prev, cur, ss, outp);
            else pool_block<16>(prev, cur, ss, outp);
#pragma unroll
            for (int i = 0; i < 16; ++i) prev[i] = cur[i];
        }
    }
}

__device__ __forceinline__ void sgu_spatial_phase(LAS unsigned char* lds, const bf16_t* Z, const float* vstat, const float* wsf, const float* bsf, const float* lng, const float* lnb, bf16_t* T1, int G) {
    constexpr int APITCH = 272;
    LAS unsigned char* Aimg = lds;
    LAS unsigned char* VT = lds + 34816;
    LAS float* mu = (LAS float*)(lds + 34816 + 65536); LAS float* rsd = mu + 128;
    int tid_ = threadIdx.x; asm volatile("" : "+v"(tid_));
    const int tid = tid_, lane = tid & 63, wave = __builtin_amdgcn_readfirstlane(tid >> 6);
    const int g = blockIdx.x & 3;
    bool first = true;
    for (int u = blockIdx.x; u < (M / 128) * 4; u += G) {
        const int nb = u >> 2; const size_t rowb = (size_t)nb * 128;
        __syncthreads();
        if (tid < 128) {
            const f32x4* p = (const f32x4*)(vstat + (rowb + tid) * 32); float s1 = 0.f, s2 = 0.f;
#pragma unroll
            for (int i = 0; i < 4; ++i) { const f32x4 a = p[i], b = p[4 + i]; s1 += (a[0] + a[1]) + (a[2] + a[3]); s2 += (b[0] + b[1]) + (b[2] + b[3]); }
            const float m = s1 * (1.0f / D), var = s2 * (1.0f / D) - m * m;
            mu[tid] = m; rsd[tid] = 1.0f / sqrtf(fmaxf(var, 0.f) + EPS);
        }
        if (first) {
            first = false;
            const float* wg = wsf + (size_t)g * 128 * 128;
#pragma unroll
            for (int i = 0; i < 8; ++i) { const int e = (tid + 512 * i) * 4, p = e >> 7, q = e & 127; f32x4 v = *(const f32x4*)(wg + e);
                if ((p >> 6) < (q >> 6)) v = (f32x4){0.f, 0.f, 0.f, 0.f};
                u32x2 w; w.x = cvt_pk_bf16(v[0], v[1]); w.y = cvt_pk_bf16(v[2], v[3]); *(LAS u32x2*)(Aimg + p * APITCH + q * 2) = w; }
        }
        __syncthreads();
        {
            const int cp = tid & 31, c0 = 8 * cp; float gg[8], bb[8];
#pragma unroll
            for (int e = 0; e < 8; ++e) { gg[e] = lng[g * 256 + c0 + e]; bb[e] = lnb[g * 256 + c0 + e]; }
#pragma unroll 2
            for (int i = 0; i < 8; ++i) {
                const int q = (tid >> 5) + 16 * i;
                const u32x4 raw = *(const u32x4*)(Z + (rowb + q) * 2048 + 1024 + g * 256 + c0);
                const float m = mu[q], r = rsd[q];
                const unsigned wv[4] = {raw.x, raw.y, raw.z, raw.w};
#pragma unroll
                for (int e = 0; e < 8; ++e) {
                    const float v = __uint_as_float((e & 1) ? (wv[e >> 1] & 0xffff0000u) : (wv[e >> 1] << 16));
                    const float y = (v - m) * r * gg[e] + bb[e];
                    const unsigned pk = cvt_pk_bf16(y, y);
                    const int c = c0 + e, chunk = (q >> 3) ^ ((c >> 3) & 15) ^ (c & 7);
                    *(LAS unsigned short*)(VT + c * 256 + chunk * 16 + (q & 7) * 2) = (unsigned short)pk;
                }
            }
        }
        __syncthreads();
        f32x4 acc[2][8];
#pragma unroll
        for (int ct = 0; ct < 2; ++ct)
#pragma unroll
            for (int pt = 0; pt < 8; ++pt) acc[ct][pt] = (f32x4){0.f, 0.f, 0.f, 0.f};
        const int l16 = lane & 15, l4 = lane >> 4;
#pragma unroll
        for (int ks = 0; ks < 4; ++ks) {
            bf16x8 af[2], bfr[8];
#pragma unroll
            for (int ct = 0; ct < 2; ++ct) { const int c = wave * 32 + ct * 16 + l16, chunk = (4 * ks + l4) ^ ((c >> 3) & 15) ^ (c & 7); af[ct] = *(const LAS bf16x8*)(VT + c * 256 + chunk * 16); }
#pragma unroll
            for (int pt = 0; pt < 8; ++pt) bfr[pt] = *(const LAS bf16x8*)(Aimg + (pt * 16 + l16) * APITCH + (32 * ks + 8 * l4) * 2);
#pragma unroll
            for (int ct = 0; ct < 2; ++ct)
#pragma unroll
                for (int pt = 0; pt < 8; ++pt) acc[ct][pt] = __builtin_amdgcn_mfma_f32_16x16x32_bf16(af[ct], bfr[pt], acc[ct][pt], 0, 0, 0);
        }
#pragma unroll
        for (int pt = 0; pt < 8; ++pt) {
            const int p = pt * 16 + l16; const float bsv = bsf[g * 128 + p];
#pragma unroll
            for (int ct = 0; ct < 2; ++ct) {
                const int c = g * 256 + wave * 32 + ct * 16 + 4 * l4;
                const u32x2 uu = *(const u32x2*)(Z + (rowb + p) * 2048 + c);
                const float u0 = __uint_as_float(uu.x << 16), u1 = __uint_as_float(uu.x & 0xffff0000u), u2 = __uint_as_float(uu.y << 16), u3 = __uint_as_float(uu.y & 0xffff0000u);
                const f32x4 s = acc[ct][pt] + bsv;
                u32x2 w; w.x = cvt_pk_bf16(u0 * s[0], u1 * s[1]); w.y = cvt_pk_bf16(u2 * s[2], u3 * s[3]);
                *(u32x2*)(T1 + (rowb + p) * D + c) = w;
            }
        }
    }
}

constexpr int ATT_BUF = 36864;
__device__ __forceinline__ int sig23(int r) { return (r & ~12) | ((r & 4) << 1) | ((r & 8) >> 1); }

__device__ __forceinline__ void attn_issue(int st, int first_unit, int L, const bf16_t* Q, const bf16_t* Kall, const bf16_t* Vtall, u32x4 (&pre)[4], bf16x8 (&qpre)[4], int tid) {
    const int unit = first_unit + (st >> 3), chn = st & 7, pm = unit >> 2, h = unit & 3, b = pm >> 4;
    const int lane = tid & 63, wave = tid >> 6;
    if (chn < 4) {
#pragma unroll
        for (int i = 0; i < 4; ++i) { const int p = tid + 512 * i, rho = p >> 3, part = p & 7;
            pre[i] = *(const u32x4*)(Kall + (size_t)(b * 256 + sig23(rho)) * 4096 + L * 1024 + h * 256 + chn * 64 + part * 8); }
        const bf16_t* qp = Q + (size_t)(pm * 256 + wave * 32 + (lane & 31)) * D + h * 256 + chn * 64 + (lane >> 5) * 8;
#pragma unroll
        for (int ks = 0; ks < 4; ++ks) qpre[ks] = *(const bf16x8*)(qp + ks * 16);
    } else {
        const int vc = chn - 4;
#pragma unroll
        for (int i = 0; i < 4; ++i) { const int p = tid + 512 * i, r = p >> 5, part = p & 31;
            pre[i] = *(const u32x4*)(Vtall + (size_t)(L * 1024 + h * 256 + vc * 64 + r) * 4096 + b * 256 + part * 8); }
    }
}
__device__ __forceinline__ void attn_commit(int st, LAS unsigned char* lds, const u32x4 (&pre)[4], int tid) {
    LAS unsigned char* buf = lds + (st & 1) * ATT_BUF; const int chn = st & 7;
    if (chn < 4) {
#pragma unroll
        for (int i = 0; i < 4; ++i) { const int p = tid + 512 * i, rho = p >> 3, part = p & 7; *(LAS u32x4*)(buf + rho * 144 + part * 16) = pre[i]; }
    } else {
#pragma unroll
        for (int i = 0; i < 4; ++i) { const int p = tid + 512 * i, r = p >> 5, part = p & 31; *(LAS u32x4*)(buf + r * 528 + part * 16) = pre[i]; }
    }
}

__device__ __forceinline__ void attn_phase(LAS unsigned char* lds, const bf16_t* Q, const bf16_t* Kall, const bf16_t* Vtall, bf16_t* O, int L, int G) {
    int tid_ = threadIdx.x; asm volatile("" : "+v"(tid_));
    const int tid = tid_, lane = tid & 63, wave = __builtin_amdgcn_readfirstlane(tid >> 6), l32 = lane & 31, half = lane >> 5;
    const int bx = blockIdx.x, vcu = (G % 8 == 0) ? (bx % 8) * (G / 8) + bx / 8 : bx;
    const int nper = (1024 + G - 1) / G, first_unit = vcu * nper;
    int nunits = 1024 - first_unit; if (nunits > nper) nunits = nper; if (nunits <= 0) return;
    const int nsteps = nunits * 8;
    u32x4 pre[4]; bf16x8 qpre[4], qcur[4];
    __syncthreads();
    attn_issue(0, first_unit, L, Q, Kall, Vtall, pre, qpre, tid);
    attn_commit(0, lds, pre, tid);
#pragma unroll
    for (int ks = 0; ks < 4; ++ks) qcur[ks] = qpre[ks];
    __syncthreads();
    int st = 0;
    for (int ui = 0; ui < nunits; ++ui) {
        const int unit = first_unit + ui, pm = unit >> 2, h = unit & 3;
        f32x16 S[8];
#pragma unroll
        for (int mt = 0; mt < 8; ++mt)
#pragma unroll
            for (int i = 0; i < 16; ++i) S[mt][i] = 0.f;
        for (int kc = 0; kc < 4; ++kc, ++st) {
            if (st + 1 < nsteps) attn_issue(st + 1, first_unit, L, Q, Kall, Vtall, pre, qpre, tid);
            const LAS unsigned char* buf = lds + (st & 1) * ATT_BUF;
#pragma unroll
            for (int ks = 0; ks < 4; ++ks)
#pragma unroll
                for (int mt = 0; mt < 8; ++mt) {
                    const bf16x8 kf = *(const LAS bf16x8*)(buf + (32 * mt + l32) * 144 + ks * 32 + half * 16);
                    S[mt] = __builtin_amdgcn_mfma_f32_32x32x16_bf16(kf, qcur[ks], S[mt], 0, 0, 0);
                }
            if (st + 1 < nsteps) attn_commit(st + 1, lds, pre, tid);
#pragma unroll
            for (int ks = 0; ks < 4; ++ks) qcur[ks] = qpre[ks];
            __syncthreads();
        }
        float mx = -3.0e38f;
#pragma unroll
        for (int mt = 0; mt < 8; ++mt)
#pragma unroll
            for (int i = 0; i < 16; ++i) mx = fmaxf(mx, S[mt][i]);
        mx = fmaxf(mx, __shfl_xor(mx, 32));
        float lsum = 0.f;
        bf16x8 pf[8][2];
#pragma unroll
        for (int mt = 0; mt < 8; ++mt) {
#pragma unroll
            for (int i = 0; i < 16; ++i) { const float p = __builtin_amdgcn_exp2f(S[mt][i] - mx); S[mt][i] = p; lsum += p; }
#pragma unroll
            for (int s2 = 0; s2 < 2; ++s2) { u32x4 w; w.x = cvt_pk_bf16(S[mt][8 * s2 + 0], S[mt][8 * s2 + 1]); w.y = cvt_pk_bf16(S[mt][8 * s2 + 2], S[mt][8 * s2 + 3]);
                w.z = cvt_pk_bf16(S[mt][8 * s2 + 4], S[mt][8 * s2 + 5]); w.w = cvt_pk_bf16(S[mt][8 * s2 + 6], S[mt][8 * s2 + 7]); pf[mt][s2] = __builtin_bit_cast(bf16x8, w); }
        }
        lsum += __shfl_xor(lsum, 32);
        const float inv = 1.0f / lsum;
        bf16_t* orow = O + (size_t)(pm * 256 + wave * 32 + l32) * D + h * 256;
        for (int vc = 0; vc < 4; ++vc, ++st) {
            if (st + 1 < nsteps) attn_issue(st + 1, first_unit, L, Q, Kall, Vtall, pre, qpre, tid);
            const LAS unsigned char* buf = lds + (st & 1) * ATT_BUF;
            f32x16 o[2];
#pragma unroll
            for (int ht = 0; ht < 2; ++ht)
#pragma unroll
                for (int i = 0; i < 16; ++i) o[ht][i] = 0.f;
#pragma unroll
            for (int mt = 0; mt < 8; ++mt)
#pragma unroll
                for (int s2 = 0; s2 < 2; ++s2)
#pragma unroll
                    for (int ht = 0; ht < 2; ++ht) {
                        const bf16x8 vf = *(const LAS bf16x8*)(buf + (32 * ht + l32) * 528 + (32 * mt + 16 * s2 + 8 * half) * 2);
                        o[ht] = __builtin_amdgcn_mfma_f32_32x32x16_bf16(vf, pf[mt][s2], o[ht], 0, 0, 0);
                    }
#pragma unroll
            for (int ht = 0; ht < 2; ++ht)
#pragma unroll
                for (int i4 = 0; i4 < 4; ++i4) {
                    u32x2 w; w.x = cvt_pk_bf16(o[ht][4 * i4 + 0] * inv, o[ht][4 * i4 + 1] * inv); w.y = cvt_pk_bf16(o[ht][4 * i4 + 2] * inv, o[ht][4 * i4 + 3] * inv);
                    *(u32x2*)(orow + vc * 64 + ht * 32 + i4 * 8 + half * 4) = w;
                }
            if (st + 1 < nsteps) attn_commit(st + 1, lds, pre, tid);
#pragma unroll
            for (int ks = 0; ks < 4; ++ks) qcur[ks] = qpre[ks];
            __syncthreads();
        }
    }
}

__device__ __forceinline__ void final_norm_phase(float* x, const float* gain, int G) {
    int tid_ = threadIdx.x; asm volatile("" : "+v"(tid_));
    const int tid = tid_, lane = tid & 63, wave = tid >> 6, gw = blockIdx.x * 8 + wave, NGW = G * 8;
    f32x4 gv[4];
#pragma unroll
    for (int j = 0; j < 4; ++j) gv[j] = ((const f32x4*)gain)[lane + 64 * j];
    for (int r = gw; r < M; r += NGW) {
        f32x4* xr = (f32x4*)(x + (size_t)r * D) + lane; f32x4 v[4]; float s = 0.f;
#pragma unroll
        for (int j = 0; j < 4; ++j) { v[j] = xr[64 * j]; s += (v[j][0] * v[j][0] + v[j][1] * v[j][1]) + (v[j][2] * v[j][2] + v[j][3] * v[j][3]); }
        s = wave_sum(s);
        const float rs = 1.0f / sqrtf(s * (1.0f / D) + EPS);
#pragma unroll
        for (int j = 0; j < 4; ++j) xr[64 * j] = v[j] * rs * gv[j];
    }
}


#define XB_TMO      128
#define XB_XCNT(j)  (256  + 64 * (j))
#define XB_XSUB(j)  (1280 + 64 * (j))
#define XB_XGEN(j)  (2304 + 64 * (j))
#define XB_TOP      3328
#define XB_TOPGEN   3392
#define XCD_BAR_WORDS 3456
#define XB_SPIN_CAP (1u << 20)
__device__ __forceinline__ unsigned xb_ld(unsigned* p)              { return __hip_atomic_load(p, __ATOMIC_RELAXED, __HIP_MEMORY_SCOPE_AGENT); }
__device__ __forceinline__ unsigned xb_add(unsigned* p, unsigned v) { return __hip_atomic_fetch_add(p, v, __ATOMIC_RELAXED, __HIP_MEMORY_SCOPE_AGENT); }
__device__ __forceinline__ unsigned xb_xcc_id() { return (unsigned)__builtin_amdgcn_s_getreg((3 << 11) | 20) & 0xFu; }
#define XB_SPIN(cond, bar) do { unsigned _sp = 0; while (cond) { __builtin_amdgcn_s_sleep(1); \
    if ((++_sp & 255u) == 0u) { if (xb_ld(&(bar)[XB_TMO])) break; if (_sp > XB_SPIN_CAP) { atomicAdd(&(bar)[XB_TMO], 1u); break; } } } } while (0)
struct XcdBarrier { unsigned* bar; unsigned x; volatile LAS unsigned* st; };
__device__ __forceinline__ XcdBarrier xcd_barrier_post(unsigned* bar, volatile LAS unsigned* st) {
    XcdBarrier b; b.bar = bar; b.x = xb_xcc_id(); b.st = st;
    if (threadIdx.x == 0) (void)xb_add(&bar[XB_XCNT(b.x)], 1u);
    return b;
}
__device__ __forceinline__ void xcd_barrier_complete(unsigned* bar, unsigned x, unsigned& nloc, unsigned& nx) {
    const unsigned G = gridDim.x * gridDim.y * gridDim.z;
    unsigned sum, cnt, mine, sp = 0u;
    for (;;) {
        sum = 0u; cnt = 0u; mine = 0u;
#pragma unroll
        for (unsigned j = 0; j < 16; ++j) { const unsigned c = xb_ld(&bar[XB_XCNT(j)]); sum += c; cnt += (c > 0u) ? 1u : 0u; mine = (j == x) ? c : mine; }
        if (sum == G) break;
        __builtin_amdgcn_s_sleep(1);
        if ((++sp & 255u) == 0u) { if (xb_ld(&bar[XB_TMO])) break; if (sp > XB_SPIN_CAP) { atomicAdd(&bar[XB_TMO], 1u); break; } }
    }
    nloc = mine > 0u ? mine : 1u; nx = cnt > 0u ? cnt : 1u;
}
__device__ __forceinline__ void xcd_barrier(const XcdBarrier& b) {
    asm volatile("s_waitcnt vmcnt(0)" ::: "memory");
    __syncthreads();
    if (threadIdx.x == 0) {
        unsigned* bar = b.bar;
        __builtin_amdgcn_s_waitcnt(0);
        unsigned nloc = b.st[0], nx = b.st[1];
        if (nloc == 0u) { xcd_barrier_complete(bar, b.x, nloc, nx); b.st[0] = nloc; b.st[1] = nx; }
        const unsigned old = xb_add(&bar[XB_XSUB(b.x)], 1u);
        const unsigned gen = old / nloc;
        if (old + 1u == (gen + 1u) * nloc) {
            __builtin_amdgcn_fence(__ATOMIC_RELEASE, "agent");
            asm volatile("s_waitcnt vmcnt(0)" ::: "memory");
            const unsigned og = xb_add(&bar[XB_TOP], 1u);
            const unsigned tg = og / nx;
            if (og + 1u == (tg + 1u) * nx) xb_add(&bar[XB_TOPGEN], 1u);
            else XB_SPIN(xb_ld(&bar[XB_TOPGEN]) == tg, bar);
            __builtin_amdgcn_fence(__ATOMIC_ACQUIRE, "agent");
            xb_add(&bar[XB_XGEN(b.x)], 1u);
            asm volatile("s_waitcnt vmcnt(0)" ::: "memory");
        } else {
            XB_SPIN(xb_ld(&bar[XB_XGEN(b.x)]) == gen, bar);
            __builtin_amdgcn_fence(__ATOMIC_ACQUIRE, "agent");
            asm volatile("s_waitcnt vmcnt(0)" ::: "memory");
        }
    }
    __syncthreads();
}

constexpr int NPHASES = 35;
__host__ __device__ inline bool phase_empty(int ph) { if (ph < 2 || ph >= 34) return false; const int L = (ph - 2) >> 3, k = (ph - 2) & 7; return k == 2 && (L & 1) == 0; }

__global__ void __launch_bounds__(512, 2) fwd_megakernel(Params P) {
    extern __shared__ __attribute__((aligned(16))) unsigned char lds_raw[];
    LAS unsigned char* lds = (LAS unsigned char*)lds_raw;
    cg::grid_group grid = cg::this_grid();
    const int G = gridDim.x;
    unsigned char* ws = P.ws;
    bf16_t* T1 = (bf16_t*)(ws + WS_T1); bf16_t* OB = (bf16_t*)(ws + WS_O); bf16_t* ZB = (bf16_t*)(ws + WS_Z); bf16_t* HB = (bf16_t*)(ws + WS_H);
    bf16_t* XB = (bf16_t*)(ws + WS_XB); bf16_t* KALL = (bf16_t*)(ws + WS_KALL); bf16_t* VTALL = (bf16_t*)(ws + WS_VTALL); bf16_t* MEMB = (bf16_t*)(ws + WS_MEMB);
    float* SSQ[2] = {(float*)(ws + WS_SSQ0), (float*)(ws + WS_SSQ1)};
    float* VSTAT = (float*)(ws + WS_VSTAT); float* RSTDMEM = (float*)(ws + WS_RSTDMEM);
    float* X = P.out;
    volatile LAS unsigned* MISC = (volatile LAS unsigned*)(lds + 131072 + 320);
    if (threadIdx.x < 32) MISC[threadIdx.x] = 0u;
    __syncthreads();
    XcdBarrier bar; bar.bar = (unsigned*)(ws + WS_CTL); bar.x = 0; bar.st = MISC + 8;
    if (P.ph_hi - P.ph_lo > 1) bar = xcd_barrier_post((unsigned*)(ws + WS_CTL), MISC + 8);

    for (int ph = P.ph_lo; ph < P.ph_hi; ++ph) {
        if (phase_empty(ph)) continue;
        if (ph == 0) {
            prologue_phase(P, lds, G);
        } else if (ph == 1) {
            pg8::StaticOrder S; S.init(MR, 4096, G, (int)blockIdx.x);
            { pg8::Gemm g{MEMB, (const bf16_t*)(ws + WS_WK), MR, 4096, D, D, D, 0}; pg8::EpiAct<4> E{KALL, 4096, nullptr, 1.f, RSTDMEM, nullptr}; pg8::gemm_phase(lds, g, S, E); }
            { pg8::Gemm g{(const bf16_t*)(ws + WS_WV), MEMB, 4096, MR, D, D, D, 0}; pg8::EpiAct<3> E{VTALL, 4096, nullptr, 1.f, RSTDMEM, nullptr}; pg8::gemm_phase(lds, g, S, E); }
        } else if (ph == 34) {
            final_norm_phase(X, P.in[I_G_FINAL], G);
        } else {
            const int L = (ph - 2) >> 3, k = (ph - 2) & 7, j = L >> 1; const bool odd = (L & 1) != 0;
            if (k == 0) {
                const float* ssq_r = SSQ[(3 * L) & 1];
                if (!odd) { pool_a_phase(lds, (L == 0) ? P.in[I_X] : X, ssq_r, T1, G); }
                else { pg8::Gemm g{XB, (const bf16_t*)(ws + WS_WIN) + (size_t)j * D * 2 * D, M, 2 * D, D, D, D, 0}; pg8::StaticOrder S; S.init(M, 2 * D, G, (int)blockIdx.x);
                    pg8::EpiAct<2> E{ZB, 2 * D, ssq_r, 1.f, nullptr, VSTAT}; pg8::gemm_phase(lds, g, S, E); }
            } else if (k == 1 && odd) {
                sgu_spatial_phase(lds, ZB, VSTAT, P.in[I_SGU_WS] + (size_t)j * 4 * 128 * 128, P.in[I_SGU_BS] + j * 512, P.in[I_SGU_LNG] + j * D, P.in[I_SGU_LNB] + j * D, T1, G);
            } else if (k == 3) {
                pg8::Gemm g{XB, (const bf16_t*)(ws + WS_WQ) + (size_t)L * D * D, M, D, D, D, D, 0}; pg8::StaticOrder S; S.init(M, D, G, (int)blockIdx.x);
                pg8::EpiAct<0> E{T1, D, SSQ[(3 * L + 1) & 1], QSCALE, nullptr, nullptr}; pg8::gemm_phase(lds, g, S, E);
            } else if (k == 4) {
                attn_phase(lds, T1, KALL, VTALL, OB, L, G);
            } else if (k == 6) {
                pg8::Gemm g{XB, (const bf16_t*)(ws + WS_W1) + (size_t)L * D * FF, M, FF, D, D, D, 0}; pg8::StaticOrder S; S.init(M, FF, G, (int)blockIdx.x);
                pg8::EpiAct<1> E{HB, FF, SSQ[(3 * L + 2) & 1], 1.f, nullptr, nullptr}; pg8::gemm_phase(lds, g, S, E);
            } else {
                pg8::Gemm g; const float* xin = X; int upd;
                if (k == 1)      { g = pg8::Gemm{T1, (const bf16_t*)(ws + WS_PW) + (size_t)j * 4 * 256 * 256, M, D, 256, D, 256, 256}; upd = 3 * L; if (L == 0) xin = P.in[I_X]; }
                else if (k == 2) { g = pg8::Gemm{T1, (const bf16_t*)(ws + WS_WOUT) + (size_t)j * D * D, M, D, D, D, D, 0}; upd = 3 * L; }
                else if (k == 5) { g = pg8::Gemm{OB, (const bf16_t*)(ws + WS_WO) + (size_t)L * D * D, M, D, D, D, D, 0}; upd = 3 * L + 1; }
                else             { g = pg8::Gemm{HB, (const bf16_t*)(ws + WS_W2) + (size_t)L * D * FF, M, D, FF, FF, FF, 0}; upd = 3 * L + 2; }
                pg8::StaticOrder S; S.init(M, D, G, (int)blockIdx.x);
                pg8::EpiResid E{xin, X, XB, SSQ[(upd + 1) & 1]}; pg8::gemm_phase(lds, g, S, E);
            }
        }
        if (ph + 1 < P.ph_hi) { if (ph == 0) grid.sync(); else xcd_barrier(bar); }
    }
}

extern "C" void kernel_launch(void* const* d_in, const int* in_sizes, int n_in, void* d_out, int out_size, void* d_ws, size_t ws_size, hipStream_t stream) {
    static int grid = 0;
    if (grid == 0) {
        if (n_in != 20 || in_sizes[0] != M * D || out_size != M * D || ws_size < WS_END) { fprintf(stderr, "kernel_launch: unexpected shapes (n_in %d, in0 %d, out %d, ws %zu); nothing launched\n", n_in, n_in > 0 ? in_sizes[0] : -1, out_size, ws_size); grid = -1; return; }
        int dev = 0, cus = 0, per_cu = 0;
        if (hipGetDevice(&dev) != hipSuccess || hipDeviceGetAttribute(&cus, hipDeviceAttributeMultiprocessorCount, dev) != hipSuccess) { grid = -1; return; }
        if (hipFuncSetAttribute((const void*)fwd_megakernel, hipFuncAttributeMaxDynamicSharedMemorySize, LDS_BYTES) != hipSuccess) { fprintf(stderr, "kernel_launch: hipFuncSetAttribute failed\n"); grid = -1; return; }
        if (hipOccupancyMaxActiveBlocksPerMultiprocessor(&per_cu, (const void*)fwd_megakernel, 512, LDS_BYTES) != hipSuccess || per_cu < 1) { fprintf(stderr, "kernel_launch: occupancy query gave %d\n", per_cu); per_cu = 1; }
        (void)hipGetLastError();
        grid = cus * per_cu;
        if (grid > 256) grid = 256;
        grid &= ~7;
        if (grid < 8) { grid = -1; return; }
    }
    if (grid < 0) return;
    Params p{};
    for (int i = 0; i < 20; ++i) p.in[i] = (const float*)d_in[i];
    p.out = (float*)d_out; p.ws = (unsigned char*)d_ws;
#if MK_SINGLE
    p.ph_lo = 0; p.ph_hi = NPHASES;
    if (hipMemsetAsync((char*)d_ws + WS_CTL, 0, CTL_BYTES, stream) != hipSuccess) { fprintf(stderr, "kernel_launch: memset failed\n"); return; }
    void* args[] = {&p};
    hipError_t e = hipLaunchCooperativeKernel((const void*)fwd_megakernel, dim3(grid), dim3(512), args, LDS_BYTES, stream);
    if (e != hipSuccess) fprintf(stderr, "kernel_launch: cooperative launch failed: %s (grid %d)\n", hipGetErrorString(e), grid);
#else
    for (int ph = 0; ph < NPHASES; ++ph) {
        if (phase_empty(ph)) continue;
        p.ph_lo = ph; p.ph_hi = ph + 1;
        hipLaunchKernelGGL(fwd_megakernel, dim3(grid), dim3(512), LDS_BYTES, stream, p);
    }
#endif
}
```

```cpp
#include <hip/hip_runtime.h>
#include <hip/hip_cooperative_groups.h>
#include <cstdio>
#include <cstdint>
namespace cg = cooperative_groups;

#ifndef MK_SINGLE
#define MK_SINGLE 1
#endif

#define LAS __attribute__((address_space(3)))
typedef unsigned short bf16_t;
typedef short bf16x8 __attribute__((ext_vector_type(8)));
typedef float f32x4 __attribute__((ext_vector_type(4)));
typedef float f32x2 __attribute__((ext_vector_type(2)));
typedef float f32x16 __attribute__((ext_vector_type(16)));
typedef unsigned u32x4 __attribute__((ext_vector_type(4)));
typedef unsigned u32x2 __attribute__((ext_vector_type(2)));

constexpr int D = 1024, BATCH = 16, SEQ = 4096, DEPTH = 4, FF = 4096, NMEM = 256;
constexpr int M = BATCH * SEQ;
constexpr int MR = BATCH * NMEM;
constexpr float EPS = 1e-6f;
constexpr float QSCALE = 0.0625f * 1.4426950408889634f;

constexpr size_t MiB = 1u << 20;
constexpr size_t WS_H = 0, WS_T1 = 0, WS_O = 128 * MiB, WS_Z = 256 * MiB;
constexpr size_t WS_XB = 512 * MiB;
constexpr size_t WS_KALL = 640 * MiB, WS_VTALL = 672 * MiB, WS_MEMB = 704 * MiB;
constexpr size_t WS_SSQ0 = 712 * MiB, WS_SSQ1 = 716 * MiB, WS_VSTAT = 720 * MiB, WS_RSTDMEM = 728 * MiB;
constexpr size_t WS_CTL = 730 * MiB, CTL_BYTES = 16384;
constexpr size_t WS_WQ = 736 * MiB, WS_WO = 744 * MiB, WS_W1 = 752 * MiB, WS_W2 = 784 * MiB, WS_WK = 816 * MiB, WS_WV = 824 * MiB;
constexpr size_t WS_WIN = 832 * MiB, WS_WOUT = 840 * MiB, WS_PW = 844 * MiB, WS_END = 845 * MiB;

constexpr int LDS_BYTES = 147456;

struct Params {
    const float* in[20];
    float* out;
    unsigned char* ws;
    int ph_lo, ph_hi;
};

__device__ __forceinline__ unsigned cvt_pk_bf16(float lo, float hi) { unsigned r; asm volatile("v_cvt_pk_bf16_f32 %0, %1, %2" : "=v"(r) : "v"(lo), "v"(hi)); return r; }
__device__ __forceinline__ float wave_sum(float v) {
#pragma unroll
    for (int o = 1; o < 64; o <<= 1) v += __shfl_xor(v, o);
    return v;
}
__device__ __forceinline__ float gelu_tanh(float x) {
    const float y = 0.7978845608028654f * (x + 0.044715f * x * x * x);
    const float e = __builtin_amdgcn_exp2f(-2.0f * 1.4426950408889634f * y);
    return x * __builtin_amdgcn_rcpf(1.0f + e);
}

namespace pg8 {
constexpr int BM = 256, BK = 64, HALF = 128, HTB = HALF * BK * 2, STAGE_BYTES = 8 * HTB, NXCD = 8, WGM = 8;
__host__ __device__ __forceinline__ int lds_byte(int r, int c) { const int st = (r >> 4) * 2 + (c >> 5), rr = r & 15, cc = c & 31, ob = rr * 64 + cc * 2; return st * 1024 + (ob ^ (((ob >> 9) & 1) << 5)); }
__host__ __device__ __forceinline__ void stage_rc(int b, int& R, int& C) { const int st = b / 1024, sb = b % 1024, swz = sb ^ (((sb >> 9) & 1) << 5); R = (st >> 1) * 16 + swz / 64; C = (st & 1) * 32 + (swz % 64) / 2; }
__host__ __device__ __forceinline__ int perm32(int rho) { const int n = rho >> 4, i = rho & 15; return 8 * (i >> 2) + 4 * n + (i & 3); }

struct Unit { int pm, pn; };
struct Gemm { const bf16_t* A; const bf16_t* Bt; int M, N, K, lda, ldb, acol; };

struct StaticOrder {
    int nM, nN, nwg, G, c;
    __device__ void init(int M_, int N_, int G_, int c_) { nM = M_ / BM; nN = N_ / BM; nwg = nM * nN; G = G_; c = c_; }
    __device__ bool next(int i, Unit& u) const {
        const long L = (long)i * G + c; if (L >= nwg) return false;
        int wgid = (int)L; { const int q = nwg / NXCD, r = nwg % NXCD, xcd = wgid % NXCD, off = wgid / NXCD; wgid = (xcd < r ? xcd * (q + 1) : r * (q + 1) + (xcd - r) * q) + off; }
        const int nig = WGM * nN, gid = wgid / nig, fm = gid * WGM, gsz = (nM - fm) < WGM ? (nM - fm) : WGM;
        u.pm = fm + ((wgid % nig) % gsz); u.pn = (wgid % nig) / gsz; return true;
    }
};

__device__ __forceinline__ float rstd_from_slots(const float* ssq, int row, int fq) {
    const f32x4 v = *(const f32x4*)(ssq + (size_t)row * 16 + fq * 4);
    float s = (v[0] + v[1]) + (v[2] + v[3]);
    s += __shfl_xor(s, 16); s += __shfl_xor(s, 32);
    return __builtin_amdgcn_rsqf(s * (1.0f / 1024.0f) + EPS);
}

template <int MODE> struct EpiAct {
    bf16_t* O; int ldc; const float* ssq; float scale; const float* rvec; float* vstat;
    __device__ __forceinline__ void operator()(const f32x4 (&acc)[2][2][4][2], const Unit& u, int wr, int wc, int fr, int fq) const {
        const int row0 = u.pm * BM + wr * 64 + fr, col0 = u.pn * BM + wc * 32 + 8 * fq;
        f32x4 cs[2][2];
        if (MODE == 3) {
#pragma unroll
            for (int bj = 0; bj < 2; ++bj) { cs[bj][0] = *(const f32x4*)(rvec + col0 + bj * HALF); cs[bj][1] = *(const f32x4*)(rvec + col0 + bj * HALF + 4); }
        }
#pragma unroll
        for (int ai = 0; ai < 2; ++ai)
#pragma unroll
            for (int m = 0; m < 4; ++m) {
                const int row = row0 + ai * HALF + m * 16;
                float rs = 1.f;
                if (MODE == 0 || MODE == 1 || MODE == 2) rs = rstd_from_slots(ssq, row, fq);
                if (MODE == 0) rs *= scale;
                if (MODE == 4) rs = rvec[row];
                bf16_t* rowp = O + (size_t)row * ldc + col0;
                float s1 = 0.f, s2 = 0.f;
#pragma unroll
                for (int bj = 0; bj < 2; ++bj) {
                    f32x4 v0 = acc[ai][bj][m][0] * rs, v1 = acc[ai][bj][m][1] * rs;
                    if (MODE == 3) { v0 = acc[ai][bj][m][0] * cs[bj][0]; v1 = acc[ai][bj][m][1] * cs[bj][1]; }
                    if (MODE == 1) {
#pragma unroll
                        for (int j = 0; j < 4; ++j) { const float a = v0[j] > 0.f ? v0[j] : 0.f, b = v1[j] > 0.f ? v1[j] : 0.f; v0[j] = a * a; v1[j] = b * b; }
                    }
                    if (MODE == 2) {
#pragma unroll
                        for (int j = 0; j < 4; ++j) { v0[j] = gelu_tanh(v0[j]); v1[j] = gelu_tanh(v1[j]); }
#pragma unroll
                        for (int j = 0; j < 4; ++j) { s1 += v0[j] + v1[j]; s2 += v0[j] * v0[j] + v1[j] * v1[j]; }
                    }
                    u32x4 w; w.x = cvt_pk_bf16(v0[0], v0[1]); w.y = cvt_pk_bf16(v0[2], v0[3]); w.z = cvt_pk_bf16(v1[0], v1[1]); w.w = cvt_pk_bf16(v1[2], v1[3]);
                    *(u32x4*)(rowp + bj * HALF) = w;
                }
                if (MODE == 2) {
                    s1 += __shfl_xor(s1, 16); s1 += __shfl_xor(s1, 32); s2 += __shfl_xor(s2, 16); s2 += __shfl_xor(s2, 32);
                    if (u.pn >= 4 && fq == 0) { vstat[(size_t)row * 32 + (u.pn - 4) * 4 + wc] = s1; vstat[(size_t)row * 32 + 16 + (u.pn - 4) * 4 + wc] = s2; }
                }
            }
    }
};
template <bool F32IN> struct EpiResid {
    const float* xin; bf16_t* xb; float* ssq;
    __device__ __forceinline__ void operator()(const f32x4 (&acc)[2][2][4][2], const Unit& u, int wr, int wc, int fr, int fq) const {
        const int row0 = u.pm * BM + wr * 64 + fr, col0 = u.pn * BM + wc * 32 + 8 * fq;
#pragma unroll
        for (int ai = 0; ai < 2; ++ai)
#pragma unroll
            for (int m = 0; m < 4; ++m) {
                const int row = row0 + ai * HALF + m * 16; const size_t off = (size_t)row * D + col0;
                float ss = 0.f;
#pragma unroll
                for (int bj = 0; bj < 2; ++bj) {
                    f32x4 a0, a1;
                    if (F32IN) { a0 = *(const f32x4*)(xin + off + bj * HALF); a1 = *(const f32x4*)(xin + off + bj * HALF + 4); }
                    else { const u32x4 r = *(const u32x4*)(xb + off + bj * HALF);
                        a0 = (f32x4){__uint_as_float(r.x << 16), __uint_as_float(r.x & 0xffff0000u), __uint_as_float(r.y << 16), __uint_as_float(r.y & 0xffff0000u)};
                        a1 = (f32x4){__uint_as_float(r.z << 16), __uint_as_float(r.z & 0xffff0000u), __uint_as_float(r.w << 16), __uint_as_float(r.w & 0xffff0000u)}; }
                    const f32x4 v0 = a0 + acc[ai][bj][m][0], v1 = a1 + acc[ai][bj][m][1];
                    u32x4 w; w.x = cvt_pk_bf16(v0[0], v0[1]); w.y = cvt_pk_bf16(v0[2], v0[3]); w.z = cvt_pk_bf16(v1[0], v1[1]); w.w = cvt_pk_bf16(v1[2], v1[3]);
                    *(u32x4*)(xb + off + bj * HALF) = w;
                    const unsigned ww[4] = {w.x, w.y, w.z, w.w};
#pragma unroll
                    for (int j = 0; j < 4; ++j) { const float lo = __uint_as_float(ww[j] << 16), hi = __uint_as_float(ww[j] & 0xffff0000u); ss += lo * lo + hi * hi; }
                }
                ss += __shfl_xor(ss, 16); ss += __shfl_xor(ss, 32);
                if (fq == 0) ssq[(size_t)row * 16 + u.pn * 4 + wc] = ss;
                asm volatile("" ::: "memory");
            }
    }
};

template <class Epi>
__device__ __forceinline__ void gemm_phase(LAS unsigned char* lds, const Gemm g, const StaticOrder& S, const Epi& E) {
    int tid_ = threadIdx.x; asm volatile("" : "+v"(tid_));
    const int tid = tid_, wid = __builtin_amdgcn_readfirstlane(tid >> 6), lane = tid & 63, wr = wid >> 2, wc = wid & 3, fr = lane & 15, fq = lane >> 4;
    const int nt = g.K / BK;
    unsigned voffA[2], voffB[2];
#pragma unroll
    for (int i = 0; i < 2; ++i) { int R, C; stage_rc(tid * 16 + i * 8192, R, C); const int Rb = (R & ~31) + perm32(R & 31);
        voffA[i] = (unsigned)(R * g.lda + C) * 2u; voffB[i] = (unsigned)(Rb * g.ldb + C) * 2u; }
    const size_t kstep = (size_t)(BK * 2);
    const size_t hstepA = (size_t)HALF * g.lda * 2, hstepB = (size_t)HALF * g.ldb * 2;
    const size_t tstepA = 2 * hstepA, tstepB = 2 * hstepB, cstepA = (size_t)g.acol * 2;
    const unsigned ldsw = (unsigned)wid * 1024u;
    const int aoff = lds_byte(wr * 64 + fr, fq * 8), boff = lds_byte(wc * 32 + fr, fq * 8);
#define PG8_SA(b, h) (((b) * 2 + (h)) * HTB)
#define PG8_SB(b, h) ((4 + (b) * 2 + (h)) * HTB)
#define PG8_STAGE(bufoff, gbase, voff) do { _Pragma("unroll") for (int _i = 0; _i < 2; ++_i) \
        __builtin_amdgcn_global_load_lds((const unsigned*)((const char*)(gbase) + (voff)[_i]), (LAS unsigned*)(lds + (bufoff) + ldsw + _i * 8192), 16, 0, 0); } while (0)
#define PG8_LDA(dst, b, h) do { _Pragma("unroll") for (int m = 0; m < 4; ++m) _Pragma("unroll") for (int k = 0; k < 2; ++k) dst[m][k] = *(const LAS bf16x8*)(lds + PG8_SA(b, h) + aoff + m * 2048 + k * 1024); } while (0)
#define PG8_LDB(dst, b, h) do { _Pragma("unroll") for (int n = 0; n < 2; ++n) _Pragma("unroll") for (int k = 0; k < 2; ++k) dst[n][k] = *(const LAS bf16x8*)(lds + PG8_SB(b, h) + boff + n * 2048 + k * 1024); } while (0)
#define PG8_MMA(ai, bj, At, Bt) do { __builtin_amdgcn_s_setprio(1); _Pragma("unroll") for (int m = 0; m < 4; ++m) _Pragma("unroll") for (int n = 0; n < 2; ++n) _Pragma("unroll") for (int k = 0; k < 2; ++k) \
        acc[ai][bj][m][n] = __builtin_amdgcn_mfma_f32_16x16x32_bf16(Bt[n][k], At[m][k], acc[ai][bj][m][n], 0, 0, 0); __builtin_amdgcn_s_setprio(0); } while (0)
#define PG8_WAIT_V(n) asm volatile("s_waitcnt vmcnt(" #n ")" ::: "memory")
#define PG8_WAIT_L(n) asm volatile("s_waitcnt lgkmcnt(" #n ")" ::: "memory")
#define PG8_BAR __builtin_amdgcn_s_barrier()
#define PG8_SCHED __builtin_amdgcn_sched_barrier(0)
    Unit cur, nxt; int ui = 0;
    if (!S.next(0, cur)) return;
    f32x4 acc[2][2][4][2];
#pragma unroll
    for (int a = 0; a < 2; ++a)
#pragma unroll
        for (int b = 0; b < 2; ++b)
#pragma unroll
            for (int m = 0; m < 4; ++m)
#pragma unroll
                for (int n = 0; n < 2; ++n) acc[a][b][m][n] = (f32x4){0.f, 0.f, 0.f, 0.f};
    bf16x8 At[4][2], B0[2][2], B1[2][2];
    const char* cA = (const char*)g.A + (size_t)cur.pm * tstepA + (size_t)cur.pn * cstepA; const char* cB = (const char*)g.Bt + (size_t)cur.pn * tstepB;
    PG8_STAGE(PG8_SB(0, 0), cB, voffB); PG8_STAGE(PG8_SB(0, 1), cB + hstepB, voffB); PG8_STAGE(PG8_SA(0, 0), cA, voffA); PG8_STAGE(PG8_SA(0, 1), cA + hstepA, voffA);
    if (wr == 1) PG8_BAR;
    PG8_WAIT_V(2); PG8_BAR;
    PG8_STAGE(PG8_SB(1, 0), cB + kstep, voffB); PG8_STAGE(PG8_SA(1, 0), cA + kstep, voffA); PG8_STAGE(PG8_SB(1, 1), cB + hstepB + kstep, voffB);
    PG8_WAIT_V(6); PG8_BAR;
    for (;;) {
        const bool has_next = S.next(ui + 1, nxt);
        const char* nA = has_next ? (const char*)g.A + (size_t)nxt.pm * tstepA + (size_t)nxt.pn * cstepA : cA; const char* nB = has_next ? (const char*)g.Bt + (size_t)nxt.pn * tstepB : cB;
        for (int t = 0; t < nt; t += 2) {
            const bool last = (t == nt - 2);
            const char* a1 = cA + (size_t)(t + 1) * kstep;
            const char* a2 = last ? nA : cA + (size_t)(t + 2) * kstep; const char* b2 = last ? nB : cB + (size_t)(t + 2) * kstep;
            const char* a3 = a2 + kstep; const char* b3 = b2 + kstep;
            PG8_LDB(B0, 0, 0); PG8_LDB(B1, 0, 1); PG8_SCHED; PG8_LDA(At, 0, 0); PG8_STAGE(PG8_SA(1, 1), a1 + hstepA, voffA);
            PG8_WAIT_V(8); PG8_WAIT_L(0); PG8_BAR; PG8_MMA(0, 0, At, B0); PG8_MMA(0, 1, At, B1); PG8_BAR; PG8_SCHED;
            PG8_LDA(At, 0, 1); PG8_STAGE(PG8_SB(0, 0), b2, voffB); PG8_STAGE(PG8_SB(0, 1), b2 + hstepB, voffB); PG8_STAGE(PG8_SA(0, 0), a2, voffA);
            PG8_WAIT_V(8); PG8_WAIT_L(0); PG8_BAR; PG8_MMA(1, 0, At, B0); PG8_MMA(1, 1, At, B1); PG8_BAR; PG8_SCHED;
            PG8_LDB(B0, 1, 0); PG8_LDB(B1, 1, 1); PG8_SCHED; PG8_LDA(At, 1, 0); PG8_STAGE(PG8_SA(0, 1), a2 + hstepA, voffA);
            PG8_WAIT_V(8); PG8_WAIT_L(0); PG8_BAR; PG8_MMA(0, 0, At, B0); PG8_MMA(0, 1, At, B1); PG8_BAR; PG8_SCHED;
            PG8_LDA(At, 1, 1); PG8_STAGE(PG8_SB(1, 0), b3, voffB); PG8_STAGE(PG8_SB(1, 1), b3 + hstepB, voffB); PG8_STAGE(PG8_SA(1, 0), a3, voffA);
            PG8_WAIT_V(8); PG8_WAIT_L(0); PG8_BAR; PG8_MMA(1, 0, At, B0); PG8_MMA(1, 1, At, B1); PG8_BAR; PG8_SCHED;
        }
        if (wr == 0) PG8_BAR;
        E(acc, cur, wr, wc, fr, fq);
        if (!has_next) break;
#pragma unroll
        for (int a = 0; a < 2; ++a)
#pragma unroll
            for (int b = 0; b < 2; ++b)
#pragma unroll
                for (int m = 0; m < 4; ++m)
#pragma unroll
                    for (int n = 0; n < 2; ++n) acc[a][b][m][n] = (f32x4){0.f, 0.f, 0.f, 0.f};
        cur = nxt; cA = nA; cB = nB; ++ui;
        if (wr == 1) PG8_BAR;
    }
    PG8_WAIT_V(0);
    PG8_BAR;
#undef PG8_SA
#undef PG8_SB
#undef PG8_STAGE
#undef PG8_LDA
#undef PG8_LDB
#undef PG8_MMA
#undef PG8_WAIT_V
#undef PG8_WAIT_L
#undef PG8_BAR
#undef PG8_SCHED
}
}

struct MatDesc { const float* src; int ldw, K, N; bf16_t* dst; int ldt; const float* ks; const float* ns; };

__device__ __forceinline__ void transpose_item(const MatDesc& d, LAS float* scr, int item, int lane) {
    const int nblk = d.N / 32, kb = item / nblk, nb = item % nblk, k0 = 64 * kb, n0 = 32 * nb;
    const float nsv = d.ns ? d.ns[n0 + (lane & 31)] : 1.f;
#pragma unroll 8
    for (int i = 0; i < 32; ++i) { const int kk = 2 * i + (lane >> 5); float v = d.src[(size_t)(k0 + kk) * d.ldw + n0 + (lane & 31)] * nsv; if (d.ks) v *= d.ks[k0 + kk]; scr[kk * 33 + (lane & 31)] = v; }
    asm volatile("s_waitcnt lgkmcnt(0)" ::: "memory");
    const int c = lane & 7;
#pragma unroll
    for (int j = 0; j < 4; ++j) { const int n = (lane >> 3) + 8 * j; const LAS float* s = scr + (8 * c) * 33 + n;
        u32x4 o; o.x = cvt_pk_bf16(s[0 * 33], s[1 * 33]); o.y = cvt_pk_bf16(s[2 * 33], s[3 * 33]); o.z = cvt_pk_bf16(s[4 * 33], s[5 * 33]); o.w = cvt_pk_bf16(s[6 * 33], s[7 * 33]);
        *(u32x4*)(d.dst + (size_t)(n0 + n) * d.ldt + k0 + 8 * c) = o; }
    asm volatile("s_waitcnt lgkmcnt(0)" ::: "memory");
}

enum { I_X = 0, I_MEM, I_G_MIX, I_G_MEM, I_G_MEMKV, I_G_FFN, I_G_FINAL, I_POOL_W, I_POOL_SCALE, I_SGU_WIN, I_SGU_LNG, I_SGU_LNB, I_SGU_WS, I_SGU_BS, I_SGU_WOUT, I_WQ, I_WKV, I_WO, I_W1, I_W2 };

__device__ __forceinline__ MatDesc get_mat(const Params& P, int id) {
    MatDesc d; d.ks = nullptr; d.ns = nullptr;
    unsigned char* ws = P.ws;
    if (id < 24) {
        const int L = id / 6, t = id % 6;
        if (t == 0)      { d.src = P.in[I_WQ] + (size_t)L * D * D; d.ldw = D; d.K = D; d.N = D; d.dst = (bf16_t*)(ws + WS_WQ) + (size_t)L * D * D; d.ldt = D; d.ks = P.in[I_G_MEM] + L * D; }
        else if (t == 1) { d.src = P.in[I_WKV] + (size_t)L * D * 2 * D; d.ldw = 2 * D; d.K = D; d.N = D; d.dst = (bf16_t*)(ws + WS_WK) + (size_t)L * D * D; d.ldt = D; d.ks = P.in[I_G_MEMKV] + L * D; }
        else if (t == 2) { d.src = P.in[I_WKV] + (size_t)L * D * 2 * D + D; d.ldw = 2 * D; d.K = D; d.N = D; d.dst = (bf16_t*)(ws + WS_WV) + (size_t)L * D * D; d.ldt = D; d.ks = P.in[I_G_MEMKV] + L * D; }
        else if (t == 3) { d.src = P.in[I_WO] + (size_t)L * D * D; d.ldw = D; d.K = D; d.N = D; d.dst = (bf16_t*)(ws + WS_WO) + (size_t)L * D * D; d.ldt = D; }
        else if (t == 4) { d.src = P.in[I_W1] + (size_t)L * D * FF; d.ldw = FF; d.K = D; d.N = FF; d.dst = (bf16_t*)(ws + WS_W1) + (size_t)L * D * FF; d.ldt = D; d.ks = P.in[I_G_FFN] + L * D; }
        else             { d.src = P.in[I_W2] + (size_t)L * D * FF; d.ldw = D; d.K = FF; d.N = D; d.dst = (bf16_t*)(ws + WS_W2) + (size_t)L * D * FF; d.ldt = FF; }
    } else if (id < 28) {
        const int j = (id - 24) >> 1, t = (id - 24) & 1;
        if (t == 0) { d.src = P.in[I_SGU_WIN] + (size_t)j * D * 2 * D; d.ldw = 2 * D; d.K = D; d.N = 2 * D; d.dst = (bf16_t*)(ws + WS_WIN) + (size_t)j * D * 2 * D; d.ldt = D; d.ks = P.in[I_G_MIX] + (2 * j + 1) * D; }
        else        { d.src = P.in[I_SGU_WOUT] + (size_t)j * D * D; d.ldw = D; d.K = D; d.N = D; d.dst = (bf16_t*)(ws + WS_WOUT) + (size_t)j * D * D; d.ldt = D; }
    } else {
        const int jg = id - 28, j = jg >> 2, g = jg & 3;
        d.src = P.in[I_POOL_W] + (size_t)jg * 256 * 256; d.ldw = 256; d.K = 256; d.N = 256; d.dst = (bf16_t*)(ws + WS_PW) + (size_t)jg * 256 * 256; d.ldt = 256;
        d.ks = P.in[I_G_MIX] + (2 * j) * D + g * 256; d.ns = P.in[I_POOL_SCALE] + j * D + g * 256;
    }
    return d;
}
__device__ __forceinline__ int mat_items(int id) {
    if (id < 24) { const int t = id % 6; return (t >= 4) ? 2048 : 512; }
    if (id < 28) return ((id - 24) & 1) ? 512 : 1024;
    return 32;
}

__device__ __forceinline__ void prologue_phase(const Params& P, LAS unsigned char* lds, int G) {
    int tid_ = threadIdx.x; asm volatile("" : "+v"(tid_));
    const int tid = tid_, lane = tid & 63, wave = __builtin_amdgcn_readfirstlane(tid >> 6);
    LAS float* scr = (LAS float*)(lds + wave * 16384);
    const int gw = blockIdx.x * 8 + wave, NGW = G * 8;
    constexpr int NITEMS = 4 * (4 * 512 + 2 * 2048) + 2 * (1024 + 512) + 8 * 32;
    for (int it = gw; it < NITEMS; it += NGW) {
        int r = it, id = 0;
        for (; id < 36; ++id) { const int n = mat_items(id); if (r < n) break; r -= n; }
        const MatDesc d = get_mat(P, id);
        transpose_item(d, scr, r, lane);
    }
    const float* mem = P.in[I_MEM]; bf16_t* memb = (bf16_t*)(P.ws + WS_MEMB); float* rstd_mem = (float*)(P.ws + WS_RSTDMEM);
    for (int r = gw; r < MR; r += NGW) {
        const f32x4* xr = (const f32x4*)(mem + (size_t)r * D) + lane; f32x4 v[4]; float s = 0.f;
#pragma unroll
        for (int j = 0; j < 4; ++j) { v[j] = xr[64 * j]; s += (v[j][0] * v[j][0] + v[j][1] * v[j][1]) + (v[j][2] * v[j][2] + v[j][3] * v[j][3]); }
        s = wave_sum(s);
        if (lane == 0) rstd_mem[r] = 1.0f / sqrtf(s * (1.0f / D) + EPS);
        u32x2* o = (u32x2*)(memb + (size_t)r * D) + lane;
#pragma unroll
        for (int j = 0; j < 4; ++j) { u32x2 w; w.x = cvt_pk_bf16(v[j][0], v[j][1]); w.y = cvt_pk_bf16(v[j][2], v[j][3]); o[64 * j] = w; }
    }
    const float* x = P.in[I_X]; float* ssq0 = (float*)(P.ws + WS_SSQ0);
    for (int r = gw; r < M; r += NGW) {
        const f32x4* xr = (const f32x4*)(x + (size_t)r * D) + lane; float s = 0.f;
#pragma unroll
        for (int j = 0; j < 4; ++j) { const f32x4 v = xr[64 * j]; s += (v[0] * v[0] + v[1] * v[1]) + (v[2] * v[2] + v[3] * v[3]); }
        s = wave_sum(s);
        if (lane < 16) ssq0[(size_t)r * 16 + lane] = (lane == 0) ? s : 0.f;
    }
}

template <int W>
__device__ __forceinline__ void pool_block(const f32x2 (&prev)[16], const f32x2 (&cur)[16], bool seq_start, bf16_t* outp  ) {
#pragma unroll
    for (int i = 0; i < 16; ++i) {
        f32x2 s = cur[i];
#pragma unroll
        for (int j = 1; j < W; ++j) { s += (i - j >= 0) ? cur[(i - j) & 15] : prev[(16 + i - j) & 15]; }
        float inv = 1.0f / (float)W;
        if (i < W - 1 && seq_start) inv = 1.0f / (float)(i + 1);
        const f32x2 o = s * inv - cur[i];
        *(unsigned*)(outp + (size_t)i * D) = cvt_pk_bf16(o[0], o[1]);
    }
}
template <bool F32IN> __device__ __forceinline__ f32x2 pool_ld(const void* x, size_t idx) {
    if (F32IN) return *(const f32x2*)((const float*)x + idx);
    const unsigned r = *(const unsigned*)((const bf16_t*)x + idx); return (f32x2){__uint_as_float(r << 16), __uint_as_float(r & 0xffff0000u)};
}
template <bool F32IN>
__device__ __forceinline__ void pool_a_phase(LAS unsigned char* lds, const void* x, const float* ssq, bf16_t* PA, int G) {
    LAS float* rs = (LAS float*)lds;
    int tid_ = threadIdx.x; asm volatile("" : "+v"(tid_));
    const int tid = tid_, ch = 2 * tid, group = __builtin_amdgcn_readfirstlane(tid >> 7);
    for (int chunk = blockIdx.x; chunk < M / 64; chunk += G) {
        const int t0 = chunk * 64; const bool sstart = (t0 & (SEQ - 1)) == 0;
        __syncthreads();
        if (tid < 80) {
            float r = 0.f;
            if (!(sstart && tid < 16)) { const f32x4* p = (const f32x4*)(ssq + (size_t)(t0 - 16 + tid) * 16); const f32x4 a = p[0], b = p[1], c = p[2], d = p[3];
                const float s = (((a[0] + a[1]) + (a[2] + a[3])) + ((b[0] + b[1]) + (b[2] + b[3]))) + (((c[0] + c[1]) + (c[2] + c[3])) + ((d[0] + d[1]) + (d[2] + d[3])));
                r = 1.0f / sqrtf(s * (1.0f / D) + EPS); }
            rs[tid] = r;
        }
        __syncthreads();
        f32x2 prev[16], cur[16];
        if (sstart) {
#pragma unroll
            for (int i = 0; i < 16; ++i) prev[i] = (f32x2){0.f, 0.f};
        } else {
#pragma unroll
            for (int i = 0; i < 16; ++i) prev[i] = pool_ld<F32IN>(x, (size_t)(t0 - 16 + i) * D + ch) * rs[i];
        }
        for (int blk = 0; blk < 4; ++blk) {
#pragma unroll
            for (int i = 0; i < 16; ++i) cur[i] = pool_ld<F32IN>(x, (size_t)(t0 + blk * 16 + i) * D + ch) * rs[16 + blk * 16 + i];
            bf16_t* outp = PA + (size_t)(t0 + blk * 16) * D + ch;
            const bool ss = sstart && blk == 0;
            if (group == 0) pool_block<2>(prev, cur, ss, outp);
            else if (group == 1) pool_block<4>(prev, cur, ss, outp);
            else if (group == 2) pool_block<8>(prev, cur, ss, outp);
            else pool_block<16>(prev, cur, ss, outp);
#pragma unroll
            for (int i = 0; i < 16; ++i) prev[i] = cur[i];
        }
    }
}

__device__ __forceinline__ void sgu_spatial_phase(LAS unsigned char* lds, const bf16_t* Z, const float* vstat, const float* wsf, const float* bsf, const float* lng, const float* lnb, bf16_t* T1, int G) {
    constexpr int APITCH = 272;
    LAS unsigned char* Aimg = lds;
    LAS unsigned char* VT = lds + 34816;
    LAS float* mu = (LAS float*)(lds + 34816 + 65536); LAS float* rsd = mu + 128;
    int tid_ = threadIdx.x; asm volatile("" : "+v"(tid_));
    const int tid = tid_, lane = tid & 63, wave = __builtin_amdgcn_readfirstlane(tid >> 6);
    const int g = blockIdx.x & 3;
    bool first = true;
    for (int u = blockIdx.x; u < (M / 128) * 4; u += G) {
        const int nb = u >> 2; const size_t rowb = (size_t)nb * 128;
        __syncthreads();
        if (tid < 128) {
            const f32x4* p = (const f32x4*)(vstat + (rowb + tid) * 32); float s1 = 0.f, s2 = 0.f;
#pragma unroll
            for (int i = 0; i < 4; ++i) { const f32x4 a = p[i], b = p[4 + i]; s1 += (a[0] + a[1]) + (a[2] + a[3]); s2 += (b[0] + b[1]) + (b[2] + b[3]); }
            const float m = s1 * (1.0f / D), var = s2 * (1.0f / D) - m * m;
            mu[tid] = m; rsd[tid] = 1.0f / sqrtf(fmaxf(var, 0.f) + EPS);
        }
        if (first) {
            first = false;
            const float* wg = wsf + (size_t)g * 128 * 128;
#pragma unroll
            for (int i = 0; i < 8; ++i) { const int e = (tid + 512 * i) * 4, p = e >> 7, q = e & 127; f32x4 v = *(const f32x4*)(wg + e);
                if ((p >> 6) < (q >> 6)) v = (f32x4){0.f, 0.f, 0.f, 0.f};
                u32x2 w; w.x = cvt_pk_bf16(v[0], v[1]); w.y = cvt_pk_bf16(v[2], v[3]); *(LAS u32x2*)(Aimg + p * APITCH + q * 2) = w; }
        }
        __syncthreads();
        {
            const int cp = tid & 31, c0 = 8 * cp; float gg[8], bb[8];
#pragma unroll
            for (int e = 0; e < 8; ++e) { gg[e] = lng[g * 256 + c0 + e]; bb[e] = lnb[g * 256 + c0 + e]; }
#pragma unroll 2
            for (int i = 0; i < 8; ++i) {
                const int q = (tid >> 5) + 16 * i;
                const u32x4 raw = *(const u32x4*)(Z + (rowb + q) * 2048 + 1024 + g * 256 + c0);
                const float m = mu[q], r = rsd[q];
                const unsigned wv[4] = {raw.x, raw.y, raw.z, raw.w};
#pragma unroll
                for (int e = 0; e < 8; ++e) {
                    const float v = __uint_as_float((e & 1) ? (wv[e >> 1] & 0xffff0000u) : (wv[e >> 1] << 16));
                    const float y = (v - m) * r * gg[e] + bb[e];
                    const unsigned pk = cvt_pk_bf16(y, y);
                    const int c = c0 + e, chunk = (q >> 3) ^ ((c >> 3) & 15) ^ (c & 7);
                    *(LAS unsigned short*)(VT + c * 256 + chunk * 16 + (q & 7) * 2) = (unsigned short)pk;
                }
            }
        }
        __syncthreads();
        f32x4 acc[2][8];
#pragma unroll
        for (int ct = 0; ct < 2; ++ct)
#pragma unroll
            for (int pt = 0; pt < 8; ++pt) acc[ct][pt] = (f32x4){0.f, 0.f, 0.f, 0.f};
        const int l16 = lane & 15, l4 = lane >> 4;
#pragma unroll
        for (int ks = 0; ks < 4; ++ks) {
            bf16x8 af[2], bfr[8];
#pragma unroll
            for (int ct = 0; ct < 2; ++ct) { const int c = wave * 32 + ct * 16 + l16, chunk = (4 * ks + l4) ^ ((c >> 3) & 15) ^ (c & 7); af[ct] = *(const LAS bf16x8*)(VT + c * 256 + chunk * 16); }
#pragma unroll
            for (int pt = 0; pt < 8; ++pt) bfr[pt] = *(const LAS bf16x8*)(Aimg + (pt * 16 + l16) * APITCH + (32 * ks + 8 * l4) * 2);
#pragma unroll
            for (int ct = 0; ct < 2; ++ct)
#pragma unroll
                for (int pt = 0; pt < 8; ++pt) acc[ct][pt] = __builtin_amdgcn_mfma_f32_16x16x32_bf16(af[ct], bfr[pt], acc[ct][pt], 0, 0, 0);
        }
#pragma unroll
        for (int pt = 0; pt < 8; ++pt) {
            const int p = pt * 16 + l16; const float bsv = bsf[g * 128 + p];
#pragma unroll
            for (int ct = 0; ct < 2; ++ct) {
                const int c = g * 256 + wave * 32 + ct * 16 + 4 * l4;
                const u32x2 uu = *(const u32x2*)(Z + (rowb + p) * 2048 + c);
                const float u0 = __uint_as_float(uu.x << 16), u1 = __uint_as_float(uu.x & 0xffff0000u), u2 = __uint_as_float(uu.y << 16), u3 = __uint_as_float(uu.y & 0xffff0000u);
                const f32x4 s = acc[ct][pt] + bsv;
                u32x2 w; w.x = cvt_pk_bf16(u0 * s[0], u1 * s[1]); w.y = cvt_pk_bf16(u2 * s[2], u3 * s[3]);
                *(u32x2*)(T1 + (rowb + p) * D + c) = w;
            }
        }
    }
}

constexpr int ATT_BUF = 36864;
__device__ __forceinline__ int sig23(int r) { return (r & ~12) | ((r & 4) << 1) | ((r & 8) >> 1); }

__device__ __forceinline__ void attn_issue(int st, int first_unit, int L, const bf16_t* Q, const bf16_t* Kall, const bf16_t* Vtall, u32x4 (&pre)[4], bf16x8 (&qpre)[4], int tid) {
    const int unit = first_unit + (st >> 3), chn = st & 7, pm = unit >> 2, h = unit & 3, b = pm >> 4;
    const int lane = tid & 63, wave = tid >> 6;
    if (chn < 4) {
#pragma unroll
        for (int i = 0; i < 4; ++i) { const int p = tid + 512 * i, rho = p >> 3, part = p & 7;
            pre[i] = *(const u32x4*)(Kall + (size_t)(b * 256 + sig23(rho)) * 4096 + L * 1024 + h * 256 + chn * 64 + part * 8); }
        const bf16_t* qp = Q + (size_t)(pm * 256 + wave * 32 + (lane & 31)) * D + h * 256 + chn * 64 + (lane >> 5) * 8;
#pragma unroll
        for (int ks = 0; ks < 4; ++ks) qpre[ks] = *(const bf16x8*)(qp + ks * 16);
    } else {
        const int vc = chn - 4;
#pragma unroll
        for (int i = 0; i < 4; ++i) { const int p = tid + 512 * i, r = p >> 5, part = p & 31;
            pre[i] = *(const u32x4*)(Vtall + (size_t)(L * 1024 + h * 256 + vc * 64 + r) * 4096 + b * 256 + part * 8); }
    }
}
__device__ __forceinline__ void attn_commit(int st, LAS unsigned char* lds, const u32x4 (&pre)[4], int tid) {
    LAS unsigned char* buf = lds + (st & 1) * ATT_BUF; const int chn = st & 7;
    if (chn < 4) {
#pragma unroll
        for (int i = 0; i < 4; ++i) { const int p = tid + 512 * i, rho = p >> 3, part = p & 7; *(LAS u32x4*)(buf + rho * 144 + part * 16) = pre[i]; }
    } else {
#pragma unroll
        for (int i = 0; i < 4; ++i) { const int p = tid + 512 * i, r = p >> 5, part = p & 31; *(LAS u32x4*)(buf + r * 528 + part * 16) = pre[i]; }
    }
}

__device__ __forceinline__ void attn_phase(LAS unsigned char* lds, const bf16_t* Q, const bf16_t* Kall, const bf16_t* Vtall, bf16_t* O, int L, int G) {
    int tid_ = threadIdx.x; asm volatile("" : "+v"(tid_));
    const int tid = tid_, lane = tid & 63, wave = __builtin_amdgcn_readfirstlane(tid >> 6), l32 = lane & 31, half = lane >> 5;
    const int bx = blockIdx.x, vcu = (G % 8 == 0) ? (bx % 8) * (G / 8) + bx / 8 : bx;
    const int nper = (1024 + G - 1) / G, first_unit = vcu * nper;
    int nunits = 1024 - first_unit; if (nunits > nper) nunits = nper; if (nunits <= 0) return;
    const int nsteps = nunits * 8;
    u32x4 pre[4]; bf16x8 qpre[4], qcur[4];
    __syncthreads();
    attn_issue(0, first_unit, L, Q, Kall, Vtall, pre, qpre, tid);
    attn_commit(0, lds, pre, tid);
#pragma unroll
    for (int ks = 0; ks < 4; ++ks) qcur[ks] = qpre[ks];
    __syncthreads();
    int st = 0;
    for (int ui = 0; ui < nunits; ++ui) {
        const int unit = first_unit + ui, pm = unit >> 2, h = unit & 3;
        f32x16 S[8];
#pragma unroll
        for (int mt = 0; mt < 8; ++mt)
#pragma unroll
            for (int i = 0; i < 16; ++i) S[mt][i] = 0.f;
        for (int kc = 0; kc < 4; ++kc, ++st) {
            if (st + 1 < nsteps) attn_issue(st + 1, first_unit, L, Q, Kall, Vtall, pre, qpre, tid);
            const LAS unsigned char* buf = lds + (st & 1) * ATT_BUF;
#pragma unroll
            for (int ks = 0; ks < 4; ++ks)
#pragma unroll
                for (int mt = 0; mt < 8; ++mt) {
                    const bf16x8 kf = *(const LAS bf16x8*)(buf + (32 * mt + l32) * 144 + ks * 32 + half * 16);
                    S[mt] = __builtin_amdgcn_mfma_f32_32x32x16_bf16(kf, qcur[ks], S[mt], 0, 0, 0);
                }
            if (st + 1 < nsteps) attn_commit(st + 1, lds, pre, tid);
#pragma unroll
            for (int ks = 0; ks < 4; ++ks) qcur[ks] = qpre[ks];
            __syncthreads();
        }
        float mx = -3.0e38f;
#pragma unroll
        for (int mt = 0; mt < 8; ++mt)
#pragma unroll
            for (int i = 0; i < 16; ++i) mx = fmaxf(mx, S[mt][i]);
        mx = fmaxf(mx, __shfl_xor(mx, 32));
        float lsum = 0.f;
        bf16x8 pf[8][2];
#pragma unroll
        for (int mt = 0; mt < 8; ++mt) {
#pragma unroll
            for (int i = 0; i < 16; ++i) { const float p = __builtin_amdgcn_exp2f(S[mt][i] - mx); S[mt][i] = p; lsum += p; }
#pragma unroll
            for (int s2 = 0; s2 < 2; ++s2) { u32x4 w; w.x = cvt_pk_bf16(S[mt][8 * s2 + 0], S[mt][8 * s2 + 1]); w.y = cvt_pk_bf16(S[mt][8 * s2 + 2], S[mt][8 * s2 + 3]);
                w.z = cvt_pk_bf16(S[mt][8 * s2 + 4], S[mt][8 * s2 + 5]); w.w = cvt_pk_bf16(S[mt][8 * s2 + 6], S[mt][8 * s2 + 7]); pf[mt][s2] = __builtin_bit_cast(bf16x8, w); }
        }
        lsum += __shfl_xor(lsum, 32);
        const float inv = 1.0f / lsum;
        bf16_t* orow = O + (size_t)(pm * 256 + wave * 32 + l32) * D + h * 256;
        for (int vc = 0; vc < 4; ++vc, ++st) {
            if (st + 1 < nsteps) attn_issue(st + 1, first_unit, L, Q, Kall, Vtall, pre, qpre, tid);
            const LAS unsigned char* buf = lds + (st & 1) * ATT_BUF;
            f32x16 o[2];
#pragma unroll
            for (int ht = 0; ht < 2; ++ht)
#pragma unroll
                for (int i = 0; i < 16; ++i) o[ht][i] = 0.f;
#pragma unroll
            for (int mt = 0; mt < 8; ++mt)
#pragma unroll
                for (int s2 = 0; s2 < 2; ++s2)
#pragma unroll
                    for (int ht = 0; ht < 2; ++ht) {
                        const bf16x8 vf = *(const LAS bf16x8*)(buf + (32 * ht + l32) * 528 + (32 * mt + 16 * s2 + 8 * half) * 2);
                        o[ht] = __builtin_amdgcn_mfma_f32_32x32x16_bf16(vf, pf[mt][s2], o[ht], 0, 0, 0);
                    }
#pragma unroll
            for (int ht = 0; ht < 2; ++ht)
#pragma unroll
                for (int i4 = 0; i4 < 4; ++i4) {
                    u32x2 w; w.x = cvt_pk_bf16(o[ht][4 * i4 + 0] * inv, o[ht][4 * i4 + 1] * inv); w.y = cvt_pk_bf16(o[ht][4 * i4 + 2] * inv, o[ht][4 * i4 + 3] * inv);
                    *(u32x2*)(orow + vc * 64 + ht * 32 + i4 * 8 + half * 4) = w;
                }
            if (st + 1 < nsteps) attn_commit(st + 1, lds, pre, tid);
#pragma unroll
            for (int ks = 0; ks < 4; ++ks) qcur[ks] = qpre[ks];
            __syncthreads();
        }
    }
}

__device__ __forceinline__ void final_norm_phase(const bf16_t* xb, float* out, const float* gain, int G) {
    int tid_ = threadIdx.x; asm volatile("" : "+v"(tid_));
    const int tid = tid_, lane = tid & 63, wave = tid >> 6, gw = blockIdx.x * 8 + wave, NGW = G * 8;
    f32x4 gv[4];
#pragma unroll
    for (int j = 0; j < 2; ++j) { gv[2 * j] = *(const f32x4*)(gain + 512 * j + 8 * lane); gv[2 * j + 1] = *(const f32x4*)(gain + 512 * j + 8 * lane + 4); }
    for (int r = gw; r < M; r += NGW) {
        f32x4 v[4]; float s = 0.f;
#pragma unroll
        for (int j = 0; j < 2; ++j) { const u32x4 q = *(const u32x4*)(xb + (size_t)r * D + 512 * j + 8 * lane);
            v[2 * j] = (f32x4){__uint_as_float(q.x << 16), __uint_as_float(q.x & 0xffff0000u), __uint_as_float(q.y << 16), __uint_as_float(q.y & 0xffff0000u)};
            v[2 * j + 1] = (f32x4){__uint_as_float(q.z << 16), __uint_as_float(q.z & 0xffff0000u), __uint_as_float(q.w << 16), __uint_as_float(q.w & 0xffff0000u)}; }
#pragma unroll
        for (int j = 0; j < 4; ++j) s += (v[j][0] * v[j][0] + v[j][1] * v[j][1]) + (v[j][2] * v[j][2] + v[j][3] * v[j][3]);
        s = wave_sum(s);
        const float rs = 1.0f / sqrtf(s * (1.0f / D) + EPS);
#pragma unroll
        for (int j = 0; j < 2; ++j) { *(f32x4*)(out + (size_t)r * D + 512 * j + 8 * lane) = v[2 * j] * rs * gv[2 * j]; *(f32x4*)(out + (size_t)r * D + 512 * j + 8 * lane + 4) = v[2 * j + 1] * rs * gv[2 * j + 1]; }
    }
}

#define XB_TMO      128
#define XB_XCNT(j)  (256  + 64 * (j))
#define XB_XSUB(j)  (1280 + 64 * (j))
#define XB_XGEN(j)  (2304 + 64 * (j))
#define XB_TOP      3328
#define XB_TOPGEN   3392
#define XCD_BAR_WORDS 3456
#define XB_SPIN_CAP (1u << 20)
__device__ __forceinline__ unsigned xb_ld(unsigned* p)              { return __hip_atomic_load(p, __ATOMIC_RELAXED, __HIP_MEMORY_SCOPE_AGENT); }
__device__ __forceinline__ unsigned xb_add(unsigned* p, unsigned v) { return __hip_atomic_fetch_add(p, v, __ATOMIC_RELAXED, __HIP_MEMORY_SCOPE_AGENT); }
__device__ __forceinline__ unsigned xb_xcc_id() { return (unsigned)__builtin_amdgcn_s_getreg((3 << 11) | 20) & 0xFu; }
#define XB_SPIN(cond, bar) do { unsigned _sp = 0; while (cond) { __builtin_amdgcn_s_sleep(1); \
    if ((++_sp & 255u) == 0u) { if (xb_ld(&(bar)[XB_TMO])) break; if (_sp > XB_SPIN_CAP) { atomicAdd(&(bar)[XB_TMO], 1u); break; } } } } while (0)
struct XcdBarrier { unsigned* bar; unsigned x; volatile LAS unsigned* st; };
__device__ __forceinline__ XcdBarrier xcd_barrier_post(unsigned* bar, volatile LAS unsigned* st) {
    XcdBarrier b; b.bar = bar; b.x = xb_xcc_id(); b.st = st;
    if (threadIdx.x == 0) (void)xb_add(&bar[XB_XCNT(b.x)], 1u);
    return b;
}
__device__ __forceinline__ void xcd_barrier_complete(unsigned* bar, unsigned x, unsigned& nloc, unsigned& nx) {
    const unsigned G = gridDim.x * gridDim.y * gridDim.z;
    unsigned sum, cnt, mine, sp = 0u;
    for (;;) {
        sum = 0u; cnt = 0u; mine = 0u;
#pragma unroll
        for (unsigned j = 0; j < 16; ++j) { const unsigned c = xb_ld(&bar[XB_XCNT(j)]); sum += c; cnt += (c > 0u) ? 1u : 0u; mine = (j == x) ? c : mine; }
        if (sum == G) break;
        __builtin_amdgcn_s_sleep(1);
        if ((++sp & 255u) == 0u) { if (xb_ld(&bar[XB_TMO])) break; if (sp > XB_SPIN_CAP) { atomicAdd(&bar[XB_TMO], 1u); break; } }
    }
    nloc = mine > 0u ? mine : 1u; nx = cnt > 0u ? cnt : 1u;
}
__device__ __forceinline__ void xcd_barrier(const XcdBarrier& b) {
    asm volatile("s_waitcnt vmcnt(0)" ::: "memory");
    __syncthreads();
    if (threadIdx.x == 0) {
        unsigned* bar = b.bar;
        __builtin_amdgcn_s_waitcnt(0);
        unsigned nloc = b.st[0], nx = b.st[1];
        if (nloc == 0u) { xcd_barrier_complete(bar, b.x, nloc, nx); b.st[0] = nloc; b.st[1] = nx; }
        const unsigned old = xb_add(&bar[XB_XSUB(b.x)], 1u);
        const unsigned gen = old / nloc;
        if (old + 1u == (gen + 1u) * nloc) {
            __builtin_amdgcn_fence(__ATOMIC_RELEASE, "agent");
            asm volatile("s_waitcnt vmcnt(0)" ::: "memory");
            const unsigned og = xb_add(&bar[XB_TOP], 1u);
            const unsigned tg = og / nx;
            if (og + 1u == (tg + 1u) * nx) xb_add(&bar[XB_TOPGEN], 1u);
            else XB_SPIN(xb_ld(&bar[XB_TOPGEN]) == tg, bar);
            __builtin_amdgcn_fence(__ATOMIC_ACQUIRE, "agent");
            xb_add(&bar[XB_XGEN(b.x)], 1u);
            asm volatile("s_waitcnt vmcnt(0)" ::: "memory");
        } else {
            XB_SPIN(xb_ld(&bar[XB_XGEN(b.x)]) == gen, bar);
            __builtin_amdgcn_fence(__ATOMIC_ACQUIRE, "agent");
            asm volatile("s_waitcnt vmcnt(0)" ::: "memory");
        }
    }
    __syncthreads();
}

constexpr int NPHASES = 35;
__host__ __device__ inline bool phase_empty(int ph) { if (ph < 2 || ph >= 34) return false; const int L = (ph - 2) >> 3, k = (ph - 2) & 7; return k == 2 && (L & 1) == 0; }

__global__ void __launch_bounds__(512, 2) fwd_megakernel(Params P) {
    extern __shared__ __attribute__((aligned(16))) unsigned char lds_raw[];
    LAS unsigned char* lds = (LAS unsigned char*)lds_raw;
    cg::grid_group grid = cg::this_grid();
    const int G = gridDim.x;
    unsigned char* ws = P.ws;
    bf16_t* T1 = (bf16_t*)(ws + WS_T1); bf16_t* OB = (bf16_t*)(ws + WS_O); bf16_t* ZB = (bf16_t*)(ws + WS_Z); bf16_t* HB = (bf16_t*)(ws + WS_H);
    bf16_t* XB = (bf16_t*)(ws + WS_XB); bf16_t* KALL = (bf16_t*)(ws + WS_KALL); bf16_t* VTALL = (bf16_t*)(ws + WS_VTALL); bf16_t* MEMB = (bf16_t*)(ws + WS_MEMB);
    float* SSQ[2] = {(float*)(ws + WS_SSQ0), (float*)(ws + WS_SSQ1)};
    float* VSTAT = (float*)(ws + WS_VSTAT); float* RSTDMEM = (float*)(ws + WS_RSTDMEM);
    volatile LAS unsigned* MISC = (volatile LAS unsigned*)(lds + 131072 + 320);
    if (threadIdx.x < 32) MISC[threadIdx.x] = 0u;
    __syncthreads();
    XcdBarrier bar; bar.bar = (unsigned*)(ws + WS_CTL); bar.x = 0; bar.st = MISC + 8;
    if (P.ph_hi - P.ph_lo > 1) bar = xcd_barrier_post((unsigned*)(ws + WS_CTL), MISC + 8);

    for (int ph = P.ph_lo; ph < P.ph_hi; ++ph) {
        if (phase_empty(ph)) continue;
        if (ph == 0) {
            prologue_phase(P, lds, G);
        } else if (ph == 1) {
            pg8::StaticOrder S; S.init(MR, 4096, G, (int)blockIdx.x);
            { pg8::Gemm g{MEMB, (const bf16_t*)(ws + WS_WK), MR, 4096, D, D, D, 0}; pg8::EpiAct<4> E{KALL, 4096, nullptr, 1.f, RSTDMEM, nullptr}; pg8::gemm_phase(lds, g, S, E); }
            { pg8::Gemm g{(const bf16_t*)(ws + WS_WV), MEMB, 4096, MR, D, D, D, 0}; pg8::EpiAct<3> E{VTALL, 4096, nullptr, 1.f, RSTDMEM, nullptr}; pg8::gemm_phase(lds, g, S, E); }
        } else if (ph == 34) {
            final_norm_phase(XB, P.out, P.in[I_G_FINAL], G);
        } else {
            const int L = (ph - 2) >> 3, k = (ph - 2) & 7, j = L >> 1; const bool odd = (L & 1) != 0;
            if (k == 0) {
                const float* ssq_r = SSQ[(3 * L) & 1];
                if (!odd) { if (L == 0) pool_a_phase<true>(lds, P.in[I_X], ssq_r, T1, G); else pool_a_phase<false>(lds, XB, ssq_r, T1, G); }
                else { pg8::Gemm g{XB, (const bf16_t*)(ws + WS_WIN) + (size_t)j * D * 2 * D, M, 2 * D, D, D, D, 0}; pg8::StaticOrder S; S.init(M, 2 * D, G, (int)blockIdx.x);
                    pg8::EpiAct<2> E{ZB, 2 * D, ssq_r, 1.f, nullptr, VSTAT}; pg8::gemm_phase(lds, g, S, E); }
            } else if (k == 1 && odd) {
                sgu_spatial_phase(lds, ZB, VSTAT, P.in[I_SGU_WS] + (size_t)j * 4 * 128 * 128, P.in[I_SGU_BS] + j * 512, P.in[I_SGU_LNG] + j * D, P.in[I_SGU_LNB] + j * D, T1, G);
            } else if (k == 3) {
                pg8::Gemm g{XB, (const bf16_t*)(ws + WS_WQ) + (size_t)L * D * D, M, D, D, D, D, 0}; pg8::StaticOrder S; S.init(M, D, G, (int)blockIdx.x);
                pg8::EpiAct<0> E{T1, D, SSQ[(3 * L + 1) & 1], QSCALE, nullptr, nullptr}; pg8::gemm_phase(lds, g, S, E);
            } else if (k == 4) {
                attn_phase(lds, T1, KALL, VTALL, OB, L, G);
            } else if (k == 6) {
                pg8::Gemm g{XB, (const bf16_t*)(ws + WS_W1) + (size_t)L * D * FF, M, FF, D, D, D, 0}; pg8::StaticOrder S; S.init(M, FF, G, (int)blockIdx.x);
                pg8::EpiAct<1> E{HB, FF, SSQ[(3 * L + 2) & 1], 1.f, nullptr, nullptr}; pg8::gemm_phase(lds, g, S, E);
            } else {
                pg8::Gemm g; int upd;
                if (k == 1)      { g = pg8::Gemm{T1, (const bf16_t*)(ws + WS_PW) + (size_t)j * 4 * 256 * 256, M, D, 256, D, 256, 256}; upd = 3 * L; }
                else if (k == 2) { g = pg8::Gemm{T1, (const bf16_t*)(ws + WS_WOUT) + (size_t)j * D * D, M, D, D, D, D, 0}; upd = 3 * L; }
                else if (k == 5) { g = pg8::Gemm{OB, (const bf16_t*)(ws + WS_WO) + (size_t)L * D * D, M, D, D, D, D, 0}; upd = 3 * L + 1; }
                else             { g = pg8::Gemm{HB, (const bf16_t*)(ws + WS_W2) + (size_t)L * D * FF, M, D, FF, FF, FF, 0}; upd = 3 * L + 2; }
                pg8::StaticOrder S; S.init(M, D, G, (int)blockIdx.x);
                if (ph == 3) { pg8::EpiResid<true> E{P.in[I_X], XB, SSQ[(upd + 1) & 1]}; pg8::gemm_phase(lds, g, S, E); }
                else { pg8::EpiResid<false> E{nullptr, XB, SSQ[(upd + 1) & 1]}; pg8::gemm_phase(lds, g, S, E); }
            }
        }
        if (ph + 1 < P.ph_hi) { if (ph == 0) grid.sync(); else xcd_barrier(bar); }
    }
}

extern "C" void kernel_launch(void* const* d_in, const int* in_sizes, int n_in, void* d_out, int out_size, void* d_ws, size_t ws_size, hipStream_t stream) {
    static int grid = 0;
    if (grid == 0) {
        if (n_in != 20 || in_sizes[0] != M * D || out_size != M * D || ws_size < WS_END) { fprintf(stderr, "kernel_launch: unexpected shapes (n_in %d, in0 %d, out %d, ws %zu); nothing launched\n", n_in, n_in > 0 ? in_sizes[0] : -1, out_size, ws_size); grid = -1; return; }
        int dev = 0, cus = 0, per_cu = 0;
        if (hipGetDevice(&dev) != hipSuccess || hipDeviceGetAttribute(&cus, hipDeviceAttributeMultiprocessorCount, dev) != hipSuccess) { grid = -1; return; }
        if (hipFuncSetAttribute((const void*)fwd_megakernel, hipFuncAttributeMaxDynamicSharedMemorySize, LDS_BYTES) != hipSuccess) { fprintf(stderr, "kernel_launch: hipFuncSetAttribute failed\n"); grid = -1; return; }
        if (hipOccupancyMaxActiveBlocksPerMultiprocessor(&per_cu, (const void*)fwd_megakernel, 512, LDS_BYTES) != hipSuccess || per_cu < 1) { fprintf(stderr, "kernel_launch: occupancy query gave %d\n", per_cu); per_cu = 1; }
        (void)hipGetLastError();
        grid = cus * per_cu;
        if (grid > 256) grid = 256;
        grid &= ~7;
        if (grid < 8) { grid = -1; return; }
    }
    if (grid < 0) return;
    Params p{};
    for (int i = 0; i < 20; ++i) p.in[i] = (const float*)d_in[i];
    p.out = (float*)d_out; p.ws = (unsigned char*)d_ws;
#if MK_SINGLE
    p.ph_lo = 0; p.ph_hi = NPHASES;
    if (hipMemsetAsync((char*)d_ws + WS_CTL, 0, CTL_BYTES, stream) != hipSuccess) { fprintf(stderr, "kernel_launch: memset failed\n"); return; }
    void* args[] = {&p};
    hipError_t e = hipLaunchCooperativeKernel((const void*)fwd_megakernel, dim3(grid), dim3(512), args, LDS_BYTES, stream);
    if (e != hipSuccess) fprintf(stderr, "kernel_launch: cooperative launch failed: %s (grid %d)\n", hipGetErrorString(e), grid);
#else
    for (int ph = 0; ph < NPHASES; ++ph) {
        if (phase_empty(ph)) continue;
        p.ph_lo = ph; p.ph_hi = ph + 1;
        hipLaunchKernelGGL(fwd_megakernel, dim3(grid), dim3(512), LDS_BYTES, stream, p);
    }
#endif
}
```

```cpp
#include <hip/hip_runtime.h>
#include <hip/hip_cooperative_groups.h>
#include <cstdio>
#include <cstdint>
namespace cg = cooperative_groups;

#ifndef MK_SINGLE
#define MK_SINGLE 1
#endif

#define LAS __attribute__((address_space(3)))
typedef unsigned short bf16_t;
typedef short bf16x8 __attribute__((ext_vector_type(8)));
typedef float f32x4 __attribute__((ext_vector_type(4)));
typedef float f32x2 __attribute__((ext_vector_type(2)));
typedef float f32x16 __attribute__((ext_vector_type(16)));
typedef unsigned u32x4 __attribute__((ext_vector_type(4)));
typedef unsigned u32x2 __attribute__((ext_vector_type(2)));

constexpr int D = 1024, BATCH = 16, SEQ = 4096, DEPTH = 4, FF = 4096, NMEM = 256;
constexpr int M = BATCH * SEQ;
constexpr int MR = BATCH * NMEM;
constexpr float EPS = 1e-6f;
constexpr float QSCALE = 0.0625f * 1.4426950408889634f;

constexpr size_t MiB = 1u << 20;
constexpr size_t WS_H = 0, WS_T1 = 0, WS_O = 128 * MiB, WS_Z = 256 * MiB;
constexpr size_t WS_XB = 512 * MiB;
constexpr size_t WS_KALL = 640 * MiB, WS_VTALL = 672 * MiB, WS_MEMB = 704 * MiB;
constexpr size_t WS_SSQ0 = 712 * MiB, WS_SSQ1 = 716 * MiB, WS_VSTAT = 720 * MiB, WS_RSTDMEM = 728 * MiB;
constexpr size_t WS_CTL = 730 * MiB, CTL_BYTES = 16384;
constexpr size_t WS_WQ = 736 * MiB, WS_WO = 744 * MiB, WS_W1 = 752 * MiB, WS_W2 = 784 * MiB, WS_WK = 816 * MiB, WS_WV = 824 * MiB;
constexpr size_t WS_WIN = 832 * MiB, WS_WOUT = 840 * MiB, WS_PW = 844 * MiB, WS_END = 845 * MiB;

constexpr int LDS_BYTES = 147456;

struct Params {
    const float* in[20];
    float* out;
    unsigned char* ws;
    int ph_lo, ph_hi;
};

__device__ __forceinline__ unsigned cvt_pk_bf16(float lo, float hi) { unsigned r; asm volatile("v_cvt_pk_bf16_f32 %0, %1, %2" : "=v"(r) : "v"(lo), "v"(hi)); return r; }
__device__ __forceinline__ float wave_sum(float v) {
#pragma unroll
    for (int o = 1; o < 64; o <<= 1) v += __shfl_xor(v, o);
    return v;
}
__device__ __forceinline__ float gelu_tanh(float x) {
    const float y = 0.7978845608028654f * (x + 0.044715f * x * x * x);
    const float e = __builtin_amdgcn_exp2f(-2.0f * 1.4426950408889634f * y);
    return x * __builtin_amdgcn_rcpf(1.0f + e);
}

__device__ __forceinline__ int sig23(int r) { return (r & ~12) | ((r & 4) << 1) | ((r & 8) >> 1); }
namespace pg8 {
constexpr int BM = 256, BK = 64, HALF = 128, HTB = HALF * BK * 2, STAGE_BYTES = 8 * HTB, NXCD = 8, WGM = 8;
__host__ __device__ __forceinline__ int lds_byte(int r, int c) { const int st = (r >> 4) * 2 + (c >> 5), rr = r & 15, cc = c & 31, ob = rr * 64 + cc * 2; return st * 1024 + (ob ^ (((ob >> 9) & 1) << 5)); }
__host__ __device__ __forceinline__ void stage_rc(int b, int& R, int& C) { const int st = b / 1024, sb = b % 1024, swz = sb ^ (((sb >> 9) & 1) << 5); R = (st >> 1) * 16 + swz / 64; C = (st & 1) * 32 + (swz % 64) / 2; }
__host__ __device__ __forceinline__ int perm32(int rho) { const int n = rho >> 4, i = rho & 15; return 8 * (i >> 2) + 4 * n + (i & 3); }

struct Unit { int pm, pn; };
struct Gemm { const bf16_t* A; const bf16_t* Bt; int M, N, K, lda, ldb, acol; };

struct StaticOrder {
    int nM, nN, nwg, G, c;
    __device__ void init(int M_, int N_, int G_, int c_) { nM = M_ / BM; nN = N_ / BM; nwg = nM * nN; G = G_; c = c_; }
    __device__ bool next(int i, Unit& u) const {
        const long L = (long)i * G + c; if (L >= nwg) return false;
        int wgid = (int)L; { const int q = nwg / NXCD, r = nwg % NXCD, xcd = wgid % NXCD, off = wgid / NXCD; wgid = (xcd < r ? xcd * (q + 1) : r * (q + 1) + (xcd - r) * q) + off; }
        const int nig = WGM * nN, gid = wgid / nig, fm = gid * WGM, gsz = (nM - fm) < WGM ? (nM - fm) : WGM;
        u.pm = fm + ((wgid % nig) % gsz); u.pn = (wgid % nig) / gsz; return true;
    }
};

__device__ __forceinline__ float rstd_from_slots(const float* ssq, int row, int fq) {
    const f32x4 v = *(const f32x4*)(ssq + (size_t)row * 16 + fq * 4);
    float s = (v[0] + v[1]) + (v[2] + v[3]);
    s += __shfl_xor(s, 16); s += __shfl_xor(s, 32);
    return __builtin_amdgcn_rsqf(s * (1.0f / 1024.0f) + EPS);
}

template <int MODE> struct EpiAct {
    bf16_t* O; int ldc; const float* ssq; float scale; const float* rvec; float* vstat;
    __device__ __forceinline__ void operator()(const f32x4 (&acc)[2][2][4][2], const Unit& u, int wr, int wc, int fr, int fq) const {
        const int row0 = u.pm * BM + wr * 64 + fr, col0 = u.pn * BM + wc * 32 + 8 * fq;
        f32x4 cs[2][2];
        if (MODE == 3) {
#pragma unroll
            for (int bj = 0; bj < 2; ++bj) { cs[bj][0] = *(const f32x4*)(rvec + col0 + bj * HALF); cs[bj][1] = *(const f32x4*)(rvec + col0 + bj * HALF + 4); }
        }
#pragma unroll
        for (int ai = 0; ai < 2; ++ai)
#pragma unroll
            for (int m = 0; m < 4; ++m) {
                const int row = row0 + ai * HALF + m * 16;
                float rs = 1.f;
                if (MODE == 0 || MODE == 1 || MODE == 2) rs = rstd_from_slots(ssq, row, fq);
                if (MODE == 0) rs *= scale;
                if (MODE == 4) rs = rvec[row];
                bf16_t* rowp = O + (size_t)row * ldc + col0;
                if (MODE == 4) { const int b = row >> 8, n = row & 255; rowp = O + ((size_t)(b * 4) << 16) + (sig23(n) << 6); }
                if (MODE == 3) { const int Lh = row >> 8, d = row & 255; rowp = O + ((size_t)((Lh >> 2) * 64 + (Lh & 3)) << 16) + ((d >> 6) << 14) + ((d & 63) << 8); }
                float s1 = 0.f, s2 = 0.f;
#pragma unroll
                for (int bj = 0; bj < 2; ++bj) {
                    f32x4 v0 = acc[ai][bj][m][0] * rs, v1 = acc[ai][bj][m][1] * rs;
                    if (MODE == 3) { v0 = acc[ai][bj][m][0] * cs[bj][0]; v1 = acc[ai][bj][m][1] * cs[bj][1]; }
                    if (MODE == 1) {
#pragma unroll
                        for (int j = 0; j < 4; ++j) { const float a = v0[j] > 0.f ? v0[j] : 0.f, b = v1[j] > 0.f ? v1[j] : 0.f; v0[j] = a * a; v1[j] = b * b; }
                    }
                    if (MODE == 2) {
#pragma unroll
                        for (int j = 0; j < 4; ++j) { v0[j] = gelu_tanh(v0[j]); v1[j] = gelu_tanh(v1[j]); }
#pragma unroll
                        for (int j = 0; j < 4; ++j) { s1 += v0[j] + v1[j]; s2 += v0[j] * v0[j] + v1[j] * v1[j]; }
                    }
                    u32x4 w; w.x = cvt_pk_bf16(v0[0], v0[1]); w.y = cvt_pk_bf16(v0[2], v0[3]); w.z = cvt_pk_bf16(v1[0], v1[1]); w.w = cvt_pk_bf16(v1[2], v1[3]);
                    bf16_t* sp = rowp + bj * HALF;
                    if (MODE == 4) { const int col = col0 + bj * HALF, L = col >> 10, h = (col >> 8) & 3, d = col & 255; sp = rowp + ((size_t)(L * 64 + h) << 16) + ((d >> 6) << 14) + (d & 63); }
                    if (MODE == 3) { const int col = col0 + bj * HALF, b = col >> 8, n = col & 255; sp = rowp + ((size_t)(b * 4) << 16) + n; }
                    __builtin_nontemporal_store(w, (u32x4*)sp);
                }
                if (MODE == 2) {
                    s1 += __shfl_xor(s1, 16); s1 += __shfl_xor(s1, 32); s2 += __shfl_xor(s2, 16); s2 += __shfl_xor(s2, 32);
                    if (u.pn >= 4 && fq == 0) { vstat[(size_t)row * 32 + (u.pn - 4) * 4 + wc] = s1; vstat[(size_t)row * 32 + 16 + (u.pn - 4) * 4 + wc] = s2; }
                }
            }
    }
};
template <bool F32IN> struct EpiResid {
    const float* xin; bf16_t* xb; float* ssq;
    __device__ __forceinline__ void operator()(const f32x4 (&acc)[2][2][4][2], const Unit& u, int wr, int wc, int fr, int fq) const {
        const int row0 = u.pm * BM + wr * 64 + fr, col0 = u.pn * BM + wc * 32 + 8 * fq;
#pragma unroll
        for (int ai = 0; ai < 2; ++ai)
#pragma unroll
            for (int m = 0; m < 4; ++m) {
                const int row = row0 + ai * HALF + m * 16; const size_t off = (size_t)row * D + col0;
                float ss = 0.f;
#pragma unroll
                for (int bj = 0; bj < 2; ++bj) {
                    f32x4 a0, a1;
                    if (F32IN) { a0 = *(const f32x4*)(xin + off + bj * HALF); a1 = *(const f32x4*)(xin + off + bj * HALF + 4); }
                    else { const u32x4 r = *(const u32x4*)(xb + off + bj * HALF);
                        a0 = (f32x4){__uint_as_float(r.x << 16), __uint_as_float(r.x & 0xffff0000u), __uint_as_float(r.y << 16), __uint_as_float(r.y & 0xffff0000u)};
                        a1 = (f32x4){__uint_as_float(r.z << 16), __uint_as_float(r.z & 0xffff0000u), __uint_as_float(r.w << 16), __uint_as_float(r.w & 0xffff0000u)}; }
                    const f32x4 v0 = a0 + acc[ai][bj][m][0], v1 = a1 + acc[ai][bj][m][1];
                    u32x4 w; w.x = cvt_pk_bf16(v0[0], v0[1]); w.y = cvt_pk_bf16(v0[2], v0[3]); w.z = cvt_pk_bf16(v1[0], v1[1]); w.w = cvt_pk_bf16(v1[2], v1[3]);
                    __builtin_nontemporal_store(w, (u32x4*)(xb + off + bj * HALF));
                    const unsigned ww[4] = {w.x, w.y, w.z, w.w};
#pragma unroll
                    for (int j = 0; j < 4; ++j) { const float lo = __uint_as_float(ww[j] << 16), hi = __uint_as_float(ww[j] & 0xffff0000u); ss += lo * lo + hi * hi; }
                }
                ss += __shfl_xor(ss, 16); ss += __shfl_xor(ss, 32);
                if (fq == 0) ssq[(size_t)row * 16 + u.pn * 4 + wc] = ss;
                asm volatile("" ::: "memory");
            }
    }
};

template <class Epi>
__device__ __forceinline__ void gemm_phase(LAS unsigned char* lds, const Gemm g, const StaticOrder& S, const Epi& E) {
    int tid_ = threadIdx.x; asm volatile("" : "+v"(tid_));
    const int tid = tid_, wid = __builtin_amdgcn_readfirstlane(tid >> 6), lane = tid & 63, wr = wid >> 2, wc = wid & 3, fr = lane & 15, fq = lane >> 4;
    const int nt = g.K / BK;
    unsigned voffA[2], voffB[2];
#pragma unroll
    for (int i = 0; i < 2; ++i) { int R, C; stage_rc(tid * 16 + i * 8192, R, C); const int Rb = (R & ~31) + perm32(R & 31);
        voffA[i] = (unsigned)(R * g.lda + C) * 2u; voffB[i] = (unsigned)(Rb * g.ldb + C) * 2u; }
    const size_t kstep = (size_t)(BK * 2);
    const size_t hstepA = (size_t)HALF * g.lda * 2, hstepB = (size_t)HALF * g.ldb * 2;
    const size_t tstepA = 2 * hstepA, tstepB = 2 * hstepB, cstepA = (size_t)g.acol * 2;
    const unsigned ldsw = (unsigned)wid * 1024u;
    const int aoff = lds_byte(wr * 64 + fr, fq * 8), boff = lds_byte(wc * 32 + fr, fq * 8);
#define PG8_SA(b, h) (((b) * 2 + (h)) * HTB)
#define PG8_SB(b, h) ((4 + (b) * 2 + (h)) * HTB)
#define PG8_STAGE(bufoff, gbase, voff) do { _Pragma("unroll") for (int _i = 0; _i < 2; ++_i) \
        __builtin_amdgcn_global_load_lds((const unsigned*)((const char*)(gbase) + (voff)[_i]), (LAS unsigned*)(lds + (bufoff) + ldsw + _i * 8192), 16, 0, 0); } while (0)
#define PG8_LDA(dst, b, h) do { _Pragma("unroll") for (int m = 0; m < 4; ++m) _Pragma("unroll") for (int k = 0; k < 2; ++k) dst[m][k] = *(const LAS bf16x8*)(lds + PG8_SA(b, h) + aoff + m * 2048 + k * 1024); } while (0)
#define PG8_LDB(dst, b, h) do { _Pragma("unroll") for (int n = 0; n < 2; ++n) _Pragma("unroll") for (int k = 0; k < 2; ++k) dst[n][k] = *(const LAS bf16x8*)(lds + PG8_SB(b, h) + boff + n * 2048 + k * 1024); } while (0)
#define PG8_MMA(ai, bj, At, Bt) do { __builtin_amdgcn_s_setprio(1); _Pragma("unroll") for (int m = 0; m < 4; ++m) _Pragma("unroll") for (int n = 0; n < 2; ++n) _Pragma("unroll") for (int k = 0; k < 2; ++k) \
        acc[ai][bj][m][n] = __builtin_amdgcn_mfma_f32_16x16x32_bf16(Bt[n][k], At[m][k], acc[ai][bj][m][n], 0, 0, 0); __builtin_amdgcn_s_setprio(0); } while (0)
#define PG8_WAIT_V(n) asm volatile("s_waitcnt vmcnt(" #n ")" ::: "memory")
#define PG8_WAIT_L(n) asm volatile("s_waitcnt lgkmcnt(" #n ")" ::: "memory")
#define PG8_BAR __builtin_amdgcn_s_barrier()
#define PG8_SCHED __builtin_amdgcn_sched_barrier(0)
    Unit cur, nxt; int ui = 0;
    if (!S.next(0, cur)) return;
    f32x4 acc[2][2][4][2];
#pragma unroll
    for (int a = 0; a < 2; ++a)
#pragma unroll
        for (int b = 0; b < 2; ++b)
#pragma unroll
            for (int m = 0; m < 4; ++m)
#pragma unroll
                for (int n = 0; n < 2; ++n) acc[a][b][m][n] = (f32x4){0.f, 0.f, 0.f, 0.f};
    bf16x8 At[4][2], B0[2][2], B1[2][2];
    const char* cA = (const char*)g.A + (size_t)cur.pm * tstepA + (size_t)cur.pn * cstepA; const char* cB = (const char*)g.Bt + (size_t)cur.pn * tstepB;
    PG8_STAGE(PG8_SB(0, 0), cB, voffB); PG8_STAGE(PG8_SB(0, 1), cB + hstepB, voffB); PG8_STAGE(PG8_SA(0, 0), cA, voffA); PG8_STAGE(PG8_SA(0, 1), cA + hstepA, voffA);
    if (wr == 1) PG8_BAR;
    PG8_WAIT_V(2); PG8_BAR;
    PG8_STAGE(PG8_SB(1, 0), cB + kstep, voffB); PG8_STAGE(PG8_SA(1, 0), cA + kstep, voffA); PG8_STAGE(PG8_SB(1, 1), cB + hstepB + kstep, voffB);
    PG8_WAIT_V(6); PG8_BAR;
    for (;;) {
        const bool has_next = S.next(ui + 1, nxt);
        const char* nA = has_next ? (const char*)g.A + (size_t)nxt.pm * tstepA + (size_t)nxt.pn * cstepA : cA; const char* nB = has_next ? (const char*)g.Bt + (size_t)nxt.pn * tstepB : cB;
        for (int t = 0; t < nt; t += 2) {
            const bool last = (t == nt - 2);
            const char* a1 = cA + (size_t)(t + 1) * kstep;
            const char* a2 = last ? nA : cA + (size_t)(t + 2) * kstep; const char* b2 = last ? nB : cB + (size_t)(t + 2) * kstep;
            const char* a3 = a2 + kstep; const char* b3 = b2 + kstep;
            PG8_LDB(B0, 0, 0); PG8_LDB(B1, 0, 1); PG8_SCHED; PG8_LDA(At, 0, 0); PG8_STAGE(PG8_SA(1, 1), a1 + hstepA, voffA);
            PG8_WAIT_V(8); PG8_WAIT_L(0); PG8_BAR; PG8_MMA(0, 0, At, B0); PG8_MMA(0, 1, At, B1); PG8_BAR; PG8_SCHED;
            PG8_LDA(At, 0, 1); PG8_STAGE(PG8_SB(0, 0), b2, voffB); PG8_STAGE(PG8_SB(0, 1), b2 + hstepB, voffB); PG8_STAGE(PG8_SA(0, 0), a2, voffA);
            PG8_WAIT_V(8); PG8_WAIT_L(0); PG8_BAR; PG8_MMA(1, 0, At, B0); PG8_MMA(1, 1, At, B1); PG8_BAR; PG8_SCHED;
            PG8_LDB(B0, 1, 0); PG8_LDB(B1, 1, 1); PG8_SCHED; PG8_LDA(At, 1, 0); PG8_STAGE(PG8_SA(0, 1), a2 + hstepA, voffA);
            PG8_WAIT_V(8); PG8_WAIT_L(0); PG8_BAR; PG8_MMA(0, 0, At, B0); PG8_MMA(0, 1, At, B1); PG8_BAR; PG8_SCHED;
            PG8_LDA(At, 1, 1); PG8_STAGE(PG8_SB(1, 0), b3, voffB); PG8_STAGE(PG8_SB(1, 1), b3 + hstepB, voffB); PG8_STAGE(PG8_SA(1, 0), a3, voffA);
            PG8_WAIT_V(8); PG8_WAIT_L(0); PG8_BAR; PG8_MMA(1, 0, At, B0); PG8_MMA(1, 1, At, B1); PG8_BAR; PG8_SCHED;
        }
        if (wr == 0) PG8_BAR;
        E(acc, cur, wr, wc, fr, fq);
        if (!has_next) break;
#pragma unroll
        for (int a = 0; a < 2; ++a)
#pragma unroll
            for (int b = 0; b < 2; ++b)
#pragma unroll
                for (int m = 0; m < 4; ++m)
#pragma unroll
                    for (int n = 0; n < 2; ++n) acc[a][b][m][n] = (f32x4){0.f, 0.f, 0.f, 0.f};
        cur = nxt; cA = nA; cB = nB; ++ui;
        if (wr == 1) PG8_BAR;
    }
    PG8_WAIT_V(0);
    PG8_BAR;
#undef PG8_SA
#undef PG8_SB
#undef PG8_STAGE
#undef PG8_LDA
#undef PG8_LDB
#undef PG8_MMA
#undef PG8_WAIT_V
#undef PG8_WAIT_L
#undef PG8_BAR
#undef PG8_SCHED
}
}

struct MatDesc { const float* src; int ldw, K, N; bf16_t* dst; int ldt; const float* ks; const float* ns; };

__device__ __forceinline__ void transpose_item(const MatDesc& d, LAS float* scr, int item, int lane) {
    const int nblk = d.N / 32, kb = item / nblk, nb = item % nblk, k0 = 64 * kb, n0 = 32 * nb;
    const float nsv = d.ns ? d.ns[n0 + (lane & 31)] : 1.f;
#pragma unroll 8
    for (int i = 0; i < 32; ++i) { const int kk = 2 * i + (lane >> 5); float v = d.src[(size_t)(k0 + kk) * d.ldw + n0 + (lane & 31)] * nsv; if (d.ks) v *= d.ks[k0 + kk]; scr[kk * 33 + (lane & 31)] = v; }
    asm volatile("s_waitcnt lgkmcnt(0)" ::: "memory");
    const int c = lane & 7;
#pragma unroll
    for (int j = 0; j < 4; ++j) { const int n = (lane >> 3) + 8 * j; const LAS float* s = scr + (8 * c) * 33 + n;
        u32x4 o; o.x = cvt_pk_bf16(s[0 * 33], s[1 * 33]); o.y = cvt_pk_bf16(s[2 * 33], s[3 * 33]); o.z = cvt_pk_bf16(s[4 * 33], s[5 * 33]); o.w = cvt_pk_bf16(s[6 * 33], s[7 * 33]);
        *(u32x4*)(d.dst + (size_t)(n0 + n) * d.ldt + k0 + 8 * c) = o; }
    asm volatile("s_waitcnt lgkmcnt(0)" ::: "memory");
}

enum { I_X = 0, I_MEM, I_G_MIX, I_G_MEM, I_G_MEMKV, I_G_FFN, I_G_FINAL, I_POOL_W, I_POOL_SCALE, I_SGU_WIN, I_SGU_LNG, I_SGU_LNB, I_SGU_WS, I_SGU_BS, I_SGU_WOUT, I_WQ, I_WKV, I_WO, I_W1, I_W2 };

__device__ __forceinline__ MatDesc get_mat(const Params& P, int id) {
    MatDesc d; d.ks = nullptr; d.ns = nullptr;
    unsigned char* ws = P.ws;
    if (id < 24) {
        const int L = id / 6, t = id % 6;
        if (t == 0)      { d.src = P.in[I_WQ] + (size_t)L * D * D; d.ldw = D; d.K = D; d.N = D; d.dst = (bf16_t*)(ws + WS_WQ) + (size_t)L * D * D; d.ldt = D; d.ks = P.in[I_G_MEM] + L * D; }
        else if (t == 1) { d.src = P.in[I_WKV] + (size_t)L * D * 2 * D; d.ldw = 2 * D; d.K = D; d.N = D; d.dst = (bf16_t*)(ws + WS_WK) + (size_t)L * D * D; d.ldt = D; d.ks = P.in[I_G_MEMKV] + L * D; }
        else if (t == 2) { d.src = P.in[I_WKV] + (size_t)L * D * 2 * D + D; d.ldw = 2 * D; d.K = D; d.N = D; d.dst = (bf16_t*)(ws + WS_WV) + (size_t)L * D * D; d.ldt = D; d.ks = P.in[I_G_MEMKV] + L * D; }
        else if (t == 3) { d.src = P.in[I_WO] + (size_t)L * D * D; d.ldw = D; d.K = D; d.N = D; d.dst = (bf16_t*)(ws + WS_WO) + (size_t)L * D * D; d.ldt = D; }
        else if (t == 4) { d.src = P.in[I_W1] + (size_t)L * D * FF; d.ldw = FF; d.K = D; d.N = FF; d.dst = (bf16_t*)(ws + WS_W1) + (size_t)L * D * FF; d.ldt = D; d.ks = P.in[I_G_FFN] + L * D; }
        else             { d.src = P.in[I_W2] + (size_t)L * D * FF; d.ldw = D; d.K = FF; d.N = D; d.dst = (bf16_t*)(ws + WS_W2) + (size_t)L * D * FF; d.ldt = FF; }
    } else if (id < 28) {
        const int j = (id - 24) >> 1, t = (id - 24) & 1;
        if (t == 0) { d.src = P.in[I_SGU_WIN] + (size_t)j * D * 2 * D; d.ldw = 2 * D; d.K = D; d.N = 2 * D; d.dst = (bf16_t*)(ws + WS_WIN) + (size_t)j * D * 2 * D; d.ldt = D; d.ks = P.in[I_G_MIX] + (2 * j + 1) * D; }
        else        { d.src = P.in[I_SGU_WOUT] + (size_t)j * D * D; d.ldw = D; d.K = D; d.N = D; d.dst = (bf16_t*)(ws + WS_WOUT) + (size_t)j * D * D; d.ldt = D; }
    } else {
        const int jg = id - 28, j = jg >> 2, g = jg & 3;
        d.src = P.in[I_POOL_W] + (size_t)jg * 256 * 256; d.ldw = 256; d.K = 256; d.N = 256; d.dst = (bf16_t*)(ws + WS_PW) + (size_t)jg * 256 * 256; d.ldt = 256;
        d.ks = P.in[I_G_MIX] + (2 * j) * D + g * 256; d.ns = P.in[I_POOL_SCALE] + j * D + g * 256;
    }
    return d;
}
__device__ __forceinline__ int mat_items(int id) {
    if (id < 24) { const int t = id % 6; return (t >= 4) ? 2048 : 512; }
    if (id < 28) return ((id - 24) & 1) ? 512 : 1024;
    return 32;
}

__device__ __forceinline__ void prologue_phase(const Params& P, LAS unsigned char* lds, int G) {
    int tid_ = threadIdx.x; asm volatile("" : "+v"(tid_));
    const int tid = tid_, lane = tid & 63, wave = __builtin_amdgcn_readfirstlane(tid >> 6);
    LAS float* scr = (LAS float*)(lds + wave * 16384);
    const int gw = blockIdx.x * 8 + wave, NGW = G * 8;
    constexpr int NITEMS = 4 * (4 * 512 + 2 * 2048) + 2 * (1024 + 512) + 8 * 32;
    for (int it = gw; it < NITEMS; it += NGW) {
        int r = it, id = 0;
        for (; id < 36; ++id) { const int n = mat_items(id); if (r < n) break; r -= n; }
        const MatDesc d = get_mat(P, id);
        transpose_item(d, scr, r, lane);
    }
    const float* mem = P.in[I_MEM]; bf16_t* memb = (bf16_t*)(P.ws + WS_MEMB); float* rstd_mem = (float*)(P.ws + WS_RSTDMEM);
    for (int r = gw; r < MR; r += NGW) {
        const f32x4* xr = (const f32x4*)(mem + (size_t)r * D) + lane; f32x4 v[4]; float s = 0.f;
#pragma unroll
        for (int j = 0; j < 4; ++j) { v[j] = xr[64 * j]; s += (v[j][0] * v[j][0] + v[j][1] * v[j][1]) + (v[j][2] * v[j][2] + v[j][3] * v[j][3]); }
        s = wave_sum(s);
        if (lane == 0) rstd_mem[r] = 1.0f / sqrtf(s * (1.0f / D) + EPS);
        u32x2* o = (u32x2*)(memb + (size_t)r * D) + lane;
#pragma unroll
        for (int j = 0; j < 4; ++j) { u32x2 w; w.x = cvt_pk_bf16(v[j][0], v[j][1]); w.y = cvt_pk_bf16(v[j][2], v[j][3]); o[64 * j] = w; }
    }
    const float* x = P.in[I_X]; float* ssq0 = (float*)(P.ws + WS_SSQ0);
    for (int r = gw; r < M; r += NGW) {
        const f32x4* xr = (const f32x4*)(x + (size_t)r * D) + lane; float s = 0.f;
#pragma unroll
        for (int j = 0; j < 4; ++j) { const f32x4 v = xr[64 * j]; s += (v[0] * v[0] + v[1] * v[1]) + (v[2] * v[2] + v[3] * v[3]); }
        s = wave_sum(s);
        if (lane < 16) ssq0[(size_t)r * 16 + lane] = (lane == 0) ? s : 0.f;
    }
}

template <int W>
__device__ __forceinline__ void pool_block(const f32x2 (&prev)[16], const f32x2 (&cur)[16], bool seq_start, bf16_t* outp  ) {
#pragma unroll
    for (int i = 0; i < 16; ++i) {
        f32x2 s = cur[i];
#pragma unroll
        for (int j = 1; j < W; ++j) { s += (i - j >= 0) ? cur[(i - j) & 15] : prev[(16 + i - j) & 15]; }
        float inv = 1.0f / (float)W;
        if (i < W - 1 && seq_start) inv = 1.0f / (float)(i + 1);
        const f32x2 o = s * inv - cur[i];
        *(unsigned*)(outp + (size_t)i * D) = cvt_pk_bf16(o[0], o[1]);
    }
}
template <bool F32IN> __device__ __forceinline__ f32x2 pool_ld(const void* x, size_t idx) {
    if (F32IN) return *(const f32x2*)((const float*)x + idx);
    const unsigned r = *(const unsigned*)((const bf16_t*)x + idx); return (f32x2){__uint_as_float(r << 16), __uint_as_float(r & 0xffff0000u)};
}
template <bool F32IN>
__device__ __forceinline__ void pool_a_phase(LAS unsigned char* lds, const void* x, const float* ssq, bf16_t* PA, int G) {
    LAS float* rs = (LAS float*)lds;
    int tid_ = threadIdx.x; asm volatile("" : "+v"(tid_));
    const int tid = tid_, ch = 2 * tid, group = __builtin_amdgcn_readfirstlane(tid >> 7);
    for (int chunk = blockIdx.x; chunk < M / 64; chunk += G) {
        const int t0 = chunk * 64; const bool sstart = (t0 & (SEQ - 1)) == 0;
        __syncthreads();
        if (tid < 80) {
            float r = 0.f;
            if (!(sstart && tid < 16)) { const f32x4* p = (const f32x4*)(ssq + (size_t)(t0 - 16 + tid) * 16); const f32x4 a = p[0], b = p[1], c = p[2], d = p[3];
                const float s = (((a[0] + a[1]) + (a[2] + a[3])) + ((b[0] + b[1]) + (b[2] + b[3]))) + (((c[0] + c[1]) + (c[2] + c[3])) + ((d[0] + d[1]) + (d[2] + d[3])));
                r = 1.0f / sqrtf(s * (1.0f / D) + EPS); }
            rs[tid] = r;
        }
        __syncthreads();
        f32x2 prev[16], cur[16];
        if (sstart) {
#pragma unroll
            for (int i = 0; i < 16; ++i) prev[i] = (f32x2){0.f, 0.f};
        } else {
#pragma unroll
            for (int i = 0; i < 16; ++i) prev[i] = pool_ld<F32IN>(x, (size_t)(t0 - 16 + i) * D + ch) * rs[i];
        }
        for (int blk = 0; blk < 4; ++blk) {
#pragma unroll
            for (int i = 0; i < 16; ++i) cur[i] = pool_ld<F32IN>(x, (size_t)(t0 + blk * 16 + i) * D + ch) * rs[16 + blk * 16 + i];
            bf16_t* outp = PA + (size_t)(t0 + blk * 16) * D + ch;
            const bool ss = sstart && blk == 0;
            if (group == 0) pool_block<2>(prev, cur, ss, outp);
            else if (group == 1) pool_block<4>(prev, cur, ss, outp);
            else if (group == 2) pool_block<8>(prev, cur, ss, outp);
            else pool_block<16>(prev, cur, ss, outp);
#pragma unroll
            for (int i = 0; i < 16; ++i) prev[i] = cur[i];
        }
    }
}

__device__ __forceinline__ void sgu_spatial_phase(LAS unsigned char* lds, const bf16_t* Z, const float* vstat, const float* wsf, const float* bsf, const float* lng, const float* lnb, bf16_t* T1, int G) {
    constexpr int APITCH = 272;
    LAS unsigned char* Aimg = lds;
    LAS unsigned char* VT = lds + 34816;
    LAS float* mu = (LAS float*)(lds + 34816 + 65536); LAS float* rsd = mu + 128;
    int tid_ = threadIdx.x; asm volatile("" : "+v"(tid_));
    const int tid = tid_, lane = tid & 63, wave = __builtin_amdgcn_readfirstlane(tid >> 6);
    const int g = blockIdx.x & 3;
    bool first = true;
    for (int u = blockIdx.x; u < (M / 128) * 4; u += G) {
        const int nb = u >> 2; const size_t rowb = (size_t)nb * 128;
        __syncthreads();
        if (tid < 128) {
            const f32x4* p = (const f32x4*)(vstat + (rowb + tid) * 32); float s1 = 0.f, s2 = 0.f;
#pragma unroll
            for (int i = 0; i < 4; ++i) { const f32x4 a = p[i], b = p[4 + i]; s1 += (a[0] + a[1]) + (a[2] + a[3]); s2 += (b[0] + b[1]) + (b[2] + b[3]); }
            const float m = s1 * (1.0f / D), var = s2 * (1.0f / D) - m * m;
            mu[tid] = m; rsd[tid] = 1.0f / sqrtf(fmaxf(var, 0.f) + EPS);
        }
        if (first) {
            first = false;
            const float* wg = wsf + (size_t)g * 128 * 128;
#pragma unroll
            for (int i = 0; i < 8; ++i) { const int e = (tid + 512 * i) * 4, p = e >> 7, q = e & 127; f32x4 v = *(const f32x4*)(wg + e);
                if ((p >> 6) < (q >> 6)) v = (f32x4){0.f, 0.f, 0.f, 0.f};
                u32x2 w; w.x = cvt_pk_bf16(v[0], v[1]); w.y = cvt_pk_bf16(v[2], v[3]); *(LAS u32x2*)(Aimg + p * APITCH + q * 2) = w; }
        }
        __syncthreads();
        {
            const int cp = tid & 31, c0 = 8 * cp; float gg[8], bb[8];
#pragma unroll
            for (int e = 0; e < 8; ++e) { gg[e] = lng[g * 256 + c0 + e]; bb[e] = lnb[g * 256 + c0 + e]; }
#pragma unroll 2
            for (int i = 0; i < 8; ++i) {
                const int q = (tid >> 5) + 16 * i;
                const u32x4 raw = *(const u32x4*)(Z + (rowb + q) * 2048 + 1024 + g * 256 + c0);
                const float m = mu[q], r = rsd[q];
                const unsigned wv[4] = {raw.x, raw.y, raw.z, raw.w};
#pragma unroll
                for (int e = 0; e < 8; ++e) {
                    const float v = __uint_as_float((e & 1) ? (wv[e >> 1] & 0xffff0000u) : (wv[e >> 1] << 16));
                    const float y = (v - m) * r * gg[e] + bb[e];
                    const unsigned pk = cvt_pk_bf16(y, y);
                    const int c = c0 + e, chunk = (q >> 3) ^ ((c >> 3) & 15) ^ (c & 7);
                    *(LAS unsigned short*)(VT + c * 256 + chunk * 16 + (q & 7) * 2) = (unsigned short)pk;
                }
            }
        }
        __syncthreads();
        f32x4 acc[2][8];
#pragma unroll
        for (int ct = 0; ct < 2; ++ct)
#pragma unroll
            for (int pt = 0; pt < 8; ++pt) acc[ct][pt] = (f32x4){0.f, 0.f, 0.f, 0.f};
        const int l16 = lane & 15, l4 = lane >> 4;
#pragma unroll
        for (int ks = 0; ks < 4; ++ks) {
            bf16x8 af[2], bfr[8];
#pragma unroll
            for (int ct = 0; ct < 2; ++ct) { const int c = wave * 32 + ct * 16 + l16, chunk = (4 * ks + l4) ^ ((c >> 3) & 15) ^ (c & 7); af[ct] = *(const LAS bf16x8*)(VT + c * 256 + chunk * 16); }
#pragma unroll
            for (int pt = 0; pt < 8; ++pt) bfr[pt] = *(const LAS bf16x8*)(Aimg + (pt * 16 + l16) * APITCH + (32 * ks + 8 * l4) * 2);
#pragma unroll
            for (int ct = 0; ct < 2; ++ct)
#pragma unroll
                for (int pt = 0; pt < 8; ++pt) acc[ct][pt] = __builtin_amdgcn_mfma_f32_16x16x32_bf16(af[ct], bfr[pt], acc[ct][pt], 0, 0, 0);
        }
#pragma unroll
        for (int pt = 0; pt < 8; ++pt) {
            const int p = pt * 16 + l16; const float bsv = bsf[g * 128 + p];
#pragma unroll
            for (int ct = 0; ct < 2; ++ct) {
                const int c = g * 256 + wave * 32 + ct * 16 + 4 * l4;
                const u32x2 uu = *(const u32x2*)(Z + (rowb + p) * 2048 + c);
                const float u0 = __uint_as_float(uu.x << 16), u1 = __uint_as_float(uu.x & 0xffff0000u), u2 = __uint_as_float(uu.y << 16), u3 = __uint_as_float(uu.y & 0xffff0000u);
                const f32x4 s = acc[ct][pt] + bsv;
                u32x2 w; w.x = cvt_pk_bf16(u0 * s[0], u1 * s[1]); w.y = cvt_pk_bf16(u2 * s[2], u3 * s[3]);
                *(u32x2*)(T1 + (rowb + p) * D + c) = w;
            }
        }
    }
}

constexpr int ATT_BUF = 36864;
constexpr int ATT_STG = 2 * ATT_BUF, ATT_STG_W = 32 * 144;

__device__ __forceinline__ void attn_issue(int st, int first_unit, int L, const bf16_t* Q, const bf16_t* Kall, const bf16_t* Vtall, u32x4 (&pre)[4], u32x4 (&qpre)[4], int tid) {
    const int unit = first_unit + (st >> 3), chn = st & 7, pm = unit >> 2, h = unit & 3, b = pm >> 4;
    const int lane = tid & 63, wave = tid >> 6;
    const bf16_t* src = ((chn < 4) ? Kall : Vtall) + ((size_t)((L * 16 + b) * 4 + h) << 16) + (chn & 3) * 16384;
#pragma unroll
    for (int i = 0; i < 4; ++i) pre[i] = *(const u32x4*)(src + (size_t)(tid + 512 * i) * 8);
    if (chn < 4) {
        const bf16_t* qp = Q + (size_t)(pm * 256 + wave * 32 + (lane >> 3)) * D + h * 256 + chn * 64 + (lane & 7) * 8;
#pragma unroll
        for (int j = 0; j < 4; ++j) qpre[j] = *(const u32x4*)(qp + (size_t)(8 * j) * D);
    }
}
__device__ __forceinline__ void attn_commit(int st, LAS unsigned char* lds, const u32x4 (&pre)[4], const u32x4 (&qpre)[4], int tid) {
    LAS unsigned char* buf = lds + (st & 1) * ATT_BUF; const int chn = st & 7;
    const int lane = tid & 63, wave = tid >> 6;
    if (chn < 4) {
#pragma unroll
        for (int i = 0; i < 4; ++i) { const int p = tid + 512 * i, rho = p >> 3, part = p & 7; *(LAS u32x4*)(buf + rho * 144 + part * 16) = pre[i]; }
        LAS unsigned char* stg = lds + ATT_STG + wave * ATT_STG_W;
#pragma unroll
        for (int j = 0; j < 4; ++j) *(LAS u32x4*)(stg + ((lane >> 3) + 8 * j) * 144 + (lane & 7) * 16) = qpre[j];
    } else {
#pragma unroll
        for (int i = 0; i < 4; ++i) { const int p = tid + 512 * i, r = p >> 5, part = p & 31; *(LAS u32x4*)(buf + r * 528 + part * 16) = pre[i]; }
    }
}

__device__ __forceinline__ void attn_phase(LAS unsigned char* lds, const bf16_t* Q, const bf16_t* Kall, const bf16_t* Vtall, bf16_t* O, int L, int G) {
    int tid_ = threadIdx.x; asm volatile("" : "+v"(tid_));
    const int tid = tid_, lane = tid & 63, wave = __builtin_amdgcn_readfirstlane(tid >> 6), l32 = lane & 31, half = lane >> 5;
    const int bx = blockIdx.x, vcu = (G % 8 == 0) ? (bx % 8) * (G / 8) + bx / 8 : bx;
    const int nper = (1024 + G - 1) / G, first_unit = vcu * nper;
    int nunits = 1024 - first_unit; if (nunits > nper) nunits = nper; if (nunits <= 0) return;
    const int nsteps = nunits * 8;
    LAS unsigned char* stg = lds + ATT_STG + wave * ATT_STG_W;
    u32x4 pre[4], qpre[4];
    __syncthreads();
    attn_issue(0, first_unit, L, Q, Kall, Vtall, pre, qpre, tid);
    attn_commit(0, lds, pre, qpre, tid);
    __syncthreads();
    int st = 0;
    for (int ui = 0; ui < nunits; ++ui) {
        const int unit = first_unit + ui, pm = unit >> 2, h = unit & 3;
        f32x16 S[8];
#pragma unroll
        for (int mt = 0; mt < 8; ++mt)
#pragma unroll
            for (int i = 0; i < 16; ++i) S[mt][i] = 0.f;
        for (int kc = 0; kc < 4; ++kc, ++st) {
            if (st + 1 < nsteps) attn_issue(st + 1, first_unit, L, Q, Kall, Vtall, pre, qpre, tid);
            const LAS unsigned char* buf = lds + (st & 1) * ATT_BUF;
#pragma unroll
            for (int ks = 0; ks < 4; ++ks) {
                const bf16x8 qk = *(const LAS bf16x8*)(stg + l32 * 144 + ks * 32 + half * 16);
#pragma unroll
                for (int mh = 0; mh < 2; ++mh) {
                    bf16x8 kf[4];
#pragma unroll
                    for (int mt = 0; mt < 4; ++mt) kf[mt] = *(const LAS bf16x8*)(buf + (32 * (4 * mh + mt) + l32) * 144 + ks * 32 + half * 16);
                    __builtin_amdgcn_sched_barrier(0);
#pragma unroll
                    for (int mt = 0; mt < 4; ++mt) S[4 * mh + mt] = __builtin_amdgcn_mfma_f32_32x32x16_bf16(kf[mt], qk, S[4 * mh + mt], 0, 0, 0);
                    __builtin_amdgcn_sched_barrier(0);
                }
            }
            asm volatile("" ::: "memory");
            if (st + 1 < nsteps) attn_commit(st + 1, lds, pre, qpre, tid);
            asm volatile("s_waitcnt lgkmcnt(0)" ::: "memory"); __builtin_amdgcn_s_barrier(); asm volatile("" ::: "memory");
        }
        float mx = -3.0e38f;
#pragma unroll
        for (int mt = 0; mt < 8; ++mt)
#pragma unroll
            for (int i = 0; i < 16; ++i) mx = fmaxf(mx, S[mt][i]);
        mx = fmaxf(mx, __shfl_xor(mx, 32));
        float lsum = 0.f;
        bf16x8 pf[8][2];
#pragma unroll
        for (int mt = 0; mt < 8; ++mt) {
#pragma unroll
            for (int i = 0; i < 16; ++i) { const float p = __builtin_amdgcn_exp2f(S[mt][i] - mx); S[mt][i] = p; lsum += p; }
#pragma unroll
            for (int s2 = 0; s2 < 2; ++s2) { u32x4 w; w.x = cvt_pk_bf16(S[mt][8 * s2 + 0], S[mt][8 * s2 + 1]); w.y = cvt_pk_bf16(S[mt][8 * s2 + 2], S[mt][8 * s2 + 3]);
                w.z = cvt_pk_bf16(S[mt][8 * s2 + 4], S[mt][8 * s2 + 5]); w.w = cvt_pk_bf16(S[mt][8 * s2 + 6], S[mt][8 * s2 + 7]); pf[mt][s2] = __builtin_bit_cast(bf16x8, w); }
        }
        lsum += __shfl_xor(lsum, 32);
        const float inv = 1.0f / lsum;
        bf16_t* obase = O + (size_t)(pm * 256 + wave * 32 + (lane >> 3)) * D + h * 256 + (lane & 7) * 8;
        for (int vc = 0; vc < 4; ++vc, ++st) {
            if (st + 1 < nsteps) attn_issue(st + 1, first_unit, L, Q, Kall, Vtall, pre, qpre, tid);
            const LAS unsigned char* buf = lds + (st & 1) * ATT_BUF;
            f32x16 o[2];
#pragma unroll
            for (int ht = 0; ht < 2; ++ht)
#pragma unroll
                for (int i = 0; i < 16; ++i) o[ht][i] = 0.f;
#pragma unroll
            for (int mp = 0; mp < 4; ++mp) {
                bf16x8 vf[2][2][2];
#pragma unroll
                for (int mi = 0; mi < 2; ++mi)
#pragma unroll
                    for (int s2 = 0; s2 < 2; ++s2)
#pragma unroll
                        for (int ht = 0; ht < 2; ++ht) vf[mi][s2][ht] = *(const LAS bf16x8*)(buf + (32 * ht + l32) * 528 + (32 * (2 * mp + mi) + 16 * s2 + 8 * half) * 2);
                __builtin_amdgcn_sched_barrier(0);
#pragma unroll
                for (int mi = 0; mi < 2; ++mi)
#pragma unroll
                    for (int s2 = 0; s2 < 2; ++s2)
#pragma unroll
                        for (int ht = 0; ht < 2; ++ht) o[ht] = __builtin_amdgcn_mfma_f32_32x32x16_bf16(vf[mi][s2][ht], pf[2 * mp + mi][s2], o[ht], 0, 0, 0);
                __builtin_amdgcn_sched_barrier(0);
            }
            asm volatile("" ::: "memory");
#pragma unroll
            for (int ht = 0; ht < 2; ++ht)
#pragma unroll
                for (int i4 = 0; i4 < 4; ++i4) {
                    u32x2 w; w.x = cvt_pk_bf16(o[ht][4 * i4 + 0] * inv, o[ht][4 * i4 + 1] * inv); w.y = cvt_pk_bf16(o[ht][4 * i4 + 2] * inv, o[ht][4 * i4 + 3] * inv);
                    *(LAS u32x2*)(stg + l32 * 144 + (ht * 32 + i4 * 8 + half * 4) * 2) = w;
                }
            asm volatile("s_waitcnt lgkmcnt(0)" ::: "memory");
#pragma unroll
            for (int j = 0; j < 4; ++j) {
                const u32x4 v = *(const LAS u32x4*)(stg + ((lane >> 3) + 8 * j) * 144 + (lane & 7) * 16);
                __builtin_nontemporal_store(v, (u32x4*)(obase + (size_t)(8 * j) * D + vc * 64));
            }
            asm volatile("" ::: "memory");
            if (st + 1 < nsteps) attn_commit(st + 1, lds, pre, qpre, tid);
            asm volatile("s_waitcnt lgkmcnt(0)" ::: "memory"); __builtin_amdgcn_s_barrier(); asm volatile("" ::: "memory");
        }
    }
}

__device__ __forceinline__ void final_norm_phase(const bf16_t* xb, float* out, const float* gain, int G) {
    int tid_ = threadIdx.x; asm volatile("" : "+v"(tid_));
    const int tid = tid_, lane = tid & 63, wave = tid >> 6, gw = blockIdx.x * 8 + wave, NGW = G * 8;
    f32x4 gv[4];
#pragma unroll
    for (int j = 0; j < 2; ++j) { gv[2 * j] = *(const f32x4*)(gain + 512 * j + 8 * lane); gv[2 * j + 1] = *(const f32x4*)(gain + 512 * j + 8 * lane + 4); }
    for (int r = gw; r < M; r += NGW) {
        f32x4 v[4]; float s = 0.f;
#pragma unroll
        for (int j = 0; j < 2; ++j) { const u32x4 q = *(const u32x4*)(xb + (size_t)r * D + 512 * j + 8 * lane);
            v[2 * j] = (f32x4){__uint_as_float(q.x << 16), __uint_as_float(q.x & 0xffff0000u), __uint_as_float(q.y << 16), __uint_as_float(q.y & 0xffff0000u)};
            v[2 * j + 1] = (f32x4){__uint_as_float(q.z << 16), __uint_as_float(q.z & 0xffff0000u), __uint_as_float(q.w << 16), __uint_as_float(q.w & 0xffff0000u)}; }
#pragma unroll
        for (int j = 0; j < 4; ++j) s += (v[j][0] * v[j][0] + v[j][1] * v[j][1]) + (v[j][2] * v[j][2] + v[j][3] * v[j][3]);
        s = wave_sum(s);
        const float rs = 1.0f / sqrtf(s * (1.0f / D) + EPS);
#pragma unroll
        for (int j = 0; j < 2; ++j) { *(f32x4*)(out + (size_t)r * D + 512 * j + 8 * lane) = v[2 * j] * rs * gv[2 * j]; *(f32x4*)(out + (size_t)r * D + 512 * j + 8 * lane + 4) = v[2 * j + 1] * rs * gv[2 * j + 1]; }
    }
}

#define XB_TMO      128
#define XB_XCNT(j)  (256  + 64 * (j))
#define XB_XSUB(j)  (1280 + 64 * (j))
#define XB_XGEN(j)  (2304 + 64 * (j))
#define XB_TOP      3328
#define XB_TOPGEN   3392
#define XCD_BAR_WORDS 3456
#define XB_SPIN_CAP (1u << 20)
__device__ __forceinline__ unsigned xb_ld(unsigned* p)              { return __hip_atomic_load(p, __ATOMIC_RELAXED, __HIP_MEMORY_SCOPE_AGENT); }
__device__ __forceinline__ unsigned xb_add(unsigned* p, unsigned v) { return __hip_atomic_fetch_add(p, v, __ATOMIC_RELAXED, __HIP_MEMORY_SCOPE_AGENT); }
__device__ __forceinline__ unsigned xb_xcc_id() { return (unsigned)__builtin_amdgcn_s_getreg((3 << 11) | 20) & 0xFu; }
#define XB_SPIN(cond, bar) do { unsigned _sp = 0; while (cond) { __builtin_amdgcn_s_sleep(1); \
    if ((++_sp & 255u) == 0u) { if (xb_ld(&(bar)[XB_TMO])) break; if (_sp > XB_SPIN_CAP) { atomicAdd(&(bar)[XB_TMO], 1u); break; } } } } while (0)
struct XcdBarrier { unsigned* bar; unsigned x; volatile LAS unsigned* st; };
__device__ __forceinline__ XcdBarrier xcd_barrier_post(unsigned* bar, volatile LAS unsigned* st) {
    XcdBarrier b; b.bar = bar; b.x = xb_xcc_id(); b.st = st;
    if (threadIdx.x == 0) (void)xb_add(&bar[XB_XCNT(b.x)], 1u);
    return b;
}
__device__ __forceinline__ void xcd_barrier_complete(unsigned* bar, unsigned x, unsigned& nloc, unsigned& nx) {
    const unsigned G = gridDim.x * gridDim.y * gridDim.z;
    unsigned sum, cnt, mine, sp = 0u;
    for (;;) {
        sum = 0u; cnt = 0u; mine = 0u;
#pragma unroll
        for (unsigned j = 0; j < 16; ++j) { const unsigned c = xb_ld(&bar[XB_XCNT(j)]); sum += c; cnt += (c > 0u) ? 1u : 0u; mine = (j == x) ? c : mine; }
        if (sum == G) break;
        __builtin_amdgcn_s_sleep(1);
        if ((++sp & 255u) == 0u) { if (xb_ld(&bar[XB_TMO])) break; if (sp > XB_SPIN_CAP) { atomicAdd(&bar[XB_TMO], 1u); break; } }
    }
    nloc = mine > 0u ? mine : 1u; nx = cnt > 0u ? cnt : 1u;
}
__device__ __forceinline__ void xcd_barrier(const XcdBarrier& b) {
    asm volatile("s_waitcnt vmcnt(0)" ::: "memory");
    __syncthreads();
    if (threadIdx.x == 0) {
        unsigned* bar = b.bar;
        __builtin_amdgcn_s_waitcnt(0);
        unsigned nloc = b.st[0], nx = b.st[1];
        if (nloc == 0u) { xcd_barrier_complete(bar, b.x, nloc, nx); b.st[0] = nloc; b.st[1] = nx; }
        const unsigned old = xb_add(&bar[XB_XSUB(b.x)], 1u);
        const unsigned gen = old / nloc;
        if (old + 1u == (gen + 1u) * nloc) {
            __builtin_amdgcn_fence(__ATOMIC_RELEASE, "agent");
            asm volatile("s_waitcnt vmcnt(0)" ::: "memory");
            const unsigned og = xb_add(&bar[XB_TOP], 1u);
            const unsigned tg = og / nx;
            if (og + 1u == (tg + 1u) * nx) xb_add(&bar[XB_TOPGEN], 1u);
            else XB_SPIN(xb_ld(&bar[XB_TOPGEN]) == tg, bar);
            __builtin_amdgcn_fence(__ATOMIC_ACQUIRE, "agent");
            xb_add(&bar[XB_XGEN(b.x)], 1u);
            asm volatile("s_waitcnt vmcnt(0)" ::: "memory");
        } else {
            XB_SPIN(xb_ld(&bar[XB_XGEN(b.x)]) == gen, bar);
            __builtin_amdgcn_fence(__ATOMIC_ACQUIRE, "agent");
            asm volatile("s_waitcnt vmcnt(0)" ::: "memory");
        }
    }
    __syncthreads();
}

constexpr int NPHASES = 35;
__host__ __device__ inline bool phase_empty(int ph) { if (ph < 2 || ph >= 34) return false; const int L = (ph - 2) >> 3, k = (ph - 2) & 7; return k == 2 && (L & 1) == 0; }

__global__ void __launch_bounds__(512, 2) fwd_megakernel(Params P) {
    extern __shared__ __attribute__((aligned(16))) unsigned char lds_raw[];
    LAS unsigned char* lds = (LAS unsigned char*)lds_raw;
    cg::grid_group grid = cg::this_grid();
    const int G = gridDim.x;
    unsigned char* ws = P.ws;
    bf16_t* T1 = (bf16_t*)(ws + WS_T1); bf16_t* OB = (bf16_t*)(ws + WS_O); bf16_t* ZB = (bf16_t*)(ws + WS_Z); bf16_t* HB = (bf16_t*)(ws + WS_H);
    bf16_t* XB = (bf16_t*)(ws + WS_XB); bf16_t* KALL = (bf16_t*)(ws + WS_KALL); bf16_t* VTALL = (bf16_t*)(ws + WS_VTALL); bf16_t* MEMB = (bf16_t*)(ws + WS_MEMB);
    float* SSQ[2] = {(float*)(ws + WS_SSQ0), (float*)(ws + WS_SSQ1)};
    float* VSTAT = (float*)(ws + WS_VSTAT); float* RSTDMEM = (float*)(ws + WS_RSTDMEM);
    volatile LAS unsigned* MISC = (volatile LAS unsigned*)(lds + 131072 + 320);
    if (threadIdx.x < 32) MISC[threadIdx.x] = 0u;
    __syncthreads();
    XcdBarrier bar; bar.bar = (unsigned*)(ws + WS_CTL); bar.x = 0; bar.st = MISC + 8;
    if (P.ph_hi - P.ph_lo > 1) bar = xcd_barrier_post((unsigned*)(ws + WS_CTL), MISC + 8);

    for (int ph = P.ph_lo; ph < P.ph_hi; ++ph) {
        if (phase_empty(ph)) continue;
        if (ph == 0) {
            prologue_phase(P, lds, G);
        } else if (ph == 1) {
            pg8::StaticOrder S; S.init(MR, 4096, G, (int)blockIdx.x);
            { pg8::Gemm g{MEMB, (const bf16_t*)(ws + WS_WK), MR, 4096, D, D, D, 0}; pg8::EpiAct<4> E{KALL, 4096, nullptr, 1.f, RSTDMEM, nullptr}; pg8::gemm_phase(lds, g, S, E); }
            { pg8::Gemm g{(const bf16_t*)(ws + WS_WV), MEMB, 4096, MR, D, D, D, 0}; pg8::EpiAct<3> E{VTALL, 4096, nullptr, 1.f, RSTDMEM, nullptr}; pg8::gemm_phase(lds, g, S, E); }
        } else if (ph == 34) {
            final_norm_phase(XB, P.out, P.in[I_G_FINAL], G);
        } else {
            const int L = (ph - 2) >> 3, k = (ph - 2) & 7, j = L >> 1; const bool odd = (L & 1) != 0;
            if (k == 0) {
                const float* ssq_r = SSQ[(3 * L) & 1];
                if (!odd) { if (L == 0) pool_a_phase<true>(lds, P.in[I_X], ssq_r, T1, G); else pool_a_phase<false>(lds, XB, ssq_r, T1, G); }
                else { pg8::Gemm g{XB, (const bf16_t*)(ws + WS_WIN) + (size_t)j * D * 2 * D, M, 2 * D, D, D, D, 0}; pg8::StaticOrder S; S.init(M, 2 * D, G, (int)blockIdx.x);
                    pg8::EpiAct<2> E{ZB, 2 * D, ssq_r, 1.f, nullptr, VSTAT}; pg8::gemm_phase(lds, g, S, E); }
            } else if (k == 1 && odd) {
                sgu_spatial_phase(lds, ZB, VSTAT, P.in[I_SGU_WS] + (size_t)j * 4 * 128 * 128, P.in[I_SGU_BS] + j * 512, P.in[I_SGU_LNG] + j * D, P.in[I_SGU_LNB] + j * D, T1, G);
            } else if (k == 3) {
                pg8::Gemm g{XB, (const bf16_t*)(ws + WS_WQ) + (size_t)L * D * D, M, D, D, D, D, 0}; pg8::StaticOrder S; S.init(M, D, G, (int)blockIdx.x);
                pg8::EpiAct<0> E{T1, D, SSQ[(3 * L + 1) & 1], QSCALE, nullptr, nullptr}; pg8::gemm_phase(lds, g, S, E);
            } else if (k == 4) {
                attn_phase(lds, T1, KALL, VTALL, OB, L, G);
            } else if (k == 6) {
                pg8::Gemm g{XB, (const bf16_t*)(ws + WS_W1) + (size_t)L * D * FF, M, FF, D, D, D, 0}; pg8::StaticOrder S; S.init(M, FF, G, (int)blockIdx.x);
                pg8::EpiAct<1> E{HB, FF, SSQ[(3 * L + 2) & 1], 1.f, nullptr, nullptr}; pg8::gemm_phase(lds, g, S, E);
            } else {
                pg8::Gemm g; int upd;
                if (k == 1)      { g = pg8::Gemm{T1, (const bf16_t*)(ws + WS_PW) + (size_t)j * 4 * 256 * 256, M, D, 256, D, 256, 256}; upd = 3 * L; }
                else if (k == 2) { g = pg8::Gemm{T1, (const bf16_t*)(ws + WS_WOUT) + (size_t)j * D * D, M, D, D, D, D, 0}; upd = 3 * L; }
                else if (k == 5) { g = pg8::Gemm{OB, (const bf16_t*)(ws + WS_WO) + (size_t)L * D * D, M, D, D, D, D, 0}; upd = 3 * L + 1; }
                else             { g = pg8::Gemm{HB, (const bf16_t*)(ws + WS_W2) + (size_t)L * D * FF, M, D, FF, FF, FF, 0}; upd = 3 * L + 2; }
                pg8::StaticOrder S; S.init(M, D, G, (int)blockIdx.x);
                if (ph == 3) { pg8::EpiResid<true> E{P.in[I_X], XB, SSQ[(upd + 1) & 1]}; pg8::gemm_phase(lds, g, S, E); }
                else { pg8::EpiResid<false> E{nullptr, XB, SSQ[(upd + 1) & 1]}; pg8::gemm_phase(lds, g, S, E); }
            }
        }
        if (ph + 1 < P.ph_hi) { if (ph == 0) grid.sync(); else xcd_barrier(bar); }
    }
}

extern "C" void kernel_launch(void* const* d_in, const int* in_sizes, int n_in, void* d_out, int out_size, void* d_ws, size_t ws_size, hipStream_t stream) {
    static int grid = 0;
    if (grid == 0) {
        if (n_in != 20 || in_sizes[0] != M * D || out_size != M * D || ws_size < WS_END) { fprintf(stderr, "kernel_launch: unexpected shapes (n_in %d, in0 %d, out %d, ws %zu); nothing launched\n", n_in, n_in > 0 ? in_sizes[0] : -1, out_size, ws_size); grid = -1; return; }
        int dev = 0, cus = 0, per_cu = 0;
        if (hipGetDevice(&dev) != hipSuccess || hipDeviceGetAttribute(&cus, hipDeviceAttributeMultiprocessorCount, dev) != hipSuccess) { grid = -1; return; }
        if (hipFuncSetAttribute((const void*)fwd_megakernel, hipFuncAttributeMaxDynamicSharedMemorySize, LDS_BYTES) != hipSuccess) { fprintf(stderr, "kernel_launch: hipFuncSetAttribute failed\n"); grid = -1; return; }
        if (hipOccupancyMaxActiveBlocksPerMultiprocessor(&per_cu, (const void*)fwd_megakernel, 512, LDS_BYTES) != hipSuccess || per_cu < 1) { fprintf(stderr, "kernel_launch: occupancy query gave %d\n", per_cu); per_cu = 1; }
        (void)hipGetLastError();
        grid = cus * per_cu;
        if (grid > 256) grid = 256;
        grid &= ~7;
        if (grid < 8) { grid = -1; return; }
    }
    if (grid < 0) return;
    Params p{};
    for (int i = 0; i < 20; ++i) p.in[i] = (const float*)d_in[i];
    p.out = (float*)d_out; p.ws = (unsigned char*)d_ws;
#if MK_SINGLE
    p.ph_lo = 0; p.ph_hi = NPHASES;
    if (hipMemsetAsync((char*)d_ws + WS_CTL, 0, CTL_BYTES, stream) != hipSuccess) { fprintf(stderr, "kernel_launch: memset failed\n"); return; }
    void* args[] = {&p};
    hipError_t e = hipLaunchCooperativeKernel((const void*)fwd_megakernel, dim3(grid), dim3(512), args, LDS_BYTES, stream);
    if (e != hipSuccess) fprintf(stderr, "kernel_launch: cooperative launch failed: %s (grid %d)\n", hipGetErrorString(e), grid);
#else
    for (int ph = 0; ph < NPHASES; ++ph) {
        if (phase_empty(ph)) continue;
        p.ph_lo = ph; p.ph_hi = ph + 1;
        hipLaunchKernelGGL(fwd_megakernel, dim3(grid), dim3(512), LDS_BYTES, stream, p);
    }
#endif
}
```

```cpp
#include <hip/hip_runtime.h>
#include <hip/hip_cooperative_groups.h>
#include <cstdio>
#include <cstdint>
namespace cg = cooperative_groups;

#ifndef MK_SINGLE
#define MK_SINGLE 1
#endif

#define LAS __attribute__((address_space(3)))
typedef unsigned short bf16_t;
typedef short bf16x8 __attribute__((ext_vector_type(8)));
typedef float f32x4 __attribute__((ext_vector_type(4)));
typedef float f32x2 __attribute__((ext_vector_type(2)));
typedef float f32x16 __attribute__((ext_vector_type(16)));
typedef unsigned u32x4 __attribute__((ext_vector_type(4)));
typedef unsigned u32x2 __attribute__((ext_vector_type(2)));

constexpr int D = 1024, BATCH = 16, SEQ = 4096, DEPTH = 4, FF = 4096, NMEM = 256;
constexpr int M = BATCH * SEQ;
constexpr int MR = BATCH * NMEM;
constexpr float EPS = 1e-6f;
constexpr float QSCALE = 0.0625f * 1.4426950408889634f;

constexpr size_t MiB = 1u << 20;
constexpr size_t WS_H = 0, WS_T1 = 0, WS_O = 128 * MiB, WS_Z = 256 * MiB;
constexpr size_t WS_XB = 512 * MiB;
constexpr size_t WS_KALL = 640 * MiB, WS_VTALL = 672 * MiB, WS_MEMB = 704 * MiB;
constexpr size_t WS_SSQ0 = 712 * MiB, WS_SSQ1 = 716 * MiB, WS_VSTAT = 720 * MiB, WS_RSTDMEM = 728 * MiB;
constexpr size_t WS_CTL = 730 * MiB, CTL_BYTES = 16384;
constexpr size_t WS_WQ = 736 * MiB, WS_WO = 744 * MiB, WS_W1 = 752 * MiB, WS_W2 = 784 * MiB, WS_WK = 816 * MiB, WS_WV = 824 * MiB;
constexpr size_t WS_WIN = 832 * MiB, WS_WOUT = 840 * MiB, WS_PW = 844 * MiB, WS_END = 845 * MiB;

constexpr int LDS_BYTES = 147456;

struct Params {
    const float* in[20];
    float* out;
    unsigned char* ws;
    int ph_lo, ph_hi;
};

__device__ __forceinline__ unsigned cvt_pk_bf16(float lo, float hi) { unsigned r; asm volatile("v_cvt_pk_bf16_f32 %0, %1, %2" : "=v"(r) : "v"(lo), "v"(hi)); return r; }
__device__ __forceinline__ float wave_sum(float v) {
#pragma unroll
    for (int o = 1; o < 64; o <<= 1) v += __shfl_xor(v, o);
    return v;
}
__device__ __forceinline__ float gelu_tanh(float x) {
    const float y = 0.7978845608028654f * (x + 0.044715f * x * x * x);
    const float e = __builtin_amdgcn_exp2f(-2.0f * 1.4426950408889634f * y);
    return x * __builtin_amdgcn_rcpf(1.0f + e);
}

__device__ __forceinline__ int sig23(int r) { return (r & ~12) | ((r & 4) << 1) | ((r & 8) >> 1); }
namespace pg8 {
constexpr int BM = 256, BK = 64, HALF = 128, HTB = HALF * BK * 2, STAGE_BYTES = 8 * HTB, NXCD = 8, WGM = 8;
__host__ __device__ __forceinline__ int lds_byte(int r, int c) { const int st = (r >> 4) * 2 + (c >> 5), rr = r & 15, cc = c & 31, ob = rr * 64 + cc * 2; return st * 1024 + (ob ^ (((ob >> 9) & 1) << 5)); }
__host__ __device__ __forceinline__ void stage_rc(int b, int& R, int& C) { const int st = b / 1024, sb = b % 1024, swz = sb ^ (((sb >> 9) & 1) << 5); R = (st >> 1) * 16 + swz / 64; C = (st & 1) * 32 + (swz % 64) / 2; }
__host__ __device__ __forceinline__ int perm32(int rho) { const int n = rho >> 4, i = rho & 15; return 8 * (i >> 2) + 4 * n + (i & 3); }

struct Unit { int pm, pn; };
struct Gemm { const bf16_t* A; const bf16_t* Bt; int M, N, K, lda, ldb, acol; };

struct StaticOrder {
    int nM, nN, nwg, G, c;
    __device__ void init(int M_, int N_, int G_, int c_) { nM = M_ / BM; nN = N_ / BM; nwg = nM * nN; G = G_; c = c_; }
    __device__ bool next(int i, Unit& u) const {
        const long L = (long)i * G + c; if (L >= nwg) return false;
        int wgid = (int)L; { const int q = nwg / NXCD, r = nwg % NXCD, xcd = wgid % NXCD, off = wgid / NXCD; wgid = (xcd < r ? xcd * (q + 1) : r * (q + 1) + (xcd - r) * q) + off; }
        const int nig = WGM * nN, gid = wgid / nig, fm = gid * WGM, gsz = (nM - fm) < WGM ? (nM - fm) : WGM;
        u.pm = fm + ((wgid % nig) % gsz); u.pn = (wgid % nig) / gsz; return true;
    }
};

__device__ __forceinline__ float rstd_from_slots(const float* ssq, int row, int fq) {
    const f32x4 v = *(const f32x4*)(ssq + (size_t)row * 16 + fq * 4);
    float s = (v[0] + v[1]) + (v[2] + v[3]);
    s += __shfl_xor(s, 16); s += __shfl_xor(s, 32);
    return __builtin_amdgcn_rsqf(s * (1.0f / 1024.0f) + EPS);
}

template <int MODE> struct EpiAct {
    bf16_t* O; int ldc; const float* ssq; float scale; const float* rvec; float* vstat;
    __device__ __forceinline__ void operator()(const f32x4 (&acc)[2][2][4][2], const Unit& u, int wr, int wc, int fr, int fq) const {
        const int row0 = u.pm * BM + wr * 64 + fr, col0 = u.pn * BM + wc * 32 + 8 * fq;
        f32x4 cs[2][2];
        if (MODE == 3) {
#pragma unroll
            for (int bj = 0; bj < 2; ++bj) { cs[bj][0] = *(const f32x4*)(rvec + col0 + bj * HALF); cs[bj][1] = *(const f32x4*)(rvec + col0 + bj * HALF + 4); }
        }
#pragma unroll
        for (int ai = 0; ai < 2; ++ai)
#pragma unroll
            for (int m = 0; m < 4; ++m) {
                const int row = row0 + ai * HALF + m * 16;
                float rs = 1.f;
                if (MODE == 0 || MODE == 1 || MODE == 2) rs = rstd_from_slots(ssq, row, fq);
                if (MODE == 0) rs *= scale;
                if (MODE == 4) rs = rvec[row];
                bf16_t* rowp = O + (size_t)row * ldc + col0;
                if (MODE == 4) { const int b = row >> 8, n = row & 255; rowp = O + ((size_t)(b * 4) << 16) + (sig23(n) << 6); }
                if (MODE == 3) { const int Lh = row >> 8, d = row & 255; rowp = O + ((size_t)((Lh >> 2) * 64 + (Lh & 3)) << 16) + ((d >> 6) << 14) + ((d & 63) << 8); }
                float s1 = 0.f, s2 = 0.f;
#pragma unroll
                for (int bj = 0; bj < 2; ++bj) {
                    f32x4 v0 = acc[ai][bj][m][0] * rs, v1 = acc[ai][bj][m][1] * rs;
                    if (MODE == 3) { v0 = acc[ai][bj][m][0] * cs[bj][0]; v1 = acc[ai][bj][m][1] * cs[bj][1]; }
                    if (MODE == 1) {
#pragma unroll
                        for (int j = 0; j < 4; ++j) { const float a = v0[j] > 0.f ? v0[j] : 0.f, b = v1[j] > 0.f ? v1[j] : 0.f; v0[j] = a * a; v1[j] = b * b; }
                    }
                    if (MODE == 2) {
#pragma unroll
                        for (int j = 0; j < 4; ++j) { v0[j] = gelu_tanh(v0[j]); v1[j] = gelu_tanh(v1[j]); }
#pragma unroll
                        for (int j = 0; j < 4; ++j) { s1 += v0[j] + v1[j]; s2 += v0[j] * v0[j] + v1[j] * v1[j]; }
                    }
                    u32x4 w; w.x = cvt_pk_bf16(v0[0], v0[1]); w.y = cvt_pk_bf16(v0[2], v0[3]); w.z = cvt_pk_bf16(v1[0], v1[1]); w.w = cvt_pk_bf16(v1[2], v1[3]);
                    bf16_t* sp = rowp + bj * HALF;
                    if (MODE == 4) { const int col = col0 + bj * HALF, L = col >> 10, h = (col >> 8) & 3, d = col & 255; sp = rowp + ((size_t)(L * 64 + h) << 16) + ((d >> 6) << 14) + (d & 63); }
                    if (MODE == 3) { const int col = col0 + bj * HALF, b = col >> 8, n = col & 255; sp = rowp + ((size_t)(b * 4) << 16) + n; }
                    __builtin_nontemporal_store(w, (u32x4*)sp);
                }
                if (MODE == 2) {
                    s1 += __shfl_xor(s1, 16); s1 += __shfl_xor(s1, 32); s2 += __shfl_xor(s2, 16); s2 += __shfl_xor(s2, 32);
                    if (u.pn >= 4 && fq == 0) { vstat[(size_t)row * 32 + (u.pn - 4) * 4 + wc] = s1; vstat[(size_t)row * 32 + 16 + (u.pn - 4) * 4 + wc] = s2; }
                }
            }
    }
};
template <bool F32IN> struct EpiResid {
    const float* xin; bf16_t* xb; float* ssq;
    __device__ __forceinline__ void operator()(const f32x4 (&acc)[2][2][4][2], const Unit& u, int wr, int wc, int fr, int fq) const {
        const int row0 = u.pm * BM + wr * 64 + fr, col0 = u.pn * BM + wc * 32 + 8 * fq;
#pragma unroll
        for (int ai = 0; ai < 2; ++ai)
#pragma unroll
            for (int m = 0; m < 4; ++m) {
                const int row = row0 + ai * HALF + m * 16; const size_t off = (size_t)row * D + col0;
                float ss = 0.f;
#pragma unroll
                for (int bj = 0; bj < 2; ++bj) {
                    f32x4 a0, a1;
                    if (F32IN) { a0 = *(const f32x4*)(xin + off + bj * HALF); a1 = *(const f32x4*)(xin + off + bj * HALF + 4); }
                    else { const u32x4 r = *(const u32x4*)(xb + off + bj * HALF);
                        a0 = (f32x4){__uint_as_float(r.x << 16), __uint_as_float(r.x & 0xffff0000u), __uint_as_float(r.y << 16), __uint_as_float(r.y & 0xffff0000u)};
                        a1 = (f32x4){__uint_as_float(r.z << 16), __uint_as_float(r.z & 0xffff0000u), __uint_as_float(r.w << 16), __uint_as_float(r.w & 0xffff0000u)}; }
                    const f32x4 v0 = a0 + acc[ai][bj][m][0], v1 = a1 + acc[ai][bj][m][1];
                    u32x4 w; w.x = cvt_pk_bf16(v0[0], v0[1]); w.y = cvt_pk_bf16(v0[2], v0[3]); w.z = cvt_pk_bf16(v1[0], v1[1]); w.w = cvt_pk_bf16(v1[2], v1[3]);
                    __builtin_nontemporal_store(w, (u32x4*)(xb + off + bj * HALF));
                    const unsigned ww[4] = {w.x, w.y, w.z, w.w};
#pragma unroll
                    for (int j = 0; j < 4; ++j) { const float lo = __uint_as_float(ww[j] << 16), hi = __uint_as_float(ww[j] & 0xffff0000u); ss += lo * lo + hi * hi; }
                }
                ss += __shfl_xor(ss, 16); ss += __shfl_xor(ss, 32);
                if (fq == 0) ssq[(size_t)row * 16 + u.pn * 4 + wc] = ss;
                asm volatile("" ::: "memory");
            }
    }
};

template <class Epi>
__device__ __forceinline__ void gemm_phase(LAS unsigned char* lds, const Gemm g, const StaticOrder& S, const Epi& E) {
    int tid_ = threadIdx.x; asm volatile("" : "+v"(tid_));
    const int tid = tid_, wid = __builtin_amdgcn_readfirstlane(tid >> 6), lane = tid & 63, wr = wid >> 2, wc = wid & 3, fr = lane & 15, fq = lane >> 4;
    const int nt = g.K / BK;
    unsigned voffA[2], voffB[2];
#pragma unroll
    for (int i = 0; i < 2; ++i) { int R, C; stage_rc(tid * 16 + i * 8192, R, C); const int Rb = (R & ~31) + perm32(R & 31);
        voffA[i] = (unsigned)(R * g.lda + C) * 2u; voffB[i] = (unsigned)(Rb * g.ldb + C) * 2u; }
    const size_t kstep = (size_t)(BK * 2);
    const size_t hstepA = (size_t)HALF * g.lda * 2, hstepB = (size_t)HALF * g.ldb * 2;
    const size_t tstepA = 2 * hstepA, tstepB = 2 * hstepB, cstepA = (size_t)g.acol * 2;
    const unsigned ldsw = (unsigned)wid * 1024u;
    const int aoff = lds_byte(wr * 64 + fr, fq * 8), boff = lds_byte(wc * 32 + fr, fq * 8);
#define PG8_SA(b, h) (((b) * 2 + (h)) * HTB)
#define PG8_SB(b, h) ((4 + (b) * 2 + (h)) * HTB)
#define PG8_STAGE(bufoff, gbase, voff) do { _Pragma("unroll") for (int _i = 0; _i < 2; ++_i) \
        __builtin_amdgcn_global_load_lds((const unsigned*)((const char*)(gbase) + (voff)[_i]), (LAS unsigned*)(lds + (bufoff) + ldsw + _i * 8192), 16, 0, 0); } while (0)
#define PG8_LDA(dst, b, h) do { _Pragma("unroll") for (int m = 0; m < 4; ++m) _Pragma("unroll") for (int k = 0; k < 2; ++k) dst[m][k] = *(const LAS bf16x8*)(lds + PG8_SA(b, h) + aoff + m * 2048 + k * 1024); } while (0)
#define PG8_LDB(dst, b, h) do { _Pragma("unroll") for (int n = 0; n < 2; ++n) _Pragma("unroll") for (int k = 0; k < 2; ++k) dst[n][k] = *(const LAS bf16x8*)(lds + PG8_SB(b, h) + boff + n * 2048 + k * 1024); } while (0)
#define PG8_MMA(ai, bj, At, Bt) do { __builtin_amdgcn_s_setprio(1); _Pragma("unroll") for (int m = 0; m < 4; ++m) _Pragma("unroll") for (int n = 0; n < 2; ++n) _Pragma("unroll") for (int k = 0; k < 2; ++k) \
        acc[ai][bj][m][n] = __builtin_amdgcn_mfma_f32_16x16x32_bf16(Bt[n][k], At[m][k], acc[ai][bj][m][n], 0, 0, 0); __builtin_amdgcn_s_setprio(0); } while (0)
#define PG8_WAIT_V(n) asm volatile("s_waitcnt vmcnt(" #n ")" ::: "memory")
#define PG8_WAIT_L(n) asm volatile("s_waitcnt lgkmcnt(" #n ")" ::: "memory")
#define PG8_BAR __builtin_amdgcn_s_barrier()
#define PG8_SCHED __builtin_amdgcn_sched_barrier(0)
    Unit cur, nxt; int ui = 0;
    if (!S.next(0, cur)) return;
    f32x4 acc[2][2][4][2];
#pragma unroll
    for (int a = 0; a < 2; ++a)
#pragma unroll
        for (int b = 0; b < 2; ++b)
#pragma unroll
            for (int m = 0; m < 4; ++m)
#pragma unroll
                for (int n = 0; n < 2; ++n) acc[a][b][m][n] = (f32x4){0.f, 0.f, 0.f, 0.f};
    bf16x8 At[4][2], B0[2][2], B1[2][2];
    const char* cA = (const char*)g.A + (size_t)cur.pm * tstepA + (size_t)cur.pn * cstepA; const char* cB = (const char*)g.Bt + (size_t)cur.pn * tstepB;
    PG8_STAGE(PG8_SB(0, 0), cB, voffB); PG8_STAGE(PG8_SB(0, 1), cB + hstepB, voffB); PG8_STAGE(PG8_SA(0, 0), cA, voffA); PG8_STAGE(PG8_SA(0, 1), cA + hstepA, voffA);
    if (wr == 1) PG8_BAR;
    PG8_WAIT_V(2); PG8_BAR;
    PG8_STAGE(PG8_SB(1, 0), cB + kstep, voffB); PG8_STAGE(PG8_SA(1, 0), cA + kstep, voffA); PG8_STAGE(PG8_SB(1, 1), cB + hstepB + kstep, voffB);
    PG8_WAIT_V(6); PG8_BAR;
    for (;;) {
        const bool has_next = S.next(ui + 1, nxt);
        const char* nA = has_next ? (const char*)g.A + (size_t)nxt.pm * tstepA + (size_t)nxt.pn * cstepA : cA; const char* nB = has_next ? (const char*)g.Bt + (size_t)nxt.pn * tstepB : cB;
        for (int t = 0; t < nt; t += 2) {
            const bool last = (t == nt - 2);
            const char* a1 = cA + (size_t)(t + 1) * kstep;
            const char* a2 = last ? nA : cA + (size_t)(t + 2) * kstep; const char* b2 = last ? nB : cB + (size_t)(t + 2) * kstep;
            const char* a3 = a2 + kstep; const char* b3 = b2 + kstep;
            PG8_LDB(B0, 0, 0); PG8_LDB(B1, 0, 1); PG8_SCHED; PG8_LDA(At, 0, 0); PG8_STAGE(PG8_SA(1, 1), a1 + hstepA, voffA);
            PG8_WAIT_V(8); PG8_WAIT_L(0); PG8_BAR; PG8_MMA(0, 0, At, B0); PG8_MMA(0, 1, At, B1); PG8_BAR; PG8_SCHED;
            PG8_LDA(At, 0, 1); PG8_STAGE(PG8_SB(0, 0), b2, voffB); PG8_STAGE(PG8_SB(0, 1), b2 + hstepB, voffB); PG8_STAGE(PG8_SA(0, 0), a2, voffA);
            PG8_WAIT_V(8); PG8_WAIT_L(0); PG8_BAR; PG8_MMA(1, 0, At, B0); PG8_MMA(1, 1, At, B1); PG8_BAR; PG8_SCHED;
            PG8_LDB(B0, 1, 0); PG8_LDB(B1, 1, 1); PG8_SCHED; PG8_LDA(At, 1, 0); PG8_STAGE(PG8_SA(0, 1), a2 + hstepA, voffA);
            PG8_WAIT_V(8); PG8_WAIT_L(0); PG8_BAR; PG8_MMA(0, 0, At, B0); PG8_MMA(0, 1, At, B1); PG8_BAR; PG8_SCHED;
            PG8_LDA(At, 1, 1); PG8_STAGE(PG8_SB(1, 0), b3, voffB); PG8_STAGE(PG8_SB(1, 1), b3 + hstepB, voffB); PG8_STAGE(PG8_SA(1, 0), a3, voffA);
            PG8_WAIT_V(8); PG8_WAIT_L(0); PG8_BAR; PG8_MMA(1, 0, At, B0); PG8_MMA(1, 1, At, B1); PG8_BAR; PG8_SCHED;
        }
        if (wr == 0) PG8_BAR;
        E(acc, cur, wr, wc, fr, fq);
        if (!has_next) break;
#pragma unroll
        for (int a = 0; a < 2; ++a)
#pragma unroll
            for (int b = 0; b < 2; ++b)
#pragma unroll
                for (int m = 0; m < 4; ++m)
#pragma unroll
                    for (int n = 0; n < 2; ++n) acc[a][b][m][n] = (f32x4){0.f, 0.f, 0.f, 0.f};
        cur = nxt; cA = nA; cB = nB; ++ui;
        if (wr == 1) PG8_BAR;
    }
    PG8_WAIT_V(0);
    PG8_BAR;
#undef PG8_SA
#undef PG8_SB
#undef PG8_STAGE
#undef PG8_LDA
#undef PG8_LDB
#undef PG8_MMA
#undef PG8_WAIT_V
#undef PG8_WAIT_L
#undef PG8_BAR
#undef PG8_SCHED
}
}

struct MatDesc { const float* src; int ldw, K, N; bf16_t* dst; int ldt; const float* ks; const float* ns; };

__device__ __forceinline__ void transpose_item(const MatDesc& d, LAS float* scr, int item, int lane) {
    const int nblk = d.N / 32, kb = item / nblk, nb = item % nblk, k0 = 64 * kb, n0 = 32 * nb;
    const int n4 = lane & 7, rr = lane >> 3;
    f32x4 nsv = (f32x4){1.f, 1.f, 1.f, 1.f};
    if (d.ns) nsv = *(const f32x4*)(d.ns + n0 + 4 * n4);
    f32x4 v[8];
#pragma unroll
    for (int j = 0; j < 8; ++j) v[j] = *(const f32x4*)(d.src + (size_t)(k0 + rr + 8 * j) * d.ldw + n0 + 4 * n4);
#pragma unroll
    for (int j = 0; j < 8; ++j) { const int kk = rr + 8 * j; f32x4 w = v[j] * nsv; if (d.ks) w = w * d.ks[k0 + kk];
        scr[kk * 33 + 4 * n4 + 0] = w[0]; scr[kk * 33 + 4 * n4 + 1] = w[1]; scr[kk * 33 + 4 * n4 + 2] = w[2]; scr[kk * 33 + 4 * n4 + 3] = w[3]; }
    asm volatile("s_waitcnt lgkmcnt(0)" ::: "memory");
    const int c = lane & 7;
#pragma unroll
    for (int j = 0; j < 4; ++j) { const int n = (lane >> 3) + 8 * j; const LAS float* s = scr + (8 * c) * 33 + n;
        u32x4 o; o.x = cvt_pk_bf16(s[0 * 33], s[1 * 33]); o.y = cvt_pk_bf16(s[2 * 33], s[3 * 33]); o.z = cvt_pk_bf16(s[4 * 33], s[5 * 33]); o.w = cvt_pk_bf16(s[6 * 33], s[7 * 33]);
        *(u32x4*)(d.dst + (size_t)(n0 + n) * d.ldt + k0 + 8 * c) = o; }
    asm volatile("s_waitcnt lgkmcnt(0)" ::: "memory");
}

enum { I_X = 0, I_MEM, I_G_MIX, I_G_MEM, I_G_MEMKV, I_G_FFN, I_G_FINAL, I_POOL_W, I_POOL_SCALE, I_SGU_WIN, I_SGU_LNG, I_SGU_LNB, I_SGU_WS, I_SGU_BS, I_SGU_WOUT, I_WQ, I_WKV, I_WO, I_W1, I_W2 };

__device__ __forceinline__ MatDesc get_mat(const Params& P, int id) {
    MatDesc d; d.ks = nullptr; d.ns = nullptr;
    unsigned char* ws = P.ws;
    if (id < 24) {
        const int L = id / 6, t = id % 6;
        if (t == 0)      { d.src = P.in[I_WQ] + (size_t)L * D * D; d.ldw = D; d.K = D; d.N = D; d.dst = (bf16_t*)(ws + WS_WQ) + (size_t)L * D * D; d.ldt = D; d.ks = P.in[I_G_MEM] + L * D; }
        else if (t == 1) { d.src = P.in[I_WKV] + (size_t)L * D * 2 * D; d.ldw = 2 * D; d.K = D; d.N = D; d.dst = (bf16_t*)(ws + WS_WK) + (size_t)L * D * D; d.ldt = D; d.ks = P.in[I_G_MEMKV] + L * D; }
        else if (t == 2) { d.src = P.in[I_WKV] + (size_t)L * D * 2 * D + D; d.ldw = 2 * D; d.K = D; d.N = D; d.dst = (bf16_t*)(ws + WS_WV) + (size_t)L * D * D; d.ldt = D; d.ks = P.in[I_G_MEMKV] + L * D; }
        else if (t == 3) { d.src = P.in[I_WO] + (size_t)L * D * D; d.ldw = D; d.K = D; d.N = D; d.dst = (bf16_t*)(ws + WS_WO) + (size_t)L * D * D; d.ldt = D; }
        else if (t == 4) { d.src = P.in[I_W1] + (size_t)L * D * FF; d.ldw = FF; d.K = D; d.N = FF; d.dst = (bf16_t*)(ws + WS_W1) + (size_t)L * D * FF; d.ldt = D; d.ks = P.in[I_G_FFN] + L * D; }
        else             { d.src = P.in[I_W2] + (size_t)L * D * FF; d.ldw = D; d.K = FF; d.N = D; d.dst = (bf16_t*)(ws + WS_W2) + (size_t)L * D * FF; d.ldt = FF; }
    } else if (id < 28) {
        const int j = (id - 24) >> 1, t = (id - 24) & 1;
        if (t == 0) { d.src = P.in[I_SGU_WIN] + (size_t)j * D * 2 * D; d.ldw = 2 * D; d.K = D; d.N = 2 * D; d.dst = (bf16_t*)(ws + WS_WIN) + (size_t)j * D * 2 * D; d.ldt = D; d.ks = P.in[I_G_MIX] + (2 * j + 1) * D; }
        else        { d.src = P.in[I_SGU_WOUT] + (size_t)j * D * D; d.ldw = D; d.K = D; d.N = D; d.dst = (bf16_t*)(ws + WS_WOUT) + (size_t)j * D * D; d.ldt = D; }
    } else {
        const int jg = id - 28, j = jg >> 2, g = jg & 3;
        d.src = P.in[I_POOL_W] + (size_t)jg * 256 * 256; d.ldw = 256; d.K = 256; d.N = 256; d.dst = (bf16_t*)(ws + WS_PW) + (size_t)jg * 256 * 256; d.ldt = 256;
        d.ks = P.in[I_G_MIX] + (2 * j) * D + g * 256; d.ns = P.in[I_POOL_SCALE] + j * D + g * 256;
    }
    return d;
}
__device__ __forceinline__ int mat_items(int id) {
    if (id < 24) { const int t = id % 6; return (t >= 4) ? 2048 : 512; }
    if (id < 28) return ((id - 24) & 1) ? 512 : 1024;
    return 32;
}

__device__ __forceinline__ void prologue_phase(const Params& P, LAS unsigned char* lds, int G) {
    int tid_ = threadIdx.x; asm volatile("" : "+v"(tid_));
    const int tid = tid_, lane = tid & 63, wave = __builtin_amdgcn_readfirstlane(tid >> 6);
    LAS float* scr = (LAS float*)(lds + wave * 16384);
    const int gw = blockIdx.x * 8 + wave, NGW = G * 8;
    constexpr int NITEMS = 4 * (4 * 512 + 2 * 2048) + 2 * (1024 + 512) + 8 * 32;
    for (int it = gw; it < NITEMS; it += NGW) {
        int r = it, id = 0;
        for (; id < 36; ++id) { const int n = mat_items(id); if (r < n) break; r -= n; }
        const MatDesc d = get_mat(P, id);
        transpose_item(d, scr, r, lane);
    }
    const float* mem = P.in[I_MEM]; bf16_t* memb = (bf16_t*)(P.ws + WS_MEMB); float* rstd_mem = (float*)(P.ws + WS_RSTDMEM);
    for (int r = gw; r < MR; r += NGW) {
        const f32x4* xr = (const f32x4*)(mem + (size_t)r * D) + lane; f32x4 v[4]; float s = 0.f;
#pragma unroll
        for (int j = 0; j < 4; ++j) { v[j] = xr[64 * j]; s += (v[j][0] * v[j][0] + v[j][1] * v[j][1]) + (v[j][2] * v[j][2] + v[j][3] * v[j][3]); }
        s = wave_sum(s);
        if (lane == 0) rstd_mem[r] = 1.0f / sqrtf(s * (1.0f / D) + EPS);
        u32x2* o = (u32x2*)(memb + (size_t)r * D) + lane;
#pragma unroll
        for (int j = 0; j < 4; ++j) { u32x2 w; w.x = cvt_pk_bf16(v[j][0], v[j][1]); w.y = cvt_pk_bf16(v[j][2], v[j][3]); o[64 * j] = w; }
    }
    const float* x = P.in[I_X]; float* ssq0 = (float*)(P.ws + WS_SSQ0);
    for (int r = gw; r < M; r += 2 * NGW) {
        const int r1 = (r + NGW < M) ? r + NGW : r;
        f32x4 va[4], vb[4];
#pragma unroll
        for (int j = 0; j < 4; ++j) { va[j] = ((const f32x4*)(x + (size_t)r * D) + lane)[64 * j]; vb[j] = ((const f32x4*)(x + (size_t)r1 * D) + lane)[64 * j]; }
        float s = 0.f, t = 0.f;
#pragma unroll
        for (int j = 0; j < 4; ++j) { s += (va[j][0] * va[j][0] + va[j][1] * va[j][1]) + (va[j][2] * va[j][2] + va[j][3] * va[j][3]); t += (vb[j][0] * vb[j][0] + vb[j][1] * vb[j][1]) + (vb[j][2] * vb[j][2] + vb[j][3] * vb[j][3]); }
        s = wave_sum(s); t = wave_sum(t);
        if (lane < 16) { ssq0[(size_t)r * 16 + lane] = (lane == 0) ? s : 0.f; if (r1 != r) ssq0[(size_t)r1 * 16 + lane] = (lane == 0) ? t : 0.f; }
    }
}

template <int W>
__device__ __forceinline__ void pool_block(const f32x2 (&prev)[16], const f32x2 (&cur)[16], bool seq_start, bf16_t* outp  ) {
#pragma unroll
    for (int i = 0; i < 16; ++i) {
        f32x2 s = cur[i];
#pragma unroll
        for (int j = 1; j < W; ++j) { s += (i - j >= 0) ? cur[(i - j) & 15] : prev[(16 + i - j) & 15]; }
        float inv = 1.0f / (float)W;
        if (i < W - 1 && seq_start) inv = 1.0f / (float)(i + 1);
        const f32x2 o = s * inv - cur[i];
        *(unsigned*)(outp + (size_t)i * D) = cvt_pk_bf16(o[0], o[1]);
    }
}
template <bool F32IN> __device__ __forceinline__ f32x2 pool_ld(const void* x, size_t idx) {
    if (F32IN) return *(const f32x2*)((const float*)x + idx);
    const unsigned r = *(const unsigned*)((const bf16_t*)x + idx); return (f32x2){__uint_as_float(r << 16), __uint_as_float(r & 0xffff0000u)};
}
template <bool F32IN>
__device__ __forceinline__ void pool_a_phase(LAS unsigned char* lds, const void* x, const float* ssq, bf16_t* PA, int G) {
    LAS float* rs = (LAS float*)lds;
    int tid_ = threadIdx.x; asm volatile("" : "+v"(tid_));
    const int tid = tid_, ch = 2 * tid, group = __builtin_amdgcn_readfirstlane(tid >> 7);
    for (int chunk = blockIdx.x; chunk < M / 64; chunk += G) {
        const int t0 = chunk * 64; const bool sstart = (t0 & (SEQ - 1)) == 0;
        __syncthreads();
        if (tid < 80) {
            float r = 0.f;
            if (!(sstart && tid < 16)) { const f32x4* p = (const f32x4*)(ssq + (size_t)(t0 - 16 + tid) * 16); const f32x4 a = p[0], b = p[1], c = p[2], d = p[3];
                const float s = (((a[0] + a[1]) + (a[2] + a[3])) + ((b[0] + b[1]) + (b[2] + b[3]))) + (((c[0] + c[1]) + (c[2] + c[3])) + ((d[0] + d[1]) + (d[2] + d[3])));
                r = 1.0f / sqrtf(s * (1.0f / D) + EPS); }
            rs[tid] = r;
        }
        __syncthreads();
        f32x2 prev[16], cur[16];
        if (sstart) {
#pragma unroll
            for (int i = 0; i < 16; ++i) prev[i] = (f32x2){0.f, 0.f};
        } else {
#pragma unroll
            for (int i = 0; i < 16; ++i) prev[i] = pool_ld<F32IN>(x, (size_t)(t0 - 16 + i) * D + ch) * rs[i];
        }
        for (int blk = 0; blk < 4; ++blk) {
#pragma unroll
            for (int i = 0; i < 16; ++i) cur[i] = pool_ld<F32IN>(x, (size_t)(t0 + blk * 16 + i) * D + ch) * rs[16 + blk * 16 + i];
            bf16_t* outp = PA + (size_t)(t0 + blk * 16) * D + ch;
            const bool ss = sstart && blk == 0;
            if (group == 0) pool_block<2>(prev, cur, ss, outp);
            else if (group == 1) pool_block<4>(prev, cur, ss, outp);
            else if (group == 2) pool_block<8>(prev, cur, ss, outp);
            else pool_block<16>(prev, cur, ss, outp);
#pragma unroll
            for (int i = 0; i < 16; ++i) prev[i] = cur[i];
        }
    }
}

__device__ __forceinline__ void sgu_spatial_phase(LAS unsigned char* lds, const bf16_t* Z, const float* vstat, const float* wsf, const float* bsf, const float* lng, const float* lnb, bf16_t* T1, int G) {
    constexpr int APITCH = 272;
    LAS unsigned char* Aimg = lds;
    LAS unsigned char* VT = lds + 34816;
    LAS float* mu = (LAS float*)(lds + 34816 + 67584); LAS float* rsd = mu + 128;
    int tid_ = threadIdx.x; asm volatile("" : "+v"(tid_));
    const int tid = tid_, lane = tid & 63, wave = __builtin_amdgcn_readfirstlane(tid >> 6);
    const int g = blockIdx.x & 3;
    bool first = true;
    for (int u = blockIdx.x; u < (M / 128) * 4; u += G) {
        const int nb = u >> 2; const size_t rowb = (size_t)nb * 128;
        __syncthreads();
        if (tid < 128) {
            const f32x4* p = (const f32x4*)(vstat + (rowb + tid) * 32); float s1 = 0.f, s2 = 0.f;
#pragma unroll
            for (int i = 0; i < 4; ++i) { const f32x4 a = p[i], b = p[4 + i]; s1 += (a[0] + a[1]) + (a[2] + a[3]); s2 += (b[0] + b[1]) + (b[2] + b[3]); }
            const float m = s1 * (1.0f / D), var = s2 * (1.0f / D) - m * m;
            mu[tid] = m; rsd[tid] = 1.0f / sqrtf(fmaxf(var, 0.f) + EPS);
        }
        if (first) {
            first = false;
            const float* wg = wsf + (size_t)g * 128 * 128;
#pragma unroll
            for (int i = 0; i < 8; ++i) { const int e = (tid + 512 * i) * 4, p = e >> 7, q = e & 127; f32x4 v = *(const f32x4*)(wg + e);
                if ((p >> 6) < (q >> 6)) v = (f32x4){0.f, 0.f, 0.f, 0.f};
                u32x2 w; w.x = cvt_pk_bf16(v[0], v[1]); w.y = cvt_pk_bf16(v[2], v[3]); *(LAS u32x2*)(Aimg + p * APITCH + q * 2) = w; }
        }
        __syncthreads();
        {
            const int cp = tid & 31, c0 = 8 * cp; float gg[8], bb[8];
#pragma unroll
            for (int e = 0; e < 8; ++e) { gg[e] = lng[g * 256 + c0 + e]; bb[e] = lnb[g * 256 + c0 + e]; }
#pragma unroll 2
            for (int i = 0; i < 8; ++i) {
                const int q = (tid >> 5) + 16 * i;
                const u32x4 raw = *(const u32x4*)(Z + (rowb + q) * 2048 + 1024 + g * 256 + c0);
                const float m = mu[q], r = rsd[q];
                const unsigned wv[4] = {raw.x, raw.y, raw.z, raw.w};
#pragma unroll
                for (int e = 0; e < 8; ++e) {
                    const float v = __uint_as_float((e & 1) ? (wv[e >> 1] & 0xffff0000u) : (wv[e >> 1] << 16));
                    const float y = (v - m) * r * gg[e] + bb[e];
                    const unsigned pk = cvt_pk_bf16(y, y);
                    const int c = c0 + e, chunk = (q >> 3) ^ ((c >> 3) & 15) ^ (c & 7);
                    *(LAS unsigned short*)(VT + c * 256 + chunk * 16 + (q & 7) * 2) = (unsigned short)pk;
                }
            }
        }
        __syncthreads();
        f32x4 acc[2][8];
#pragma unroll
        for (int ct = 0; ct < 2; ++ct)
#pragma unroll
            for (int pt = 0; pt < 8; ++pt) acc[ct][pt] = (f32x4){0.f, 0.f, 0.f, 0.f};
        const int l16 = lane & 15, l4 = lane >> 4;
#pragma unroll
        for (int ks = 0; ks < 4; ++ks) {
            bf16x8 af[2], bfr[8];
#pragma unroll
            for (int ct = 0; ct < 2; ++ct) { const int c = wave * 32 + ct * 16 + l16, chunk = (4 * ks + l4) ^ ((c >> 3) & 15) ^ (c & 7); af[ct] = *(const LAS bf16x8*)(VT + c * 256 + chunk * 16); }
#pragma unroll
            for (int pt = 0; pt < 8; ++pt) bfr[pt] = *(const LAS bf16x8*)(Aimg + (pt * 16 + l16) * APITCH + (32 * ks + 8 * l4) * 2);
#pragma unroll
            for (int ct = 0; ct < 2; ++ct)
#pragma unroll
                for (int pt = 0; pt < 8; ++pt) acc[ct][pt] = __builtin_amdgcn_mfma_f32_16x16x32_bf16(af[ct], bfr[pt], acc[ct][pt], 0, 0, 0);
        }
        u32x4 uu[8];
#pragma unroll
        for (int i = 0; i < 8; ++i) { const int piece = tid + 512 * i; uu[i] = *(const u32x4*)(Z + (rowb + (piece >> 5)) * 2048 + g * 256 + (piece & 31) * 8); }
        __syncthreads();
        LAS unsigned char* SS = VT;
#pragma unroll
        for (int pt = 0; pt < 8; ++pt) {
            const int p = pt * 16 + l16; const float bsv = bsf[g * 128 + p];
#pragma unroll
            for (int ct = 0; ct < 2; ++ct) {
                const f32x4 s = acc[ct][pt] + bsv;
                u32x2 w; w.x = cvt_pk_bf16(s[0], s[1]); w.y = cvt_pk_bf16(s[2], s[3]);
                *(LAS u32x2*)(SS + p * 528 + (wave * 32 + ct * 16 + 4 * l4) * 2) = w;
            }
        }
        __syncthreads();
#pragma unroll
        for (int i = 0; i < 8; ++i) {
            const int piece = tid + 512 * i, p = piece >> 5, part = piece & 31;
            const u32x4 sv = *(const LAS u32x4*)(SS + p * 528 + part * 16);
            const unsigned ua[4] = {uu[i].x, uu[i].y, uu[i].z, uu[i].w}, sa[4] = {sv.x, sv.y, sv.z, sv.w}; unsigned r[4];
#pragma unroll
            for (int e = 0; e < 4; ++e) r[e] = cvt_pk_bf16(__uint_as_float(ua[e] << 16) * __uint_as_float(sa[e] << 16), __uint_as_float(ua[e] & 0xffff0000u) * __uint_as_float(sa[e] & 0xffff0000u));
            u32x4 w; w.x = r[0]; w.y = r[1]; w.z = r[2]; w.w = r[3];
            __builtin_nontemporal_store(w, (u32x4*)(T1 + (rowb + p) * D + g * 256 + part * 8));
        }
    }
}

constexpr int ATT_BUF = 36864;
constexpr int ATT_STG = 2 * ATT_BUF, ATT_STG_W = 32 * 144;

__device__ __forceinline__ void attn_issue(int st, int first_unit, int L, const bf16_t* Q, const bf16_t* Kall, const bf16_t* Vtall, u32x4 (&pre)[4], u32x4 (&qpre)[4], int tid) {
    const int unit = first_unit + (st >> 3), chn = st & 7, pm = unit >> 2, h = unit & 3, b = pm >> 4;
    const int lane = tid & 63, wave = tid >> 6;
    const bf16_t* src = ((chn < 4) ? Kall : Vtall) + ((size_t)((L * 16 + b) * 4 + h) << 16) + (chn & 3) * 16384;
#pragma unroll
    for (int i = 0; i < 4; ++i) pre[i] = *(const u32x4*)(src + (size_t)(tid + 512 * i) * 8);
    if (chn < 4) {
        const bf16_t* qp = Q + (size_t)(pm * 256 + wave * 32 + (lane >> 3)) * D + h * 256 + chn * 64 + (lane & 7) * 8;
#pragma unroll
        for (int j = 0; j < 4; ++j) qpre[j] = *(const u32x4*)(qp + (size_t)(8 * j) * D);
    }
}
__device__ __forceinline__ void attn_commit(int st, LAS unsigned char* lds, const u32x4 (&pre)[4], const u32x4 (&qpre)[4], int tid) {
    LAS unsigned char* buf = lds + (st & 1) * ATT_BUF; const int chn = st & 7;
    const int lane = tid & 63, wave = tid >> 6;
    if (chn < 4) {
#pragma unroll
        for (int i = 0; i < 4; ++i) { const int p = tid + 512 * i, rho = p >> 3, part = p & 7; *(LAS u32x4*)(buf + rho * 144 + part * 16) = pre[i]; }
        LAS unsigned char* stg = lds + ATT_STG + wave * ATT_STG_W;
#pragma unroll
        for (int j = 0; j < 4; ++j) *(LAS u32x4*)(stg + ((lane >> 3) + 8 * j) * 144 + (lane & 7) * 16) = qpre[j];
    } else {
#pragma unroll
        for (int i = 0; i < 4; ++i) { const int p = tid + 512 * i, r = p >> 5, part = p & 31; *(LAS u32x4*)(buf + r * 528 + part * 16) = pre[i]; }
    }
}

__device__ __forceinline__ void attn_phase(LAS unsigned char* lds, const bf16_t* Q, const bf16_t* Kall, const bf16_t* Vtall, bf16_t* O, int L, int G) {
    int tid_ = threadIdx.x; asm volatile("" : "+v"(tid_));
    const int tid = tid_, lane = tid & 63, wave = __builtin_amdgcn_readfirstlane(tid >> 6), l32 = lane & 31, half = lane >> 5;
    const int bx = blockIdx.x, vcu = (G % 8 == 0) ? (bx % 8) * (G / 8) + bx / 8 : bx;
    const int nper = (1024 + G - 1) / G, first_unit = vcu * nper;
    int nunits = 1024 - first_unit; if (nunits > nper) nunits = nper; if (nunits <= 0) return;
    const int nsteps = nunits * 8;
    LAS unsigned char* stg = lds + ATT_STG + wave * ATT_STG_W;
    u32x4 pre[4], qpre[4];
    __syncthreads();
    attn_issue(0, first_unit, L, Q, Kall, Vtall, pre, qpre, tid);
    attn_commit(0, lds, pre, qpre, tid);
    __syncthreads();
    int st = 0;
    for (int ui = 0; ui < nunits; ++ui) {
        const int unit = first_unit + ui, pm = unit >> 2, h = unit & 3;
        f32x16 S[8];
#pragma unroll
        for (int mt = 0; mt < 8; ++mt)
#pragma unroll
            for (int i = 0; i < 16; ++i) S[mt][i] = 0.f;
        for (int kc = 0; kc < 4; ++kc, ++st) {
            if (st + 1 < nsteps) attn_issue(st + 1, first_unit, L, Q, Kall, Vtall, pre, qpre, tid);
            const LAS unsigned char* buf = lds + (st & 1) * ATT_BUF;
#pragma unroll
            for (int ks = 0; ks < 4; ++ks) {
                const bf16x8 qk = *(const LAS bf16x8*)(stg + l32 * 144 + ks * 32 + half * 16);
#pragma unroll
                for (int mh = 0; mh < 2; ++mh) {
                    bf16x8 kf[4];
#pragma unroll
                    for (int mt = 0; mt < 4; ++mt) kf[mt] = *(const LAS bf16x8*)(buf + (32 * (4 * mh + mt) + l32) * 144 + ks * 32 + half * 16);
                    __builtin_amdgcn_sched_barrier(0);
#pragma unroll
                    for (int mt = 0; mt < 4; ++mt) S[4 * mh + mt] = __builtin_amdgcn_mfma_f32_32x32x16_bf16(kf[mt], qk, S[4 * mh + mt], 0, 0, 0);
                    __builtin_amdgcn_sched_barrier(0);
                }
            }
            asm volatile("" ::: "memory");
            if (st + 1 < nsteps) attn_commit(st + 1, lds, pre, qpre, tid);
            asm volatile("s_waitcnt lgkmcnt(0)" ::: "memory"); __builtin_amdgcn_s_barrier(); asm volatile("" ::: "memory");
        }
        float mx = -3.0e38f;
#pragma unroll
        for (int mt = 0; mt < 8; ++mt)
#pragma unroll
            for (int i = 0; i < 16; ++i) mx = fmaxf(mx, S[mt][i]);
        mx = fmaxf(mx, __shfl_xor(mx, 32));
        float lsum = 0.f;
        bf16x8 pf[8][2];
#pragma unroll
        for (int mt = 0; mt < 8; ++mt) {
#pragma unroll
            for (int i = 0; i < 16; ++i) { const float p = __builtin_amdgcn_exp2f(S[mt][i] - mx); S[mt][i] = p; lsum += p; }
#pragma unroll
            for (int s2 = 0; s2 < 2; ++s2) { u32x4 w; w.x = cvt_pk_bf16(S[mt][8 * s2 + 0], S[mt][8 * s2 + 1]); w.y = cvt_pk_bf16(S[mt][8 * s2 + 2], S[mt][8 * s2 + 3]);
                w.z = cvt_pk_bf16(S[mt][8 * s2 + 4], S[mt][8 * s2 + 5]); w.w = cvt_pk_bf16(S[mt][8 * s2 + 6], S[mt][8 * s2 + 7]); pf[mt][s2] = __builtin_bit_cast(bf16x8, w); }
        }
        lsum += __shfl_xor(lsum, 32);
        const float inv = 1.0f / lsum;
        bf16_t* obase = O + (size_t)(pm * 256 + wave * 32 + (lane >> 3)) * D + h * 256 + (lane & 7) * 8;
        for (int vc = 0; vc < 4; ++vc, ++st) {
            if (st + 1 < nsteps) attn_issue(st + 1, first_unit, L, Q, Kall, Vtall, pre, qpre, tid);
            const LAS unsigned char* buf = lds + (st & 1) * ATT_BUF;
            f32x16 o[2];
#pragma unroll
            for (int ht = 0; ht < 2; ++ht)
#pragma unroll
                for (int i = 0; i < 16; ++i) o[ht][i] = 0.f;
#pragma unroll
            for (int mp = 0; mp < 4; ++mp) {
                bf16x8 vf[2][2][2];
#pragma unroll
                for (int mi = 0; mi < 2; ++mi)
#pragma unroll
                    for (int s2 = 0; s2 < 2; ++s2)
#pragma unroll
                        for (int ht = 0; ht < 2; ++ht) vf[mi][s2][ht] = *(const LAS bf16x8*)(buf + (32 * ht + l32) * 528 + (32 * (2 * mp + mi) + 16 * s2 + 8 * half) * 2);
                __builtin_amdgcn_sched_barrier(0);
#pragma unroll
                for (int mi = 0; mi < 2; ++mi)
#pragma unroll
                    for (int s2 = 0; s2 < 2; ++s2)
#pragma unroll
                        for (int ht = 0; ht < 2; ++ht) o[ht] = __builtin_amdgcn_mfma_f32_32x32x16_bf16(vf[mi][s2][ht], pf[2 * mp + mi][s2], o[ht], 0, 0, 0);
                __builtin_amdgcn_sched_barrier(0);
            }
            asm volatile("" ::: "memory");
#pragma unroll
            for (int ht = 0; ht < 2; ++ht)
#pragma unroll
                for (int i4 = 0; i4 < 4; ++i4) {
                    u32x2 w; w.x = cvt_pk_bf16(o[ht][4 * i4 + 0] * inv, o[ht][4 * i4 + 1] * inv); w.y = cvt_pk_bf16(o[ht][4 * i4 + 2] * inv, o[ht][4 * i4 + 3] * inv);
                    *(LAS u32x2*)(stg + l32 * 144 + (ht * 32 + i4 * 8 + half * 4) * 2) = w;
                }
            asm volatile("s_waitcnt lgkmcnt(0)" ::: "memory");
#pragma unroll
            for (int j = 0; j < 4; ++j) {
                const u32x4 v = *(const LAS u32x4*)(stg + ((lane >> 3) + 8 * j) * 144 + (lane & 7) * 16);
                __builtin_nontemporal_store(v, (u32x4*)(obase + (size_t)(8 * j) * D + vc * 64));
            }
            asm volatile("" ::: "memory");
            if (st + 1 < nsteps) attn_commit(st + 1, lds, pre, qpre, tid);
            asm volatile("s_waitcnt lgkmcnt(0)" ::: "memory"); __builtin_amdgcn_s_barrier(); asm volatile("" ::: "memory");
        }
    }
}

__device__ __forceinline__ void final_norm_phase(const bf16_t* xb, float* out, const float* gain, int G) {
    int tid_ = threadIdx.x; asm volatile("" : "+v"(tid_));
    const int tid = tid_, lane = tid & 63, wave = tid >> 6, gw = blockIdx.x * 8 + wave, NGW = G * 8;
    f32x4 gv[4];
#pragma unroll
    for (int j = 0; j < 2; ++j) { gv[2 * j] = *(const f32x4*)(gain + 512 * j + 8 * lane); gv[2 * j + 1] = *(const f32x4*)(gain + 512 * j + 8 * lane + 4); }
    for (int r = gw; r < M; r += NGW) {
        f32x4 v[4]; float s = 0.f;
#pragma unroll
        for (int j = 0; j < 2; ++j) { const u32x4 q = *(const u32x4*)(xb + (size_t)r * D + 512 * j + 8 * lane);
            v[2 * j] = (f32x4){__uint_as_float(q.x << 16), __uint_as_float(q.x & 0xffff0000u), __uint_as_float(q.y << 16), __uint_as_float(q.y & 0xffff0000u)};
            v[2 * j + 1] = (f32x4){__uint_as_float(q.z << 16), __uint_as_float(q.z & 0xffff0000u), __uint_as_float(q.w << 16), __uint_as_float(q.w & 0xffff0000u)}; }
#pragma unroll
        for (int j = 0; j < 4; ++j) s += (v[j][0] * v[j][0] + v[j][1] * v[j][1]) + (v[j][2] * v[j][2] + v[j][3] * v[j][3]);
        s = wave_sum(s);
        const float rs = 1.0f / sqrtf(s * (1.0f / D) + EPS);
#pragma unroll
        for (int j = 0; j < 2; ++j) { *(f32x4*)(out + (size_t)r * D + 512 * j + 8 * lane) = v[2 * j] * rs * gv[2 * j]; *(f32x4*)(out + (size_t)r * D + 512 * j + 8 * lane + 4) = v[2 * j + 1] * rs * gv[2 * j + 1]; }
    }
}

#define XB_TMO      128
#define XB_XCNT(j)  (256  + 64 * (j))
#define XB_XSUB(j)  (1280 + 64 * (j))
#define XB_XGEN(j)  (2304 + 64 * (j))
#define XB_TOP      3328
#define XB_TOPGEN   3392
#define XCD_BAR_WORDS 3456
#define XB_SPIN_CAP (1u << 20)
__device__ __forceinline__ unsigned xb_ld(unsigned* p)              { return __hip_atomic_load(p, __ATOMIC_RELAXED, __HIP_MEMORY_SCOPE_AGENT); }
__device__ __forceinline__ unsigned xb_add(unsigned* p, unsigned v) { return __hip_atomic_fetch_add(p, v, __ATOMIC_RELAXED, __HIP_MEMORY_SCOPE_AGENT); }
__device__ __forceinline__ unsigned xb_xcc_id() { return (unsigned)__builtin_amdgcn_s_getreg((3 << 11) | 20) & 0xFu; }
#define XB_SPIN(cond, bar) do { unsigned _sp = 0; while (cond) { __builtin_amdgcn_s_sleep(1); \
    if ((++_sp & 255u) == 0u) { if (xb_ld(&(bar)[XB_TMO])) break; if (_sp > XB_SPIN_CAP) { atomicAdd(&(bar)[XB_TMO], 1u); break; } } } } while (0)
struct XcdBarrier { unsigned* bar; unsigned x; volatile LAS unsigned* st; };
__device__ __forceinline__ XcdBarrier xcd_barrier_post(unsigned* bar, volatile LAS unsigned* st) {
    XcdBarrier b; b.bar = bar; b.x = xb_xcc_id(); b.st = st;
    if (threadIdx.x == 0) (void)xb_add(&bar[XB_XCNT(b.x)], 1u);
    return b;
}
__device__ __forceinline__ void xcd_barrier_complete(unsigned* bar, unsigned x, unsigned& nloc, unsigned& nx) {
    const unsigned G = gridDim.x * gridDim.y * gridDim.z;
    unsigned sum, cnt, mine, sp = 0u;
    for (;;) {
        sum = 0u; cnt = 0u; mine = 0u;
#pragma unroll
        for (unsigned j = 0; j < 16; ++j) { const unsigned c = xb_ld(&bar[XB_XCNT(j)]); sum += c; cnt += (c > 0u) ? 1u : 0u; mine = (j == x) ? c : mine; }
        if (sum == G) break;
        __builtin_amdgcn_s_sleep(1);
        if ((++sp & 255u) == 0u) { if (xb_ld(&bar[XB_TMO])) break; if (sp > XB_SPIN_CAP) { atomicAdd(&bar[XB_TMO], 1u); break; } }
    }
    nloc = mine > 0u ? mine : 1u; nx = cnt > 0u ? cnt : 1u;
}
__device__ __forceinline__ void xcd_barrier(const XcdBarrier& b) {
    asm volatile("s_waitcnt vmcnt(0)" ::: "memory");
    __syncthreads();
    if (threadIdx.x == 0) {
        unsigned* bar = b.bar;
        __builtin_amdgcn_s_waitcnt(0);
        unsigned nloc = b.st[0], nx = b.st[1];
        if (nloc == 0u) { xcd_barrier_complete(bar, b.x, nloc, nx); b.st[0] = nloc; b.st[1] = nx; }
        const unsigned old = xb_add(&bar[XB_XSUB(b.x)], 1u);
        const unsigned gen = old / nloc;
        if (old + 1u == (gen + 1u) * nloc) {
            __builtin_amdgcn_fence(__ATOMIC_RELEASE, "agent");
            asm volatile("s_waitcnt vmcnt(0)" ::: "memory");
            const unsigned og = xb_add(&bar[XB_TOP], 1u);
            const unsigned tg = og / nx;
            if (og + 1u == (tg + 1u) * nx) xb_add(&bar[XB_TOPGEN], 1u);
            else XB_SPIN(xb_ld(&bar[XB_TOPGEN]) == tg, bar);
            __builtin_amdgcn_fence(__ATOMIC_ACQUIRE, "agent");
            xb_add(&bar[XB_XGEN(b.x)], 1u);
            asm volatile("s_waitcnt vmcnt(0)" ::: "memory");
        } else {
            XB_SPIN(xb_ld(&bar[XB_XGEN(b.x)]) == gen, bar);
            __builtin_amdgcn_fence(__ATOMIC_ACQUIRE, "agent");
            asm volatile("s_waitcnt vmcnt(0)" ::: "memory");
        }
    }
    __syncthreads();
}

constexpr int NPHASES = 35;
__host__ __device__ inline bool phase_empty(int ph) { if (ph < 2 || ph >= 34) return false; const int L = (ph - 2) >> 3, k = (ph - 2) & 7; return k == 2 && (L & 1) == 0; }

__global__ void __launch_bounds__(512, 2) fwd_megakernel(Params P) {
    extern __shared__ __attribute__((aligned(16))) unsigned char lds_raw[];
    LAS unsigned char* lds = (LAS unsigned char*)lds_raw;
    cg::grid_group grid = cg::this_grid();
    const int G = gridDim.x;
    unsigned char* ws = P.ws;
    bf16_t* T1 = (bf16_t*)(ws + WS_T1); bf16_t* OB = (bf16_t*)(ws + WS_O); bf16_t* ZB = (bf16_t*)(ws + WS_Z); bf16_t* HB = (bf16_t*)(ws + WS_H);
    bf16_t* XB = (bf16_t*)(ws + WS_XB); bf16_t* KALL = (bf16_t*)(ws + WS_KALL); bf16_t* VTALL = (bf16_t*)(ws + WS_VTALL); bf16_t* MEMB = (bf16_t*)(ws + WS_MEMB);
    float* SSQ[2] = {(float*)(ws + WS_SSQ0), (float*)(ws + WS_SSQ1)};
    float* VSTAT = (float*)(ws + WS_VSTAT); float* RSTDMEM = (float*)(ws + WS_RSTDMEM);
    volatile LAS unsigned* MISC = (volatile LAS unsigned*)(lds + 131072 + 320);
    if (threadIdx.x < 32) MISC[threadIdx.x] = 0u;
    __syncthreads();
    XcdBarrier bar; bar.bar = (unsigned*)(ws + WS_CTL); bar.x = 0; bar.st = MISC + 8;
    if (P.ph_hi - P.ph_lo > 1) bar = xcd_barrier_post((unsigned*)(ws + WS_CTL), MISC + 8);

    for (int ph = P.ph_lo; ph < P.ph_hi; ++ph) {
        if (phase_empty(ph)) continue;
        if (ph == 0) {
            prologue_phase(P, lds, G);
        } else if (ph == 1) {
            pg8::StaticOrder S; S.init(MR, 4096, G, (int)blockIdx.x);
            { pg8::Gemm g{MEMB, (const bf16_t*)(ws + WS_WK), MR, 4096, D, D, D, 0}; pg8::EpiAct<4> E{KALL, 4096, nullptr, 1.f, RSTDMEM, nullptr}; pg8::gemm_phase(lds, g, S, E); }
            { pg8::Gemm g{(const bf16_t*)(ws + WS_WV), MEMB, 4096, MR, D, D, D, 0}; pg8::EpiAct<3> E{VTALL, 4096, nullptr, 1.f, RSTDMEM, nullptr}; pg8::gemm_phase(lds, g, S, E); }
        } else if (ph == 34) {
            final_norm_phase(XB, P.out, P.in[I_G_FINAL], G);
        } else {
            const int L = (ph - 2) >> 3, k = (ph - 2) & 7, j = L >> 1; const bool odd = (L & 1) != 0;
            if (k == 0) {
                const float* ssq_r = SSQ[(3 * L) & 1];
                if (!odd) { if (L == 0) pool_a_phase<true>(lds, P.in[I_X], ssq_r, T1, G); else pool_a_phase<false>(lds, XB, ssq_r, T1, G); }
                else { pg8::Gemm g{XB, (const bf16_t*)(ws + WS_WIN) + (size_t)j * D * 2 * D, M, 2 * D, D, D, D, 0}; pg8::StaticOrder S; S.init(M, 2 * D, G, (int)blockIdx.x);
                    pg8::EpiAct<2> E{ZB, 2 * D, ssq_r, 1.f, nullptr, VSTAT}; pg8::gemm_phase(lds, g, S, E); }
            } else if (k == 1 && odd) {
                sgu_spatial_phase(lds, ZB, VSTAT, P.in[I_SGU_WS] + (size_t)j * 4 * 128 * 128, P.in[I_SGU_BS] + j * 512, P.in[I_SGU_LNG] + j * D, P.in[I_SGU_LNB] + j * D, T1, G);
            } else if (k == 3) {
                pg8::Gemm g{XB, (const bf16_t*)(ws + WS_WQ) + (size_t)L * D * D, M, D, D, D, D, 0}; pg8::StaticOrder S; S.init(M, D, G, (int)blockIdx.x);
                pg8::EpiAct<0> E{T1, D, SSQ[(3 * L + 1) & 1], QSCALE, nullptr, nullptr}; pg8::gemm_phase(lds, g, S, E);
            } else if (k == 4) {
                attn_phase(lds, T1, KALL, VTALL, OB, L, G);
            } else if (k == 6) {
                pg8::Gemm g{XB, (const bf16_t*)(ws + WS_W1) + (size_t)L * D * FF, M, FF, D, D, D, 0}; pg8::StaticOrder S; S.init(M, FF, G, (int)blockIdx.x);
                pg8::EpiAct<1> E{HB, FF, SSQ[(3 * L + 2) & 1], 1.f, nullptr, nullptr}; pg8::gemm_phase(lds, g, S, E);
            } else {
                pg8::Gemm g; int upd;
                if (k == 1)      { g = pg8::Gemm{T1, (const bf16_t*)(ws + WS_PW) + (size_t)j * 4 * 256 * 256, M, D, 256, D, 256, 256}; upd = 3 * L; }
                else if (k == 2) { g = pg8::Gemm{T1, (const bf16_t*)(ws + WS_WOUT) + (size_t)j * D * D, M, D, D, D, D, 0}; upd = 3 * L; }
                else if (k == 5) { g = pg8::Gemm{OB, (const bf16_t*)(ws + WS_WO) + (size_t)L * D * D, M, D, D, D, D, 0}; upd = 3 * L + 1; }
                else             { g = pg8::Gemm{HB, (const bf16_t*)(ws + WS_W2) + (size_t)L * D * FF, M, D, FF, FF, FF, 0}; upd = 3 * L + 2; }
                pg8::StaticOrder S; S.init(M, D, G, (int)blockIdx.x);
                if (ph == 3) { pg8::EpiResid<true> E{P.in[I_X], XB, SSQ[(upd + 1) & 1]}; pg8::gemm_phase(lds, g, S, E); }
                else { pg8::EpiResid<false> E{nullptr, XB, SSQ[(upd + 1) & 1]}; pg8::gemm_phase(lds, g, S, E); }
            }
        }
        if (ph + 1 < P.ph_hi) { if (ph == 0) grid.sync(); else xcd_barrier(bar); }
    }
}

extern "C" void kernel_launch(void* const* d_in, const int* in_sizes, int n_in, void* d_out, int out_size, void* d_ws, size_t ws_size, hipStream_t stream) {
    static int grid = 0;
    if (grid == 0) {
        if (n_in != 20 || in_sizes[0] != M * D || out_size != M * D || ws_size < WS_END) { fprintf(stderr, "kernel_launch: unexpected shapes (n_in %d, in0 %d, out %d, ws %zu); nothing launched\n", n_in, n_in > 0 ? in_sizes[0] : -1, out_size, ws_size); grid = -1; return; }
        int dev = 0, cus = 0, per_cu = 0;
        if (hipGetDevice(&dev) != hipSuccess || hipDeviceGetAttribute(&cus, hipDeviceAttributeMultiprocessorCount, dev) != hipSuccess) { grid = -1; return; }
        if (hipFuncSetAttribute((const void*)fwd_megakernel, hipFuncAttributeMaxDynamicSharedMemorySize, LDS_BYTES) != hipSuccess) { fprintf(stderr, "kernel_launch: hipFuncSetAttribute failed\n"); grid = -1; return; }
        if (hipOccupancyMaxActiveBlocksPerMultiprocessor(&per_cu, (const void*)fwd_megakernel, 512, LDS_BYTES) != hipSuccess || per_cu < 1) { fprintf(stderr, "kernel_launch: occupancy query gave %d\n", per_cu); per_cu = 1; }
        (void)hipGetLastError();
        grid = cus * per_cu;
        if (grid > 256) grid = 256;
        grid &= ~7;
        if (grid < 8) { grid = -1; return; }
    }
    if (grid < 0) return;
    Params p{};
    for (int i = 0; i < 20; ++i) p.in[i] = (const float*)d_in[i];
    p.out = (float*)d_out; p.ws = (unsigned char*)d_ws;
#if MK_SINGLE
    p.ph_lo = 0; p.ph_hi = NPHASES;
    if (hipMemsetAsync((char*)d_ws + WS_CTL, 0, CTL_BYTES, stream) != hipSuccess) { fprintf(stderr, "kernel_launch: memset failed\n"); return; }
    void* args[] = {&p};
    hipError_t e = hipLaunchCooperativeKernel((const void*)fwd_megakernel, dim3(grid), dim3(512), args, LDS_BYTES, stream);
    if (e != hipSuccess) fprintf(stderr, "kernel_launch: cooperative launch failed: %s (grid %d)\n", hipGetErrorString(e), grid);
#else
    for (int ph = 0; ph < NPHASES; ++ph) {
        if (phase_empty(ph)) continue;
        p.ph_lo = ph; p.ph_hi = ph + 1;
        hipLaunchKernelGGL(fwd_megakernel, dim3(grid), dim3(512), LDS_BYTES, stream, p);
    }
#endif
}
```

```cpp
#include <hip/hip_runtime.h>
#include <hip/hip_cooperative_groups.h>
#include <cstdio>
#include <cstdint>
namespace cg = cooperative_groups;

#ifndef MK_SINGLE
#define MK_SINGLE 1
#endif

#define LAS __attribute__((address_space(3)))
typedef unsigned short bf16_t;
typedef short bf16x8 __attribute__((ext_vector_type(8)));
typedef float f32x4 __attribute__((ext_vector_type(4)));
typedef float f32x2 __attribute__((ext_vector_type(2)));
typedef float f32x16 __attribute__((ext_vector_type(16)));
typedef unsigned u32x4 __attribute__((ext_vector_type(4)));
typedef unsigned u32x2 __attribute__((ext_vector_type(2)));

constexpr int D = 1024, BATCH = 16, SEQ = 4096, DEPTH = 4, FF = 4096, NMEM = 256;
constexpr int M = BATCH * SEQ;
constexpr int MR = BATCH * NMEM;
constexpr float EPS = 1e-6f;
constexpr float QSCALE = 0.0625f * 1.4426950408889634f;

constexpr size_t MiB = 1u << 20;
constexpr size_t WS_H = 0, WS_T1 = 0, WS_O = 128 * MiB, WS_Z = 256 * MiB;
constexpr size_t WS_XB = 512 * MiB;
constexpr size_t WS_KVALL = 640 * MiB, WS_MEMB = 704 * MiB;
constexpr size_t WS_SSQ0 = 712 * MiB, WS_SSQ1 = 716 * MiB, WS_VSTAT = 720 * MiB, WS_RSTDMEM = 728 * MiB;
constexpr size_t WS_CTL = 730 * MiB, CTL_BYTES = 16384;
constexpr size_t WS_WQ = 736 * MiB, WS_WO = 744 * MiB, WS_W1 = 752 * MiB, WS_W2 = 784 * MiB, WS_WK = 816 * MiB, WS_WV = 824 * MiB;
constexpr size_t WS_WIN = 832 * MiB, WS_WOUT = 840 * MiB, WS_PW = 844 * MiB;
constexpr size_t WS_MQ = 848 * MiB, WS_VWO = 880 * MiB, WS_END = 912 * MiB;

constexpr int LDS_BYTES = 147456;

struct Params {
    const float* in[20];
    float* out;
    unsigned char* ws;
    int ph_lo, ph_hi;
};

extern __shared__ __attribute__((aligned(16))) unsigned char g_lds[];
constexpr int WIDTAB_OFF = 131072 + 512;
__device__ __forceinline__ int tid_now() {
    unsigned m = ~0u; asm volatile("" : "+s"(m));
    const int lane = (int)__builtin_amdgcn_mbcnt_hi(m, __builtin_amdgcn_mbcnt_lo(m, 0u));
    const unsigned hw = (unsigned)__builtin_amdgcn_s_getreg((5 << 11) | 4) & 63u;
    const int wid = __builtin_amdgcn_readfirstlane(((volatile LAS int*)((LAS unsigned char*)g_lds + WIDTAB_OFF))[hw]);
    return wid * 64 + lane;
}
__device__ __forceinline__ unsigned cvt_pk_bf16(float lo, float hi) { unsigned r; asm volatile("v_cvt_pk_bf16_f32 %0, %1, %2" : "=v"(r) : "v"(lo), "v"(hi)); return r; }
__device__ __forceinline__ float sx(float v, int o, int lane) { return __builtin_bit_cast(float, __builtin_amdgcn_ds_bpermute((lane ^ o) << 2, __builtin_bit_cast(int, v))); }
__device__ __forceinline__ float wave_sum(float v, int lane) {
#pragma unroll
    for (int o = 1; o < 64; o <<= 1) v += sx(v, o, lane);
    return v;
}
__device__ __forceinline__ float gelu_tanh(float x) {
    const float y = 0.7978845608028654f * (x + 0.044715f * x * x * x);
    const float e = __builtin_amdgcn_exp2f(-2.0f * 1.4426950408889634f * y);
    return x * __builtin_amdgcn_rcpf(1.0f + e);
}

__device__ __forceinline__ int sig23(int r) { return (r & ~12) | ((r & 4) << 1) | ((r & 8) >> 1); }
namespace pg8 {
constexpr int BM = 256, BK = 64, HALF = 128, HTB = HALF * BK * 2, STAGE_BYTES = 8 * HTB, NXCD = 8, WGM = 8;
__host__ __device__ __forceinline__ int lds_byte(int r, int c) { const int st = (r >> 4) * 2 + (c >> 5), rr = r & 15, cc = c & 31, ob = rr * 64 + cc * 2; return st * 1024 + (ob ^ (((ob >> 9) & 1) << 5)); }
__host__ __device__ __forceinline__ void stage_rc(int b, int& R, int& C) { const int st = b / 1024, sb = b % 1024, swz = sb ^ (((sb >> 9) & 1) << 5); R = (st >> 1) * 16 + swz / 64; C = (st & 1) * 32 + (swz % 64) / 2; }
__host__ __device__ __forceinline__ int perm32(int rho) { const int n = rho >> 4, i = rho & 15; return 8 * (i >> 2) + 4 * n + (i & 3); }

struct Unit { int pm, pn; };
struct Gemm { const bf16_t* A; const bf16_t* Bt; int M, N, K, lda, ldb; };
template <int KIND> __device__ __forceinline__ const char* unitA(const Gemm& g, int pm, int pn, size_t tstepA) {
    size_t off = (size_t)((KIND == 3) ? (pm & 15) : pm) * tstepA;
    if (KIND == 1) off += (size_t)pn * 512; if (KIND == 3) off += (size_t)(pm >> 4) * 512; if (KIND == 4) off += (size_t)(pn >> 4) * 512;
    return (const char*)g.A + off;
}
template <int KIND> __device__ __forceinline__ const char* unitB(const Gemm& g, int pm, int pn, size_t tstepB) {
    size_t off = (size_t)((KIND == 4) ? (pn & 15) : pn) * tstepB;
    if (KIND == 2) off += (size_t)(pm >> 4) * 2097152; if (KIND == 3) off += (size_t)(pm >> 4) * 512; if (KIND == 4) off += (size_t)(pn >> 4) * 512;
    return (const char*)g.Bt + off;
}

struct StaticOrder {
    int nM, nN, nwg, G, c;
    __device__ void init(int M_, int N_, int G_, int c_) { nM = M_ / BM; nN = N_ / BM; nwg = nM * nN; G = G_; c = c_; }
    __device__ bool next(int i, Unit& u) const {
        const long L = (long)i * G + c; if (L >= nwg) return false;
        int wgid = (int)L; { const int q = nwg / NXCD, r = nwg % NXCD, xcd = wgid % NXCD, off = wgid / NXCD; wgid = (xcd < r ? xcd * (q + 1) : r * (q + 1) + (xcd - r) * q) + off; }
        const int nig = WGM * nN, gid = wgid / nig, fm = gid * WGM, gsz = (nM - fm) < WGM ? (nM - fm) : WGM;
        u.pm = fm + ((wgid % nig) % gsz); u.pn = (wgid % nig) / gsz; return true;
    }
};

__device__ __forceinline__ float rstd_from_slots(const float* ssq, int row, int fq, int lane) {
    const f32x4 v = *(const f32x4*)(ssq + (size_t)row * 16 + fq * 4);
    float s = (v[0] + v[1]) + (v[2] + v[3]);
    s += sx(s, 16, lane); s += sx(s, 32, lane);
    return __builtin_amdgcn_rsqf(s * (1.0f / 1024.0f) + EPS);
}

template <int MODE> struct EpiAct {
    bf16_t* O; int ldc; const float* ssq; float scale; const float* rvec; float* vstat;
    __device__ __forceinline__ void operator()(const f32x4 (&acc)[2][2][4][2], const Unit& u, int, int, int, int) const {
        int t_ = tid_now(); asm volatile("" : "+v"(t_));
        const int wid_ = __builtin_amdgcn_readfirstlane(t_ >> 6), wr = wid_ >> 2, wc = wid_ & 3, fr = t_ & 15, fq = (t_ & 63) >> 4;
        const int row0 = u.pm * BM + wr * 64 + fr, col0 = u.pn * BM + wc * 32 + 8 * fq;
        f32x4 cs[2][2];
        if (MODE == 3) {
#pragma unroll
            for (int bj = 0; bj < 2; ++bj) { cs[bj][0] = *(const f32x4*)(rvec + col0 + bj * HALF); cs[bj][1] = *(const f32x4*)(rvec + col0 + bj * HALF + 4); }
        }
#pragma unroll
        for (int ai = 0; ai < 2; ++ai)
#pragma unroll
            for (int m = 0; m < 4; ++m) {
                const int row = row0 + ai * HALF + m * 16;
                float rs = 1.f;
                if (MODE == 0 || MODE == 1 || MODE == 2) rs = rstd_from_slots(ssq, row, fq, fq * 16 + fr);
                if (MODE == 0) rs *= scale;
                if (MODE == 4) rs = rvec[row];
                bf16_t* rowp = O + (size_t)row * ldc + col0;
                if (MODE == 5) { const int rl = row - u.pm * BM; rowp = O + ((size_t)(u.pm & 15) << 20) + (size_t)((u.pm >> 4) * 256 + rl) * 1024 + col0; rs = scale; }
                if (MODE == 6) { rowp = O + ((size_t)(u.pn & 15) << 20) + (size_t)row * 1024 + (u.pn >> 4) * 256 + (col0 - u.pn * BM); }
                float s1 = 0.f, s2 = 0.f;
#pragma unroll
                for (int bj = 0; bj < 2; ++bj) {
                    f32x4 v0 = acc[ai][bj][m][0] * rs, v1 = acc[ai][bj][m][1] * rs;
                    if (MODE == 3) { v0 = acc[ai][bj][m][0] * cs[bj][0]; v1 = acc[ai][bj][m][1] * cs[bj][1]; }
                    if (MODE == 1) {
#pragma unroll
                        for (int j = 0; j < 4; ++j) { const float a = v0[j] > 0.f ? v0[j] : 0.f, b = v1[j] > 0.f ? v1[j] : 0.f; v0[j] = a * a; v1[j] = b * b; }
                    }
                    if (MODE == 2) {
#pragma unroll
                        for (int j = 0; j < 4; ++j) { v0[j] = gelu_tanh(v0[j]); v1[j] = gelu_tanh(v1[j]); }
#pragma unroll
                        for (int j = 0; j < 4; ++j) { s1 += v0[j] + v1[j]; s2 += v0[j] * v0[j] + v1[j] * v1[j]; }
                    }
                    u32x4 w; w.x = cvt_pk_bf16(v0[0], v0[1]); w.y = cvt_pk_bf16(v0[2], v0[3]); w.z = cvt_pk_bf16(v1[0], v1[1]); w.w = cvt_pk_bf16(v1[2], v1[3]);
                    bf16_t* sp = rowp + bj * HALF;
                    __builtin_nontemporal_store(w, (u32x4*)sp);
                }
                if (MODE == 2) {
                    { const int ln = fq * 16 + fr; s1 += sx(s1, 16, ln); s1 += sx(s1, 32, ln); s2 += sx(s2, 16, ln); s2 += sx(s2, 32, ln); }
                    if (u.pn >= 4 && fq == 0) { vstat[(size_t)row * 32 + (u.pn - 4) * 4 + wc] = s1; vstat[(size_t)row * 32 + 16 + (u.pn - 4) * 4 + wc] = s2; }
                }
            }
    }
};
struct EpiSoftmax {
    bf16_t* O; const float* ssq; LAS float* red;
    __device__ __forceinline__ void operator()(f32x4 (&acc)[2][2][4][2], const Unit& u, int, int, int, int) const {
        int t_ = tid_now(); asm volatile("" : "+v"(t_));
        const int wid_ = __builtin_amdgcn_readfirstlane(t_ >> 6), wr = wid_ >> 2, wc = wid_ & 3, fr = t_ & 15, fq = (t_ & 63) >> 4;
        const int row0 = u.pm * BM + wr * 64 + fr, col0 = u.pn * BM + wc * 32 + 8 * fq, lane = fq * 16 + fr;
#pragma unroll
        for (int ai = 0; ai < 2; ++ai)
#pragma unroll
            for (int m = 0; m < 4; ++m) {
                const int rl = ai * HALF + wr * 64 + m * 16 + fr;
                const float rs = rstd_from_slots(ssq, u.pm * BM + rl, fq, lane);
                float mx = -3.0e38f;
#pragma unroll
                for (int bj = 0; bj < 2; ++bj)
#pragma unroll
                    for (int n = 0; n < 2; ++n) { acc[ai][bj][m][n] = acc[ai][bj][m][n] * rs;
#pragma unroll
                        for (int j = 0; j < 4; ++j) mx = fmaxf(mx, acc[ai][bj][m][n][j]); }
                mx = fmaxf(mx, sx(mx, 16, lane)); mx = fmaxf(mx, sx(mx, 32, lane));
                if (fq == 0) red[rl * 4 + wc] = mx;
            }
        asm volatile("s_waitcnt lgkmcnt(0)" ::: "memory"); __builtin_amdgcn_s_barrier(); asm volatile("" ::: "memory");
#pragma unroll
        for (int ai = 0; ai < 2; ++ai)
#pragma unroll
            for (int m = 0; m < 4; ++m) {
                const int rl = ai * HALF + wr * 64 + m * 16 + fr;
                const f32x4 r4 = *(const LAS f32x4*)(red + rl * 4);
                const float mx = fmaxf(fmaxf(r4[0], r4[1]), fmaxf(r4[2], r4[3]));
                float sm = 0.f;
#pragma unroll
                for (int bj = 0; bj < 2; ++bj)
#pragma unroll
                    for (int n = 0; n < 2; ++n)
#pragma unroll
                        for (int j = 0; j < 4; ++j) { const float e = __builtin_amdgcn_exp2f(acc[ai][bj][m][n][j] - mx); acc[ai][bj][m][n][j] = e; sm += e; }
                sm += sx(sm, 16, lane); sm += sx(sm, 32, lane);
                if (fq == 0) red[1024 + rl * 4 + wc] = sm;
            }
        asm volatile("s_waitcnt lgkmcnt(0)" ::: "memory"); __builtin_amdgcn_s_barrier(); asm volatile("" ::: "memory");
#pragma unroll
        for (int ai = 0; ai < 2; ++ai)
#pragma unroll
            for (int m = 0; m < 4; ++m) {
                const int rl = ai * HALF + wr * 64 + m * 16 + fr;
                const f32x4 r4 = *(const LAS f32x4*)(red + 1024 + rl * 4);
                const float inv = 1.0f / ((r4[0] + r4[1]) + (r4[2] + r4[3]));
                bf16_t* rowp = O + (size_t)(row0 + ai * HALF + m * 16) * D + col0;
#pragma unroll
                for (int bj = 0; bj < 2; ++bj) {
                    const f32x4 v0 = acc[ai][bj][m][0] * inv, v1 = acc[ai][bj][m][1] * inv;
                    u32x4 w; w.x = cvt_pk_bf16(v0[0], v0[1]); w.y = cvt_pk_bf16(v0[2], v0[3]); w.z = cvt_pk_bf16(v1[0], v1[1]); w.w = cvt_pk_bf16(v1[2], v1[3]);
                    __builtin_nontemporal_store(w, (u32x4*)(rowp + bj * HALF));
                }
            }
    }
};
template <bool F32IN> struct EpiResid {
    const float* xin; bf16_t* xb; float* ssq;
    __device__ __forceinline__ void operator()(const f32x4 (&acc)[2][2][4][2], const Unit& u, int, int, int, int) const {
        int t_ = tid_now(); asm volatile("" : "+v"(t_));
        const int wid_ = __builtin_amdgcn_readfirstlane(t_ >> 6), wr = wid_ >> 2, wc = wid_ & 3, fr = t_ & 15, fq = (t_ & 63) >> 4;
        const int row0 = u.pm * BM + wr * 64 + fr, col0 = u.pn * BM + wc * 32 + 8 * fq;
#pragma unroll
        for (int ai = 0; ai < 2; ++ai)
#pragma unroll
            for (int m = 0; m < 4; ++m) {
                const int row = row0 + ai * HALF + m * 16; const size_t off = (size_t)row * D + col0;
                float ss = 0.f;
#pragma unroll
                for (int bj = 0; bj < 2; ++bj) {
                    f32x4 a0, a1;
                    if (F32IN) { a0 = *(const f32x4*)(xin + off + bj * HALF); a1 = *(const f32x4*)(xin + off + bj * HALF + 4); }
                    else { const u32x4 r = *(const u32x4*)(xb + off + bj * HALF);
                        a0 = (f32x4){__uint_as_float(r.x << 16), __uint_as_float(r.x & 0xffff0000u), __uint_as_float(r.y << 16), __uint_as_float(r.y & 0xffff0000u)};
                        a1 = (f32x4){__uint_as_float(r.z << 16), __uint_as_float(r.z & 0xffff0000u), __uint_as_float(r.w << 16), __uint_as_float(r.w & 0xffff0000u)}; }
                    const f32x4 v0 = a0 + acc[ai][bj][m][0], v1 = a1 + acc[ai][bj][m][1];
                    u32x4 w; w.x = cvt_pk_bf16(v0[0], v0[1]); w.y = cvt_pk_bf16(v0[2], v0[3]); w.z = cvt_pk_bf16(v1[0], v1[1]); w.w = cvt_pk_bf16(v1[2], v1[3]);
                    __builtin_nontemporal_store(w, (u32x4*)(xb + off + bj * HALF));
                    const unsigned ww[4] = {w.x, w.y, w.z, w.w};
#pragma unroll
                    for (int j = 0; j < 4; ++j) { const float lo = __uint_as_float(ww[j] << 16), hi = __uint_as_float(ww[j] & 0xffff0000u); ss += lo * lo + hi * hi; }
                }
                { const int ln = fq * 16 + fr; ss += sx(ss, 16, ln); ss += sx(ss, 32, ln); }
                if (fq == 0) ssq[(size_t)row * 16 + u.pn * 4 + wc] = ss;
                asm volatile("" ::: "memory");
            }
    }
};

template <int KIND, class Epi>
__device__ __forceinline__ void gemm_phase(LAS unsigned char* lds, const Gemm g, const StaticOrder& S, const Epi& E) {
    int tid_ = tid_now(); asm volatile("" : "+v"(tid_));
    const int tid = tid_, wid = __builtin_amdgcn_readfirstlane(tid >> 6), lane = tid & 63, wr = wid >> 2, wc = wid & 3, fr = lane & 15, fq = lane >> 4;
    const int nt = g.K / BK;
    unsigned voffA[2], voffB[2];
#pragma unroll
    for (int i = 0; i < 2; ++i) { int R, C; stage_rc(tid * 16 + i * 8192, R, C); const int Rb = (R & ~31) + perm32(R & 31);
        voffA[i] = (unsigned)(R * g.lda + C) * 2u; voffB[i] = (unsigned)(Rb * g.ldb + C) * 2u; }
    const size_t kstep = (size_t)(BK * 2);
    const size_t hstepA = (size_t)HALF * g.lda * 2, hstepB = (size_t)HALF * g.ldb * 2;
    const size_t tstepA = 2 * hstepA, tstepB = 2 * hstepB;
    const unsigned ldsw = (unsigned)wid * 1024u;
    const int aoff = lds_byte(wr * 64 + fr, fq * 8), boff = lds_byte(wc * 32 + fr, fq * 8);
#define PG8_SA(b, h) (((b) * 2 + (h)) * HTB)
#define PG8_SB(b, h) ((4 + (b) * 2 + (h)) * HTB)
#define PG8_STAGE(bufoff, gbase, voff) do { _Pragma("unroll") for (int _i = 0; _i < 2; ++_i) \
        __builtin_amdgcn_global_load_lds((const unsigned*)((const char*)(gbase) + (voff)[_i]), (LAS unsigned*)(lds + (bufoff) + ldsw + _i * 8192), 16, 0, 0); } while (0)
#define PG8_LDA(dst, b, h) do { _Pragma("unroll") for (int m = 0; m < 4; ++m) _Pragma("unroll") for (int k = 0; k < 2; ++k) dst[m][k] = *(const LAS bf16x8*)(lds + PG8_SA(b, h) + aoff + m * 2048 + k * 1024); } while (0)
#define PG8_LDB(dst, b, h) do { _Pragma("unroll") for (int n = 0; n < 2; ++n) _Pragma("unroll") for (int k = 0; k < 2; ++k) dst[n][k] = *(const LAS bf16x8*)(lds + PG8_SB(b, h) + boff + n * 2048 + k * 1024); } while (0)
#define PG8_MMA(ai, bj, At, Bt) do { __builtin_amdgcn_s_setprio(1); _Pragma("unroll") for (int m = 0; m < 4; ++m) _Pragma("unroll") for (int n = 0; n < 2; ++n) _Pragma("unroll") for (int k = 0; k < 2; ++k) \
        acc[ai][bj][m][n] = __builtin_amdgcn_mfma_f32_16x16x32_bf16(Bt[n][k], At[m][k], acc[ai][bj][m][n], 0, 0, 0); __builtin_amdgcn_s_setprio(0); } while (0)
#define PG8_WAIT_V(n) asm volatile("s_waitcnt vmcnt(" #n ")" ::: "memory")
#define PG8_WAIT_L(n) asm volatile("s_waitcnt lgkmcnt(" #n ")" ::: "memory")
#define PG8_BAR __builtin_amdgcn_s_barrier()
#define PG8_SCHED __builtin_amdgcn_sched_barrier(0)
    Unit cur, nxt; int ui = 0;
    if (!S.next(0, cur)) return;
    f32x4 acc[2][2][4][2];
#pragma unroll
    for (int a = 0; a < 2; ++a)
#pragma unroll
        for (int b = 0; b < 2; ++b)
#pragma unroll
            for (int m = 0; m < 4; ++m)
#pragma unroll
                for (int n = 0; n < 2; ++n) acc[a][b][m][n] = (f32x4){0.f, 0.f, 0.f, 0.f};
    bf16x8 At[4][2], B0[2][2], B1[2][2];
    const char* cA = unitA<KIND>(g, cur.pm, cur.pn, tstepA); const char* cB = unitB<KIND>(g, cur.pm, cur.pn, tstepB);
    PG8_STAGE(PG8_SB(0, 0), cB, voffB); PG8_STAGE(PG8_SB(0, 1), cB + hstepB, voffB); PG8_STAGE(PG8_SA(0, 0), cA, voffA); PG8_STAGE(PG8_SA(0, 1), cA + hstepA, voffA);
    if (wr == 1) PG8_BAR;
    PG8_WAIT_V(2); PG8_BAR;
    PG8_STAGE(PG8_SB(1, 0), cB + kstep, voffB); PG8_STAGE(PG8_SA(1, 0), cA + kstep, voffA); PG8_STAGE(PG8_SB(1, 1), cB + hstepB + kstep, voffB);
    PG8_WAIT_V(6); PG8_BAR;
    for (;;) {
        const bool has_next = S.next(ui + 1, nxt);
        const char* nA = has_next ? unitA<KIND>(g, nxt.pm, nxt.pn, tstepA) : cA; const char* nB = has_next ? unitB<KIND>(g, nxt.pm, nxt.pn, tstepB) : cB;
        for (int t = 0; t < nt; t += 2) {
            const bool last = (t == nt - 2);
            const char* a1 = cA + (size_t)(t + 1) * kstep;
            const char* a2 = last ? nA : cA + (size_t)(t + 2) * kstep; const char* b2 = last ? nB : cB + (size_t)(t + 2) * kstep;
            const char* a3 = a2 + kstep; const char* b3 = b2 + kstep;
            PG8_LDB(B0, 0, 0); PG8_LDB(B1, 0, 1); PG8_SCHED; PG8_LDA(At, 0, 0); PG8_STAGE(PG8_SA(1, 1), a1 + hstepA, voffA);
            PG8_WAIT_V(8); PG8_WAIT_L(0); PG8_BAR; PG8_MMA(0, 0, At, B0); PG8_MMA(0, 1, At, B1); PG8_BAR; PG8_SCHED;
            PG8_LDA(At, 0, 1); PG8_STAGE(PG8_SB(0, 0), b2, voffB); PG8_STAGE(PG8_SB(0, 1), b2 + hstepB, voffB); PG8_STAGE(PG8_SA(0, 0), a2, voffA);
            PG8_WAIT_V(8); PG8_WAIT_L(0); PG8_BAR; PG8_MMA(1, 0, At, B0); PG8_MMA(1, 1, At, B1); PG8_BAR; PG8_SCHED;
            PG8_LDB(B0, 1, 0); PG8_LDB(B1, 1, 1); PG8_SCHED; PG8_LDA(At, 1, 0); PG8_STAGE(PG8_SA(0, 1), a2 + hstepA, voffA);
            PG8_WAIT_V(8); PG8_WAIT_L(0); PG8_BAR; PG8_MMA(0, 0, At, B0); PG8_MMA(0, 1, At, B1); PG8_BAR; PG8_SCHED;
            PG8_LDA(At, 1, 1); PG8_STAGE(PG8_SB(1, 0), b3, voffB); PG8_STAGE(PG8_SB(1, 1), b3 + hstepB, voffB); PG8_STAGE(PG8_SA(1, 0), a3, voffA);
            PG8_WAIT_V(8); PG8_WAIT_L(0); PG8_BAR; PG8_MMA(1, 0, At, B0); PG8_MMA(1, 1, At, B1); PG8_BAR; PG8_SCHED;
        }
        if (wr == 0) PG8_BAR;
        E(acc, cur, wr, wc, fr, fq);
        if (!has_next) break;
#pragma unroll
        for (int a = 0; a < 2; ++a)
#pragma unroll
            for (int b = 0; b < 2; ++b)
#pragma unroll
                for (int m = 0; m < 4; ++m)
#pragma unroll
                    for (int n = 0; n < 2; ++n) acc[a][b][m][n] = (f32x4){0.f, 0.f, 0.f, 0.f};
        cur = nxt; cA = nA; cB = nB; ++ui;
        if (wr == 1) PG8_BAR;
    }
    PG8_WAIT_V(0);
    PG8_BAR;
#undef PG8_SA
#undef PG8_SB
#undef PG8_STAGE
#undef PG8_LDA
#undef PG8_LDB
#undef PG8_MMA
#undef PG8_WAIT_V
#undef PG8_WAIT_L
#undef PG8_BAR
#undef PG8_SCHED
}
}

struct MatDesc { const float* src; int ldw, K, N; bf16_t* dst; int ldt; const float* ks; const float* ns; };

__device__ __forceinline__ void transpose_item(const MatDesc& d, LAS float* scr, int item, int lane) {
    const int nblk = d.N / 32, kb = item / nblk, nb = item % nblk, k0 = 64 * kb, n0 = 32 * nb;
    const int n4 = lane & 7, rr = lane >> 3;
    f32x4 nsv = (f32x4){1.f, 1.f, 1.f, 1.f};
    if (d.ns) nsv = *(const f32x4*)(d.ns + n0 + 4 * n4);
    f32x4 v[8];
#pragma unroll
    for (int j = 0; j < 8; ++j) v[j] = *(const f32x4*)(d.src + (size_t)(k0 + rr + 8 * j) * d.ldw + n0 + 4 * n4);
#pragma unroll
    for (int j = 0; j < 8; ++j) { const int kk = rr + 8 * j; f32x4 w = v[j] * nsv; if (d.ks) w = w * d.ks[k0 + kk];
        scr[kk * 33 + 4 * n4 + 0] = w[0]; scr[kk * 33 + 4 * n4 + 1] = w[1]; scr[kk * 33 + 4 * n4 + 2] = w[2]; scr[kk * 33 + 4 * n4 + 3] = w[3]; }
    asm volatile("s_waitcnt lgkmcnt(0)" ::: "memory");
    const int c = lane & 7;
#pragma unroll
    for (int j = 0; j < 4; ++j) { const int n = (lane >> 3) + 8 * j; const LAS float* s = scr + (8 * c) * 33 + n;
        u32x4 o; o.x = cvt_pk_bf16(s[0 * 33], s[1 * 33]); o.y = cvt_pk_bf16(s[2 * 33], s[3 * 33]); o.z = cvt_pk_bf16(s[4 * 33], s[5 * 33]); o.w = cvt_pk_bf16(s[6 * 33], s[7 * 33]);
        *(u32x4*)(d.dst + (size_t)(n0 + n) * d.ldt + k0 + 8 * c) = o; }
    asm volatile("s_waitcnt lgkmcnt(0)" ::: "memory");
}

enum { I_X = 0, I_MEM, I_G_MIX, I_G_MEM, I_G_MEMKV, I_G_FFN, I_G_FINAL, I_POOL_W, I_POOL_SCALE, I_SGU_WIN, I_SGU_LNG, I_SGU_LNB, I_SGU_WS, I_SGU_BS, I_SGU_WOUT, I_WQ, I_WKV, I_WO, I_W1, I_W2 };

__device__ __forceinline__ MatDesc get_mat(const Params& P, int id) {
    MatDesc d; d.ks = nullptr; d.ns = nullptr;
    unsigned char* ws = P.ws;
    if (id < 24) {
        const int L = id / 6, t = id % 6;
        if (t == 0)      { d.src = P.in[I_WQ] + (size_t)L * D * D; d.ldw = D; d.K = D; d.N = D; d.dst = (bf16_t*)(ws + WS_WQ) + (size_t)L * D * D; d.ldt = D; d.ks = P.in[I_G_MEM] + L * D; }
        else if (t == 1) { d.src = P.in[I_WKV] + (size_t)L * D * 2 * D; d.ldw = 2 * D; d.K = D; d.N = D; d.dst = (bf16_t*)(ws + WS_WK) + (size_t)L * D * D; d.ldt = D; d.ks = P.in[I_G_MEMKV] + L * D; }
        else if (t == 2) { d.src = P.in[I_WKV] + (size_t)L * D * 2 * D + D; d.ldw = 2 * D; d.K = D; d.N = D; d.dst = (bf16_t*)(ws + WS_WV) + (size_t)L * D * D; d.ldt = D; d.ks = P.in[I_G_MEMKV] + L * D; }
        else if (t == 3) { d.src = P.in[I_WO] + (size_t)L * D * D; d.ldw = D; d.K = D; d.N = D; d.dst = (bf16_t*)(ws + WS_WO) + (size_t)L * D * D; d.ldt = D; }
        else if (t == 4) { d.src = P.in[I_W1] + (size_t)L * D * FF; d.ldw = FF; d.K = D; d.N = FF; d.dst = (bf16_t*)(ws + WS_W1) + (size_t)L * D * FF; d.ldt = D; d.ks = P.in[I_G_FFN] + L * D; }
        else             { d.src = P.in[I_W2] + (size_t)L * D * FF; d.ldw = D; d.K = FF; d.N = D; d.dst = (bf16_t*)(ws + WS_W2) + (size_t)L * D * FF; d.ldt = FF; }
    } else if (id < 28) {
        const int j = (id - 24) >> 1, t = (id - 24) & 1;
        if (t == 0) { d.src = P.in[I_SGU_WIN] + (size_t)j * D * 2 * D; d.ldw = 2 * D; d.K = D; d.N = 2 * D; d.dst = (bf16_t*)(ws + WS_WIN) + (size_t)j * D * 2 * D; d.ldt = D; d.ks = P.in[I_G_MIX] + (2 * j + 1) * D; }
        else        { d.src = P.in[I_SGU_WOUT] + (size_t)j * D * D; d.ldw = D; d.K = D; d.N = D; d.dst = (bf16_t*)(ws + WS_WOUT) + (size_t)j * D * D; d.ldt = D; }
    } else {
        const int jg = id - 28, j = jg >> 2, g = jg & 3;
        d.src = P.in[I_POOL_W] + (size_t)jg * 256 * 256; d.ldw = 256; d.K = 256; d.N = 256; d.dst = (bf16_t*)(ws + WS_PW) + (size_t)jg * 256 * 256; d.ldt = 256;
        d.ks = P.in[I_G_MIX] + (2 * j) * D + g * 256; d.ns = P.in[I_POOL_SCALE] + j * D + g * 256;
    }
    return d;
}
__device__ __forceinline__ int mat_items(int id) {
    if (id < 24) { const int t = id % 6; return (t == 0) ? 0 : ((t >= 4) ? 2048 : 512); }
    if (id < 28) return ((id - 24) & 1) ? 512 : 1024;
    return 32;
}

__device__ __forceinline__ void prologue_phase(const Params& P, LAS unsigned char* lds, int G) {
    int tid_ = tid_now(); asm volatile("" : "+v"(tid_));
    const int tid = tid_, lane = tid & 63, wave = __builtin_amdgcn_readfirstlane(tid >> 6);
    LAS float* scr = (LAS float*)(lds + wave * 16384);
    const int gw = blockIdx.x * 8 + wave, NGW = G * 8;
    constexpr int NITEMS = 4 * (3 * 512 + 2 * 2048) + 2 * (1024 + 512) + 8 * 32;
    for (int it = gw; it < NITEMS; it += NGW) {
        int r = it, id = 0;
        for (; id < 36; ++id) { const int n = mat_items(id); if (r < n) break; r -= n; }
        const MatDesc d = get_mat(P, id);
        transpose_item(d, scr, r, lane);
    }
    { const float* wq = P.in[I_WQ]; const float* gq = P.in[I_G_MEM]; bf16_t* wqb = (bf16_t*)(P.ws + WS_WQ);
      for (int r = gw; r < DEPTH * D; r += NGW) { const float gk = gq[r]; const f32x4* xr = (const f32x4*)(wq + (size_t)r * D) + lane; u32x2* o = (u32x2*)(wqb + (size_t)r * D) + lane;
#pragma unroll
        for (int j = 0; j < 4; ++j) { const f32x4 v = xr[64 * j] * gk; u32x2 w; w.x = cvt_pk_bf16(v[0], v[1]); w.y = cvt_pk_bf16(v[2], v[3]); o[64 * j] = w; } } }
    const float* mem = P.in[I_MEM]; bf16_t* memb = (bf16_t*)(P.ws + WS_MEMB); float* rstd_mem = (float*)(P.ws + WS_RSTDMEM);
    for (int r = gw; r < MR; r += NGW) {
        const f32x4* xr = (const f32x4*)(mem + (size_t)r * D) + lane; f32x4 v[4]; float s = 0.f;
#pragma unroll
        for (int j = 0; j < 4; ++j) { v[j] = xr[64 * j]; s += (v[j][0] * v[j][0] + v[j][1] * v[j][1]) + (v[j][2] * v[j][2] + v[j][3] * v[j][3]); }
        s = wave_sum(s, lane);
        if (lane == 0) rstd_mem[r] = 1.0f / sqrtf(s * (1.0f / D) + EPS);
        u32x2* o = (u32x2*)(memb + (size_t)r * D) + lane;
#pragma unroll
        for (int j = 0; j < 4; ++j) { u32x2 w; w.x = cvt_pk_bf16(v[j][0], v[j][1]); w.y = cvt_pk_bf16(v[j][2], v[j][3]); o[64 * j] = w; }
    }
    const float* x = P.in[I_X]; float* ssq0 = (float*)(P.ws + WS_SSQ0);
    for (int r = gw; r < M; r += 2 * NGW) {
        const int r1 = (r + NGW < M) ? r + NGW : r;
        f32x4 va[4], vb[4];
#pragma unroll
        for (int j = 0; j < 4; ++j) { va[j] = ((const f32x4*)(x + (size_t)r * D) + lane)[64 * j]; vb[j] = ((const f32x4*)(x + (size_t)r1 * D) + lane)[64 * j]; }
        float s = 0.f, t = 0.f;
#pragma unroll
        for (int j = 0; j < 4; ++j) { s += (va[j][0] * va[j][0] + va[j][1] * va[j][1]) + (va[j][2] * va[j][2] + va[j][3] * va[j][3]); t += (vb[j][0] * vb[j][0] + vb[j][1] * vb[j][1]) + (vb[j][2] * vb[j][2] + vb[j][3] * vb[j][3]); }
        s = wave_sum(s, lane); t = wave_sum(t, lane);
        if (lane < 16) { ssq0[(size_t)r * 16 + lane] = (lane == 0) ? s : 0.f; if (r1 != r) ssq0[(size_t)r1 * 16 + lane] = (lane == 0) ? t : 0.f; }
    }
}

template <int W>
__device__ __forceinline__ void pool_block(const f32x2 (&prev)[16], const f32x2 (&cur)[16], bool seq_start, bf16_t* outp  ) {
#pragma unroll
    for (int i = 0; i < 16; ++i) {
        f32x2 s = cur[i];
#pragma unroll
        for (int j = 1; j < W; ++j) { s += (i - j >= 0) ? cur[(i - j) & 15] : prev[(16 + i - j) & 15]; }
        float inv = 1.0f / (float)W;
        if (i < W - 1 && seq_start) inv = 1.0f / (float)(i + 1);
        const f32x2 o = s * inv - cur[i];
        *(unsigned*)(outp + (size_t)i * D) = cvt_pk_bf16(o[0], o[1]);
    }
}
template <bool F32IN> __device__ __forceinline__ f32x2 pool_ld(const void* x, size_t idx) {
    if (F32IN) return *(const f32x2*)((const float*)x + idx);
    const unsigned r = *(const unsigned*)((const bf16_t*)x + idx); return (f32x2){__uint_as_float(r << 16), __uint_as_float(r & 0xffff0000u)};
}
template <bool F32IN>
__device__ __forceinline__ void pool_a_phase(LAS unsigned char* lds, const void* x, const float* ssq, bf16_t* PA, int G) {
    LAS float* rs = (LAS float*)lds;
    int tid_ = tid_now(); asm volatile("" : "+v"(tid_));
    const int tid = tid_, ch = 2 * tid, group = __builtin_amdgcn_readfirstlane(tid >> 7);
    for (int chunk = blockIdx.x; chunk < M / 64; chunk += G) {
        const int t0 = chunk * 64; const bool sstart = (t0 & (SEQ - 1)) == 0;
        __syncthreads();
        if (tid < 80) {
            float r = 0.f;
            if (!(sstart && tid < 16)) { const f32x4* p = (const f32x4*)(ssq + (size_t)(t0 - 16 + tid) * 16); const f32x4 a = p[0], b = p[1], c = p[2], d = p[3];
                const float s = (((a[0] + a[1]) + (a[2] + a[3])) + ((b[0] + b[1]) + (b[2] + b[3]))) + (((c[0] + c[1]) + (c[2] + c[3])) + ((d[0] + d[1]) + (d[2] + d[3])));
                r = 1.0f / sqrtf(s * (1.0f / D) + EPS); }
            rs[tid] = r;
        }
        __syncthreads();
        f32x2 prev[16], cur[16];
        if (sstart) {
#pragma unroll
            for (int i = 0; i < 16; ++i) prev[i] = (f32x2){0.f, 0.f};
        } else {
#pragma unroll
            for (int i = 0; i < 16; ++i) prev[i] = pool_ld<F32IN>(x, (size_t)(t0 - 16 + i) * D + ch) * rs[i];
        }
        for (int blk = 0; blk < 4; ++blk) {
#pragma unroll
            for (int i = 0; i < 16; ++i) cur[i] = pool_ld<F32IN>(x, (size_t)(t0 + blk * 16 + i) * D + ch) * rs[16 + blk * 16 + i];
            bf16_t* outp = PA + (size_t)(t0 + blk * 16) * D + ch;
            const bool ss = sstart && blk == 0;
            if (group == 0) pool_block<2>(prev, cur, ss, outp);
            else if (group == 1) pool_block<4>(prev, cur, ss, outp);
            else if (group == 2) pool_block<8>(prev, cur, ss, outp);
            else pool_block<16>(prev, cur, ss, outp);
#pragma unroll
            for (int i = 0; i < 16; ++i) prev[i] = cur[i];
        }
    }
}

__device__ __forceinline__ void sgu_spatial_phase(LAS unsigned char* lds, const bf16_t* Z, const float* vstat, const float* wsf, const float* bsf, const float* lng, const float* lnb, bf16_t* T1, int G) {
    constexpr int APITCH = 272;
    LAS unsigned char* Aimg = lds;
    LAS unsigned char* VT = lds + 34816;
    LAS float* mu = (LAS float*)(lds + 34816 + 67584); LAS float* rsd = mu + 128;
    int tid_ = tid_now(); asm volatile("" : "+v"(tid_));
    const int tid = tid_, lane = tid & 63, wave = __builtin_amdgcn_readfirstlane(tid >> 6);
    const int g = blockIdx.x & 3;
    bool first = true;
    for (int u = blockIdx.x; u < (M / 128) * 4; u += G) {
        const int nb = u >> 2; const size_t rowb = (size_t)nb * 128;
        __syncthreads();
        if (tid < 128) {
            const f32x4* p = (const f32x4*)(vstat + (rowb + tid) * 32); float s1 = 0.f, s2 = 0.f;
#pragma unroll
            for (int i = 0; i < 4; ++i) { const f32x4 a = p[i], b = p[4 + i]; s1 += (a[0] + a[1]) + (a[2] + a[3]); s2 += (b[0] + b[1]) + (b[2] + b[3]); }
            const float m = s1 * (1.0f / D), var = s2 * (1.0f / D) - m * m;
            mu[tid] = m; rsd[tid] = 1.0f / sqrtf(fmaxf(var, 0.f) + EPS);
        }
        if (first) {
            first = false;
            const float* wg = wsf + (size_t)g * 128 * 128;
#pragma unroll
            for (int i = 0; i < 8; ++i) { const int e = (tid + 512 * i) * 4, p = e >> 7, q = e & 127; f32x4 v = *(const f32x4*)(wg + e);
                if ((p >> 6) < (q >> 6)) v = (f32x4){0.f, 0.f, 0.f, 0.f};
                u32x2 w; w.x = cvt_pk_bf16(v[0], v[1]); w.y = cvt_pk_bf16(v[2], v[3]); *(LAS u32x2*)(Aimg + p * APITCH + q * 2) = w; }
        }
        __syncthreads();
        {
            const int cp = tid & 31, c0 = 8 * cp; float gg[8], bb[8];
#pragma unroll
            for (int e = 0; e < 8; ++e) { gg[e] = lng[g * 256 + c0 + e]; bb[e] = lnb[g * 256 + c0 + e]; }
#pragma unroll 2
            for (int i = 0; i < 8; ++i) {
                const int q = (tid >> 5) + 16 * i;
                const u32x4 raw = *(const u32x4*)(Z + (rowb + q) * 2048 + 1024 + g * 256 + c0);
                const float m = mu[q], r = rsd[q];
                const unsigned wv[4] = {raw.x, raw.y, raw.z, raw.w};
#pragma unroll
                for (int e = 0; e < 8; ++e) {
                    const float v = __uint_as_float((e & 1) ? (wv[e >> 1] & 0xffff0000u) : (wv[e >> 1] << 16));
                    const float y = (v - m) * r * gg[e] + bb[e];
                    const unsigned pk = cvt_pk_bf16(y, y);
                    const int c = c0 + e, chunk = (q >> 3) ^ ((c >> 3) & 15) ^ (c & 7);
                    *(LAS unsigned short*)(VT + c * 256 + chunk * 16 + (q & 7) * 2) = (unsigned short)pk;
                }
            }
        }
        __syncthreads();
        f32x4 acc[2][8];
#pragma unroll
        for (int ct = 0; ct < 2; ++ct)
#pragma unroll
            for (int pt = 0; pt < 8; ++pt) acc[ct][pt] = (f32x4){0.f, 0.f, 0.f, 0.f};
        const int l16 = lane & 15, l4 = lane >> 4;
#pragma unroll
        for (int ks = 0; ks < 4; ++ks) {
            bf16x8 af[2], bfr[8];
#pragma unroll
            for (int ct = 0; ct < 2; ++ct) { const int c = wave * 32 + ct * 16 + l16, chunk = (4 * ks + l4) ^ ((c >> 3) & 15) ^ (c & 7); af[ct] = *(const LAS bf16x8*)(VT + c * 256 + chunk * 16); }
#pragma unroll
            for (int pt = 0; pt < 8; ++pt) bfr[pt] = *(const LAS bf16x8*)(Aimg + (pt * 16 + l16) * APITCH + (32 * ks + 8 * l4) * 2);
#pragma unroll
            for (int ct = 0; ct < 2; ++ct)
#pragma unroll
                for (int pt = 0; pt < 8; ++pt) acc[ct][pt] = __builtin_amdgcn_mfma_f32_16x16x32_bf16(af[ct], bfr[pt], acc[ct][pt], 0, 0, 0);
        }
        u32x4 uu[8];
#pragma unroll
        for (int i = 0; i < 8; ++i) { const int piece = tid + 512 * i; uu[i] = *(const u32x4*)(Z + (rowb + (piece >> 5)) * 2048 + g * 256 + (piece & 31) * 8); }
        __syncthreads();
        LAS unsigned char* SS = VT;
#pragma unroll
        for (int pt = 0; pt < 8; ++pt) {
            const int p = pt * 16 + l16; const float bsv = bsf[g * 128 + p];
#pragma unroll
            for (int ct = 0; ct < 2; ++ct) {
                const f32x4 s = acc[ct][pt] + bsv;
                u32x2 w; w.x = cvt_pk_bf16(s[0], s[1]); w.y = cvt_pk_bf16(s[2], s[3]);
                *(LAS u32x2*)(SS + p * 528 + (wave * 32 + ct * 16 + 4 * l4) * 2) = w;
            }
        }
        __syncthreads();
#pragma unroll
        for (int i = 0; i < 8; ++i) {
            const int piece = tid + 512 * i, p = piece >> 5, part = piece & 31;
            const u32x4 sv = *(const LAS u32x4*)(SS + p * 528 + part * 16);
            const unsigned ua[4] = {uu[i].x, uu[i].y, uu[i].z, uu[i].w}, sa[4] = {sv.x, sv.y, sv.z, sv.w}; unsigned r[4];
#pragma unroll
            for (int e = 0; e < 4; ++e) r[e] = cvt_pk_bf16(__uint_as_float(ua[e] << 16) * __uint_as_float(sa[e] << 16), __uint_as_float(ua[e] & 0xffff0000u) * __uint_as_float(sa[e] & 0xffff0000u));
            u32x4 w; w.x = r[0]; w.y = r[1]; w.z = r[2]; w.w = r[3];
            __builtin_nontemporal_store(w, (u32x4*)(T1 + (rowb + p) * D + g * 256 + part * 8));
        }
    }
}

__device__ __forceinline__ void final_norm_phase(const bf16_t* xb, float* out, const float* gain, int G) {
    int tid_ = tid_now(); asm volatile("" : "+v"(tid_));
    const int tid = tid_, lane = tid & 63, wave = tid >> 6, gw = blockIdx.x * 8 + wave, NGW = G * 8;
    f32x4 gv[4];
#pragma unroll
    for (int j = 0; j < 2; ++j) { gv[2 * j] = *(const f32x4*)(gain + 512 * j + 8 * lane); gv[2 * j + 1] = *(const f32x4*)(gain + 512 * j + 8 * lane + 4); }
    for (int r = gw; r < M; r += NGW) {
        f32x4 v[4]; float s = 0.f;
#pragma unroll
        for (int j = 0; j < 2; ++j) { const u32x4 q = *(const u32x4*)(xb + (size_t)r * D + 512 * j + 8 * lane);
            v[2 * j] = (f32x4){__uint_as_float(q.x << 16), __uint_as_float(q.x & 0xffff0000u), __uint_as_float(q.y << 16), __uint_as_float(q.y & 0xffff0000u)};
            v[2 * j + 1] = (f32x4){__uint_as_float(q.z << 16), __uint_as_float(q.z & 0xffff0000u), __uint_as_float(q.w << 16), __uint_as_float(q.w & 0xffff0000u)}; }
#pragma unroll
        for (int j = 0; j < 4; ++j) s += (v[j][0] * v[j][0] + v[j][1] * v[j][1]) + (v[j][2] * v[j][2] + v[j][3] * v[j][3]);
        s = wave_sum(s, lane);
        const float rs = 1.0f / sqrtf(s * (1.0f / D) + EPS);
#pragma unroll
        for (int j = 0; j < 2; ++j) { *(f32x4*)(out + (size_t)r * D + 512 * j + 8 * lane) = v[2 * j] * rs * gv[2 * j]; *(f32x4*)(out + (size_t)r * D + 512 * j + 8 * lane + 4) = v[2 * j + 1] * rs * gv[2 * j + 1]; }
    }
}

#define XB_TMO      128
#define XB_XCNT(j)  (256  + 64 * (j))
#define XB_XSUB(j)  (1280 + 64 * (j))
#define XB_XGEN(j)  (2304 + 64 * (j))
#define XB_TOP      3328
#define XB_TOPGEN   3392
#define XCD_BAR_WORDS 3456
#define XB_SPIN_CAP (1u << 20)
__device__ __forceinline__ unsigned xb_ld(unsigned* p)              { return __hip_atomic_load(p, __ATOMIC_RELAXED, __HIP_MEMORY_SCOPE_AGENT); }
__device__ __forceinline__ unsigned xb_add(unsigned* p, unsigned v) { return __hip_atomic_fetch_add(p, v, __ATOMIC_RELAXED, __HIP_MEMORY_SCOPE_AGENT); }
__device__ __forceinline__ unsigned xb_xcc_id() { return (unsigned)__builtin_amdgcn_s_getreg((3 << 11) | 20) & 0xFu; }
#define XB_SPIN(cond, bar) do { unsigned _sp = 0; while (cond) { __builtin_amdgcn_s_sleep(1); \
    if ((++_sp & 255u) == 0u) { if (xb_ld(&(bar)[XB_TMO])) break; if (_sp > XB_SPIN_CAP) { atomicAdd(&(bar)[XB_TMO], 1u); break; } } } } while (0)
struct XcdBarrier { unsigned* bar; unsigned x; volatile LAS unsigned* st; };
__device__ __forceinline__ XcdBarrier xcd_barrier_post(unsigned* bar, volatile LAS unsigned* st) {
    XcdBarrier b; b.bar = bar; b.x = xb_xcc_id(); b.st = st;
    if (tid_now() == 0) (void)xb_add(&bar[XB_XCNT(b.x)], 1u);
    return b;
}
__device__ __forceinline__ void xcd_barrier_complete(unsigned* bar, unsigned x, unsigned& nloc, unsigned& nx) {
    const unsigned G = gridDim.x * gridDim.y * gridDim.z;
    unsigned sum, cnt, mine, sp = 0u;
    for (;;) {
        sum = 0u; cnt = 0u; mine = 0u;
#pragma unroll
        for (unsigned j = 0; j < 16; ++j) { const unsigned c = xb_ld(&bar[XB_XCNT(j)]); sum += c; cnt += (c > 0u) ? 1u : 0u; mine = (j == x) ? c : mine; }
        if (sum == G) break;
        __builtin_amdgcn_s_sleep(1);
        if ((++sp & 255u) == 0u) { if (xb_ld(&bar[XB_TMO])) break; if (sp > XB_SPIN_CAP) { atomicAdd(&bar[XB_TMO], 1u); break; } }
    }
    nloc = mine > 0u ? mine : 1u; nx = cnt > 0u ? cnt : 1u;
}
__device__ __forceinline__ void xcd_barrier(const XcdBarrier& b) {
    asm volatile("s_waitcnt vmcnt(0)" ::: "memory");
    __syncthreads();
    if (tid_now() == 0) {
        unsigned* bar = b.bar;
        __builtin_amdgcn_s_waitcnt(0);
        unsigned nloc = b.st[0], nx = b.st[1];
        if (nloc == 0u) { xcd_barrier_complete(bar, b.x, nloc, nx); b.st[0] = nloc; b.st[1] = nx; }
        const unsigned old = xb_add(&bar[XB_XSUB(b.x)], 1u);
        const unsigned gen = old / nloc;
        if (old + 1u == (gen + 1u) * nloc) {
            __builtin_amdgcn_fence(__ATOMIC_RELEASE, "agent");
            asm volatile("s_waitcnt vmcnt(0)" ::: "memory");
            const unsigned og = xb_add(&bar[XB_TOP], 1u);
            const unsigned tg = og / nx;
            if (og + 1u == (tg + 1u) * nx) xb_add(&bar[XB_TOPGEN], 1u);
            else XB_SPIN(xb_ld(&bar[XB_TOPGEN]) == tg, bar);
            __builtin_amdgcn_fence(__ATOMIC_ACQUIRE, "agent");
            xb_add(&bar[XB_XGEN(b.x)], 1u);
            asm volatile("s_waitcnt vmcnt(0)" ::: "memory");
        } else {
            XB_SPIN(xb_ld(&bar[XB_XGEN(b.x)]) == gen, bar);
            __builtin_amdgcn_fence(__ATOMIC_ACQUIRE, "agent");
            asm volatile("s_waitcnt vmcnt(0)" ::: "memory");
        }
    }
    __syncthreads();
}

constexpr int NPHASES = 35;
__host__ __device__ inline bool phase_empty(int ph) { if (ph < 2 || ph >= 34) return false; const int L = (ph - 2) >> 3, k = (ph - 2) & 7; return (k == 2 && (L & 1) == 0) || k == 4; }

__global__ void __launch_bounds__(512, 2) fwd_megakernel(Params P) {
    extern __shared__ __attribute__((aligned(16))) unsigned char lds_raw[];
    LAS unsigned char* lds = (LAS unsigned char*)lds_raw;
    cg::grid_group grid = cg::this_grid();
    const int G = gridDim.x;
    typedef const Params __attribute__((address_space(4))) CParams;
    volatile LAS unsigned* MISC = (volatile LAS unsigned*)(lds + 131072 + 320);
    { const int t0 = threadIdx.x;
      if ((t0 & 63) == 0) ((volatile LAS int*)(lds + WIDTAB_OFF))[(unsigned)__builtin_amdgcn_s_getreg((5 << 11) | 4) & 63u] = t0 >> 6;
      if (t0 < 32) MISC[t0] = 0u; }
    __syncthreads();
    const int ph_lo = P.ph_lo, ph_hi = P.ph_hi;
    XcdBarrier bar; bar.bar = (unsigned*)(P.ws + WS_CTL); bar.x = 0; bar.st = MISC + 8;
    if (ph_hi - ph_lo > 1) bar = xcd_barrier_post((unsigned*)(P.ws + WS_CTL), MISC + 8);

    for (int ph = ph_lo; ph < ph_hi; ++ph) {
        const CParams* KP = (const CParams*)__builtin_amdgcn_kernarg_segment_ptr(); asm volatile("" : "+s"(KP));
        unsigned char* ws = KP->ws;
        bf16_t* T1 = (bf16_t*)(ws + WS_T1); bf16_t* ZB = (bf16_t*)(ws + WS_Z); bf16_t* HB = (bf16_t*)(ws + WS_H);
        bf16_t* XB = (bf16_t*)(ws + WS_XB); bf16_t* KVALL = (bf16_t*)(ws + WS_KVALL); bf16_t* MEMB = (bf16_t*)(ws + WS_MEMB); bf16_t* MQ = (bf16_t*)(ws + WS_MQ); bf16_t* VWO = (bf16_t*)(ws + WS_VWO);
        float* SSQ[2] = {(float*)(ws + WS_SSQ0), (float*)(ws + WS_SSQ1)};
        float* VSTAT = (float*)(ws + WS_VSTAT); float* RSTDMEM = (float*)(ws + WS_RSTDMEM);
        if (phase_empty(ph)) continue;
        if (ph == 0) {
            { Params Pl; for (int i = 0; i < 20; ++i) Pl.in[i] = KP->in[i]; Pl.out = KP->out; Pl.ws = ws; Pl.ph_lo = 0; Pl.ph_hi = 0; prologue_phase(Pl, lds, G); }
        } else if (ph == 1) {
            pg8::StaticOrder S; S.init(MR, 8192, G, (int)blockIdx.x);
            pg8::Gemm g{MEMB, (const bf16_t*)(ws + WS_WK), MR, 8192, D, D, D}; pg8::EpiAct<4> E{KVALL, 8192, nullptr, 1.f, RSTDMEM, nullptr}; pg8::gemm_phase<0>(lds, g, S, E);
        } else if (ph == 34) {
            final_norm_phase(XB, KP->out, KP->in[I_G_FINAL], G);
        } else {
            const int L = (ph - 2) >> 3, k = (ph - 2) & 7, j = L >> 1; const bool odd = (L & 1) != 0;
            if (k == 0) {
                const float* ssq_r = SSQ[(3 * L) & 1];
                if (!odd) { if (L == 0) pool_a_phase<true>(lds, KP->in[I_X], ssq_r, T1, G); else pool_a_phase<false>(lds, XB, ssq_r, T1, G); }
                else { pg8::Gemm g{XB, (const bf16_t*)(ws + WS_WIN) + (size_t)j * D * 2 * D, M, 2 * D, D, D, D}; pg8::StaticOrder S; S.init(M, 2 * D, G, (int)blockIdx.x);
                    pg8::EpiAct<2> E{ZB, 2 * D, ssq_r, 1.f, nullptr, VSTAT}; pg8::gemm_phase<0>(lds, g, S, E); }
                __syncthreads();
                { pg8::Gemm g{KVALL + L * 1024, (const bf16_t*)(ws + WS_WQ) + (size_t)L * D * D, 4 * MR, D, 256, 8192, D}; pg8::StaticOrder S; S.init(4 * MR, D, G, (int)blockIdx.x);
                  pg8::EpiAct<5> E{MQ, D, nullptr, QSCALE, nullptr, nullptr}; pg8::gemm_phase<3>(lds, g, S, E); }
                { pg8::Gemm g{(const bf16_t*)(ws + WS_WO) + (size_t)L * D * D, KVALL + 4096 + L * 1024, D, 4 * MR, 256, D, 8192}; pg8::StaticOrder S; S.init(D, 4 * MR, G, (int)blockIdx.x);
                  pg8::EpiAct<6> E{VWO, D, nullptr, 1.f, nullptr, nullptr}; pg8::gemm_phase<4>(lds, g, S, E); }
            } else if (k == 1 && odd) {
                sgu_spatial_phase(lds, ZB, VSTAT, KP->in[I_SGU_WS] + (size_t)j * 4 * 128 * 128, KP->in[I_SGU_BS] + j * 512, KP->in[I_SGU_LNG] + j * D, KP->in[I_SGU_LNB] + j * D, T1, G);
            } else if (k == 3) {
                pg8::Gemm g{XB, MQ, M, D, D, D, D}; pg8::StaticOrder S; S.init(M, D, G, (int)blockIdx.x);
                pg8::EpiSoftmax E{T1, SSQ[(3 * L + 1) & 1], (LAS float*)(lds + 131072 + 1024)}; pg8::gemm_phase<2>(lds, g, S, E);
            } else if (k == 6) {
                pg8::Gemm g{XB, (const bf16_t*)(ws + WS_W1) + (size_t)L * D * FF, M, FF, D, D, D}; pg8::StaticOrder S; S.init(M, FF, G, (int)blockIdx.x);
                pg8::EpiAct<1> E{HB, FF, SSQ[(3 * L + 2) & 1], 1.f, nullptr, nullptr}; pg8::gemm_phase<0>(lds, g, S, E);
            } else {
                pg8::StaticOrder S; S.init(M, D, G, (int)blockIdx.x);
                if (k == 1) {
                    pg8::Gemm g{T1, (const bf16_t*)(ws + WS_PW) + (size_t)j * 4 * 256 * 256, M, D, 256, D, 256};
                    if (L == 0) { pg8::EpiResid<true> E{KP->in[I_X], XB, SSQ[(3 * L + 1) & 1]}; pg8::gemm_phase<1>(lds, g, S, E); }
                    else { pg8::EpiResid<false> E{nullptr, XB, SSQ[(3 * L + 1) & 1]}; pg8::gemm_phase<1>(lds, g, S, E); }
                } else if (k == 5) {
                    pg8::Gemm g{T1, VWO, M, D, D, D, D}; pg8::EpiResid<false> E{nullptr, XB, SSQ[(3 * L + 2) & 1]}; pg8::gemm_phase<2>(lds, g, S, E);
                } else {
                    pg8::Gemm g; int upd;
                    if (k == 2) { g = pg8::Gemm{T1, (const bf16_t*)(ws + WS_WOUT) + (size_t)j * D * D, M, D, D, D, D}; upd = 3 * L; }
                    else        { g = pg8::Gemm{HB, (const bf16_t*)(ws + WS_W2) + (size_t)L * D * FF, M, D, FF, FF, FF}; upd = 3 * L + 2; }
                    pg8::EpiResid<false> E{nullptr, XB, SSQ[(upd + 1) & 1]}; pg8::gemm_phase<0>(lds, g, S, E);
                }
            }
        }
        if (ph + 1 < ph_hi) { if (ph == 0) grid.sync(); else xcd_barrier(bar); }
    }
}

extern "C" void kernel_launch(void* const* d_in, const int* in_sizes, int n_in, void* d_out, int out_size, void* d_ws, size_t ws_size, hipStream_t stream) {
    static int grid = 0;
    if (grid == 0) {
        if (n_in != 20 || in_sizes[0] != M * D || out_size != M * D || ws_size < WS_END) { fprintf(stderr, "kernel_launch: unexpected shapes (n_in %d, in0 %d, out %d, ws %zu); nothing launched\n", n_in, n_in > 0 ? in_sizes[0] : -1, out_size, ws_size); grid = -1; return; }
        int dev = 0, cus = 0, per_cu = 0;
        if (hipGetDevice(&dev) != hipSuccess || hipDeviceGetAttribute(&cus, hipDeviceAttributeMultiprocessorCount, dev) != hipSuccess) { grid = -1; return; }
        if (hipFuncSetAttribute((const void*)fwd_megakernel, hipFuncAttributeMaxDynamicSharedMemorySize, LDS_BYTES) != hipSuccess) { fprintf(stderr, "kernel_launch: hipFuncSetAttribute failed\n"); grid = -1; return; }
        if (hipOccupancyMaxActiveBlocksPerMultiprocessor(&per_cu, (const void*)fwd_megakernel, 512, LDS_BYTES) != hipSuccess || per_cu < 1) { fprintf(stderr, "kernel_launch: occupancy query gave %d\n", per_cu); per_cu = 1; }
        (void)hipGetLastError();
        grid = cus * per_cu;
        if (grid > 256) grid = 256;
        grid &= ~7;
        if (grid < 8) { grid = -1; return; }
    }
    if (grid < 0) return;
    Params p{};
    for (int i = 0; i < 20; ++i) p.in[i] = (const float*)d_in[i];
    p.out = (float*)d_out; p.ws = (unsigned char*)d_ws;
#if MK_SINGLE
    p.ph_lo = 0; p.ph_hi = NPHASES;
    if (hipMemsetAsync((char*)d_ws + WS_CTL, 0, CTL_BYTES, stream) != hipSuccess) { fprintf(stderr, "kernel_launch: memset failed\n"); return; }
    void* args[] = {&p};
    hipError_t e = hipLaunchCooperativeKernel((const void*)fwd_megakernel, dim3(grid), dim3(512), args, LDS_BYTES, stream);
    if (e != hipSuccess) fprintf(stderr, "kernel_launch: cooperative launch failed: %s (grid %d)\n", hipGetErrorString(e), grid);
#else
    for (int ph = 0; ph < NPHASES; ++ph) {
        if (phase_empty(ph)) continue;
        p.ph_lo = ph; p.ph_hi = ph + 1;
        hipLaunchKernelGGL(fwd_megakernel, dim3(grid), dim3(512), LDS_BYTES, stream, p);
    }
#endif
}
```

```cpp
#include <hip/hip_runtime.h>
#include <hip/hip_cooperative_groups.h>
#include <cstdio>
#include <cstdint>
namespace cg = cooperative_groups;

#ifndef MK_SINGLE
#define MK_SINGLE 1
#endif

#define LAS __attribute__((address_space(3)))
typedef unsigned short bf16_t;
typedef short bf16x8 __attribute__((ext_vector_type(8)));
typedef float f32x4 __attribute__((ext_vector_type(4)));
typedef float f32x2 __attribute__((ext_vector_type(2)));
typedef float f32x16 __attribute__((ext_vector_type(16)));
typedef unsigned u32x4 __attribute__((ext_vector_type(4)));
typedef unsigned u32x2 __attribute__((ext_vector_type(2)));

constexpr int D = 1024, BATCH = 16, SEQ = 4096, DEPTH = 4, FF = 4096, NMEM = 256;
constexpr int M = BATCH * SEQ;
constexpr int MR = BATCH * NMEM;
constexpr float EPS = 1e-6f;
constexpr float QSCALE = 0.0625f * 1.4426950408889634f;

constexpr size_t MiB = 1u << 20;
constexpr size_t WS_H = 0, WS_T1 = 0, WS_O = 128 * MiB, WS_Z = 256 * MiB;
constexpr size_t WS_XB = 512 * MiB;
constexpr size_t WS_KVALL = 640 * MiB, WS_MEMB = 704 * MiB;
constexpr size_t WS_SSQ0 = 712 * MiB, WS_SSQ1 = 716 * MiB, WS_VSTAT = 720 * MiB, WS_RSTDMEM = 728 * MiB;
constexpr size_t WS_CTL = 730 * MiB, CTL_BYTES = 16384;
constexpr size_t WS_WQ = 736 * MiB, WS_WO = 744 * MiB, WS_W1 = 752 * MiB, WS_W2 = 784 * MiB, WS_WK = 816 * MiB, WS_WV = 824 * MiB;
constexpr size_t WS_WIN = 832 * MiB, WS_WOUT = 840 * MiB, WS_PW = 844 * MiB;
constexpr size_t WS_MQ = 848 * MiB, WS_VWO = 880 * MiB, WS_END = 912 * MiB;

constexpr int LDS_BYTES = 147456;

struct Params {
    const float* in[20];
    float* out;
    unsigned char* ws;
    int ph_lo, ph_hi;
};

extern __shared__ __attribute__((aligned(16))) unsigned char g_lds[];
constexpr int WIDTAB_OFF = 131072 + 512;
__device__ __forceinline__ int tid_now() {
    unsigned m = ~0u; asm volatile("" : "+s"(m));
    const int lane = (int)__builtin_amdgcn_mbcnt_hi(m, __builtin_amdgcn_mbcnt_lo(m, 0u));
    const unsigned hw = (unsigned)__builtin_amdgcn_s_getreg((5 << 11) | 4) & 63u;
    const int wid = __builtin_amdgcn_readfirstlane(((volatile LAS int*)((LAS unsigned char*)g_lds + WIDTAB_OFF))[hw]);
    return wid * 64 + lane;
}
__device__ __forceinline__ unsigned cvt_pk_bf16(float lo, float hi) { unsigned r; asm volatile("v_cvt_pk_bf16_f32 %0, %1, %2" : "=v"(r) : "v"(lo), "v"(hi)); return r; }
__device__ __forceinline__ float sx(float v, int o, int lane) { return __builtin_bit_cast(float, __builtin_amdgcn_ds_bpermute((lane ^ o) << 2, __builtin_bit_cast(int, v))); }
__device__ __forceinline__ float wave_sum(float v, int lane) {
#pragma unroll
    for (int o = 1; o < 64; o <<= 1) v += sx(v, o, lane);
    return v;
}
__device__ __forceinline__ float gelu_tanh(float x) {
    const float y = 0.7978845608028654f * (x + 0.044715f * x * x * x);
    const float e = __builtin_amdgcn_exp2f(-2.0f * 1.4426950408889634f * y);
    return x * __builtin_amdgcn_rcpf(1.0f + e);
}

__device__ __forceinline__ int sig23(int r) { return (r & ~12) | ((r & 4) << 1) | ((r & 8) >> 1); }
namespace pg8 {
constexpr int BM = 256, BK = 64, HALF = 128, HTB = HALF * BK * 2, STAGE_BYTES = 8 * HTB, NXCD = 8, WGM = 8;
__host__ __device__ __forceinline__ int lds_byte(int r, int c) { const int st = (r >> 4) * 2 + (c >> 5), rr = r & 15, cc = c & 31, ob = rr * 64 + cc * 2; return st * 1024 + (ob ^ (((ob >> 9) & 1) << 5)); }
__host__ __device__ __forceinline__ void stage_rc(int b, int& R, int& C) { const int st = b / 1024, sb = b % 1024, swz = sb ^ (((sb >> 9) & 1) << 5); R = (st >> 1) * 16 + swz / 64; C = (st & 1) * 32 + (swz % 64) / 2; }
__host__ __device__ __forceinline__ int perm32(int rho) { const int n = rho >> 4, i = rho & 15; return 8 * (i >> 2) + 4 * n + (i & 3); }

struct Unit { int pm, pn; };
struct Gemm { const bf16_t* A; const bf16_t* Bt; int M, N, K, lda, ldb; };
template <int KIND> __device__ __forceinline__ const char* unitA(const Gemm& g, int pm, int pn, size_t tstepA) {
    size_t off = (size_t)((KIND == 3) ? (pm & 15) : pm) * tstepA;
    if (KIND == 1) off += (size_t)pn * 512; if (KIND == 3) off += (size_t)(pm >> 4) * 512; if (KIND == 4) off += (size_t)(pn >> 4) * 512;
    return (const char*)g.A + off;
}
template <int KIND> __device__ __forceinline__ const char* unitB(const Gemm& g, int pm, int pn, size_t tstepB) {
    size_t off = (size_t)((KIND == 4) ? (pn & 15) : pn) * tstepB;
    if (KIND == 2) off += (size_t)(pm >> 4) * 2097152; if (KIND == 3) off += (size_t)(pm >> 4) * 512; if (KIND == 4) off += (size_t)(pn >> 4) * 512;
    return (const char*)g.Bt + off;
}

struct StaticOrder {
    int nM, nN, nwg, G, c;
    __device__ void init(int M_, int N_, int G_, int c_) { nM = M_ / BM; nN = N_ / BM; nwg = nM * nN; G = G_; c = c_; }
    __device__ bool next(int i, Unit& u) const {
        const long L = (long)i * G + c; if (L >= nwg) return false;
        int wgid = (int)L; { const int q = nwg / NXCD, r = nwg % NXCD, xcd = wgid % NXCD, off = wgid / NXCD; wgid = (xcd < r ? xcd * (q + 1) : r * (q + 1) + (xcd - r) * q) + off; }
        const int nig = WGM * nN, gid = wgid / nig, fm = gid * WGM, gsz = (nM - fm) < WGM ? (nM - fm) : WGM;
        u.pm = fm + ((wgid % nig) % gsz); u.pn = (wgid % nig) / gsz; return true;
    }
};

__device__ __forceinline__ float rstd_from_slots(const float* ssq, int row, int fq, int lane) {
    const f32x4 v = *(const f32x4*)(ssq + (size_t)row * 16 + fq * 4);
    float s = (v[0] + v[1]) + (v[2] + v[3]);
    s += sx(s, 16, lane); s += sx(s, 32, lane);
    return __builtin_amdgcn_rsqf(s * (1.0f / 1024.0f) + EPS);
}

template <int MODE> struct EpiAct {
    bf16_t* O; int ldc; const float* ssq; float scale; const float* rvec; float* vstat;
    __device__ __forceinline__ void operator()(const f32x4 (&acc)[2][2][4][2], const Unit& u, int, int, int, int) const {
        int t_ = tid_now(); asm volatile("" : "+v"(t_));
        const int wid_ = __builtin_amdgcn_readfirstlane(t_ >> 6), wr = wid_ >> 2, wc = wid_ & 3, fr = t_ & 15, fq = (t_ & 63) >> 4;
        const int row0 = u.pm * BM + wr * 64 + fr, col0 = u.pn * BM + wc * 32 + 8 * fq;
        f32x4 cs[2][2];
        if (MODE == 3) {
#pragma unroll
            for (int bj = 0; bj < 2; ++bj) { cs[bj][0] = *(const f32x4*)(rvec + col0 + bj * HALF); cs[bj][1] = *(const f32x4*)(rvec + col0 + bj * HALF + 4); }
        }
#pragma unroll
        for (int ai = 0; ai < 2; ++ai)
#pragma unroll
            for (int m = 0; m < 4; ++m) {
                const int row = row0 + ai * HALF + m * 16;
                float rs = 1.f;
                if (MODE == 0 || MODE == 1 || MODE == 2) rs = rstd_from_slots(ssq, row, fq, fq * 16 + fr);
                if (MODE == 0) rs *= scale;
                if (MODE == 4) rs = rvec[row];
                bf16_t* rowp = O + (size_t)row * ldc + col0;
                if (MODE == 5) { const int rl = row - u.pm * BM; rowp = O + ((size_t)(u.pm & 15) << 20) + (size_t)((u.pm >> 4) * 256 + rl) * 1024 + col0; rs = scale; }
                if (MODE == 6) { rowp = O + ((size_t)(u.pn & 15) << 20) + (size_t)row * 1024 + (u.pn >> 4) * 256 + (col0 - u.pn * BM); }
                float s1 = 0.f, s2 = 0.f;
#pragma unroll
                for (int bj = 0; bj < 2; ++bj) {
                    f32x4 v0 = acc[ai][bj][m][0] * rs, v1 = acc[ai][bj][m][1] * rs;
                    if (MODE == 3) { v0 = acc[ai][bj][m][0] * cs[bj][0]; v1 = acc[ai][bj][m][1] * cs[bj][1]; }
                    if (MODE == 1) {
#pragma unroll
                        for (int j = 0; j < 4; ++j) { const float a = v0[j] > 0.f ? v0[j] : 0.f, b = v1[j] > 0.f ? v1[j] : 0.f; v0[j] = a * a; v1[j] = b * b; }
                    }
                    if (MODE == 2) {
#pragma unroll
                        for (int j = 0; j < 4; ++j) { v0[j] = gelu_tanh(v0[j]); v1[j] = gelu_tanh(v1[j]); }
#pragma unroll
                        for (int j = 0; j < 4; ++j) { s1 += v0[j] + v1[j]; s2 += v0[j] * v0[j] + v1[j] * v1[j]; }
                    }
                    u32x4 w; w.x = cvt_pk_bf16(v0[0], v0[1]); w.y = cvt_pk_bf16(v0[2], v0[3]); w.z = cvt_pk_bf16(v1[0], v1[1]); w.w = cvt_pk_bf16(v1[2], v1[3]);
                    bf16_t* sp = rowp + bj * HALF;
                    if (MODE == 1) { const int col = col0 + bj * HALF; sp = O + (((size_t)(u.pm * (ldc >> 6) + (col >> 6)) * BM + (row - u.pm * BM)) << 6) + (col & 63); }
                    __builtin_nontemporal_store(w, (u32x4*)sp);
                }
                if (MODE == 2) {
                    { const int ln = fq * 16 + fr; s1 += sx(s1, 16, ln); s1 += sx(s1, 32, ln); s2 += sx(s2, 16, ln); s2 += sx(s2, 32, ln); }
                    if (u.pn >= 4 && fq == 0) { vstat[(size_t)row * 32 + (u.pn - 4) * 4 + wc] = s1; vstat[(size_t)row * 32 + 16 + (u.pn - 4) * 4 + wc] = s2; }
                }
            }
    }
};
struct EpiSoftmax {
    bf16_t* O; const float* ssq; LAS float* red;
    __device__ __forceinline__ void operator()(f32x4 (&acc)[2][2][4][2], const Unit& u, int, int, int, int) const {
        int t_ = tid_now(); asm volatile("" : "+v"(t_));
        const int wid_ = __builtin_amdgcn_readfirstlane(t_ >> 6), wr = wid_ >> 2, wc = wid_ & 3, fr = t_ & 15, fq = (t_ & 63) >> 4;
        const int row0 = u.pm * BM + wr * 64 + fr, col0 = u.pn * BM + wc * 32 + 8 * fq, lane = fq * 16 + fr;
#pragma unroll
        for (int ai = 0; ai < 2; ++ai)
#pragma unroll
            for (int m = 0; m < 4; ++m) {
                const int rl = ai * HALF + wr * 64 + m * 16 + fr;
                const float rs = rstd_from_slots(ssq, u.pm * BM + rl, fq, lane);
                float mx = -3.0e38f;
#pragma unroll
                for (int bj = 0; bj < 2; ++bj)
#pragma unroll
                    for (int n = 0; n < 2; ++n) { acc[ai][bj][m][n] = acc[ai][bj][m][n] * rs;
#pragma unroll
                        for (int j = 0; j < 4; ++j) mx = fmaxf(mx, acc[ai][bj][m][n][j]); }
                mx = fmaxf(mx, sx(mx, 16, lane)); mx = fmaxf(mx, sx(mx, 32, lane));
                if (fq == 0) red[rl * 4 + wc] = mx;
            }
        asm volatile("s_waitcnt lgkmcnt(0)" ::: "memory"); __builtin_amdgcn_s_barrier(); asm volatile("" ::: "memory");
#pragma unroll
        for (int ai = 0; ai < 2; ++ai)
#pragma unroll
            for (int m = 0; m < 4; ++m) {
                const int rl = ai * HALF + wr * 64 + m * 16 + fr;
                const f32x4 r4 = *(const LAS f32x4*)(red + rl * 4);
                const float mx = fmaxf(fmaxf(r4[0], r4[1]), fmaxf(r4[2], r4[3]));
                float sm = 0.f;
#pragma unroll
                for (int bj = 0; bj < 2; ++bj)
#pragma unroll
                    for (int n = 0; n < 2; ++n)
#pragma unroll
                        for (int j = 0; j < 4; ++j) { const float e = __builtin_amdgcn_exp2f(acc[ai][bj][m][n][j] - mx); acc[ai][bj][m][n][j] = e; sm += e; }
                sm += sx(sm, 16, lane); sm += sx(sm, 32, lane);
                if (fq == 0) red[1024 + rl * 4 + wc] = sm;
            }
        asm volatile("s_waitcnt lgkmcnt(0)" ::: "memory"); __builtin_amdgcn_s_barrier(); asm volatile("" ::: "memory");
#pragma unroll
        for (int ai = 0; ai < 2; ++ai)
#pragma unroll
            for (int m = 0; m < 4; ++m) {
                const int rl = ai * HALF + wr * 64 + m * 16 + fr;
                const f32x4 r4 = *(const LAS f32x4*)(red + 1024 + rl * 4);
                const float inv = 1.0f / ((r4[0] + r4[1]) + (r4[2] + r4[3]));
                bf16_t* rowp = O + (size_t)(row0 + ai * HALF + m * 16) * D + col0;
#pragma unroll
                for (int bj = 0; bj < 2; ++bj) {
                    const f32x4 v0 = acc[ai][bj][m][0] * inv, v1 = acc[ai][bj][m][1] * inv;
                    u32x4 w; w.x = cvt_pk_bf16(v0[0], v0[1]); w.y = cvt_pk_bf16(v0[2], v0[3]); w.z = cvt_pk_bf16(v1[0], v1[1]); w.w = cvt_pk_bf16(v1[2], v1[3]);
                    __builtin_nontemporal_store(w, (u32x4*)(rowp + bj * HALF));
                }
            }
    }
};
template <bool F32IN> struct EpiResid {
    const float* xin; bf16_t* xb; float* ssq;
    __device__ __forceinline__ void operator()(const f32x4 (&acc)[2][2][4][2], const Unit& u, int, int, int, int) const {
        int t_ = tid_now(); asm volatile("" : "+v"(t_));
        const int wid_ = __builtin_amdgcn_readfirstlane(t_ >> 6), wr = wid_ >> 2, wc = wid_ & 3, fr = t_ & 15, fq = (t_ & 63) >> 4;
        const int row0 = u.pm * BM + wr * 64 + fr, col0 = u.pn * BM + wc * 32 + 8 * fq;
#pragma unroll
        for (int ai = 0; ai < 2; ++ai)
#pragma unroll
            for (int m = 0; m < 4; ++m) {
                const int row = row0 + ai * HALF + m * 16; const size_t off = (size_t)row * D + col0;
                float ss = 0.f;
#pragma unroll
                for (int bj = 0; bj < 2; ++bj) {
                    f32x4 a0, a1;
                    if (F32IN) { a0 = *(const f32x4*)(xin + off + bj * HALF); a1 = *(const f32x4*)(xin + off + bj * HALF + 4); }
                    else { const u32x4 r = *(const u32x4*)(xb + off + bj * HALF);
                        a0 = (f32x4){__uint_as_float(r.x << 16), __uint_as_float(r.x & 0xffff0000u), __uint_as_float(r.y << 16), __uint_as_float(r.y & 0xffff0000u)};
                        a1 = (f32x4){__uint_as_float(r.z << 16), __uint_as_float(r.z & 0xffff0000u), __uint_as_float(r.w << 16), __uint_as_float(r.w & 0xffff0000u)}; }
                    const f32x4 v0 = a0 + acc[ai][bj][m][0], v1 = a1 + acc[ai][bj][m][1];
                    u32x4 w; w.x = cvt_pk_bf16(v0[0], v0[1]); w.y = cvt_pk_bf16(v0[2], v0[3]); w.z = cvt_pk_bf16(v1[0], v1[1]); w.w = cvt_pk_bf16(v1[2], v1[3]);
                    __builtin_nontemporal_store(w, (u32x4*)(xb + off + bj * HALF));
                    const unsigned ww[4] = {w.x, w.y, w.z, w.w};
#pragma unroll
                    for (int j = 0; j < 4; ++j) { const float lo = __uint_as_float(ww[j] << 16), hi = __uint_as_float(ww[j] & 0xffff0000u); ss += lo * lo + hi * hi; }
                }
                { const int ln = fq * 16 + fr; ss += sx(ss, 16, ln); ss += sx(ss, 32, ln); }
                if (fq == 0) ssq[(size_t)row * 16 + u.pn * 4 + wc] = ss;
                asm volatile("" ::: "memory");
            }
    }
};

template <int KIND, class Epi>
__device__ __forceinline__ void gemm_phase(LAS unsigned char* lds, const Gemm g, const StaticOrder& S, const Epi& E) {
    int tid_ = tid_now(); asm volatile("" : "+v"(tid_));
    const int tid = tid_, wid = __builtin_amdgcn_readfirstlane(tid >> 6), lane = tid & 63, wr = wid >> 2, wc = wid & 3, fr = lane & 15, fq = lane >> 4;
    const int nt = g.K / BK;
    unsigned voffA[2], voffB[2];
#pragma unroll
    for (int i = 0; i < 2; ++i) { int R, C; stage_rc(tid * 16 + i * 8192, R, C); const int Rb = (R & ~31) + perm32(R & 31);
        voffA[i] = (unsigned)(R * g.lda + C) * 2u; voffB[i] = (unsigned)(Rb * g.ldb + C) * 2u; }
    const size_t kstep = (size_t)(BK * 2), kstepA = (KIND == 5) ? (size_t)(BM * BK * 2) : kstep;
    const size_t hstepA = (size_t)HALF * g.lda * 2, hstepB = (size_t)HALF * g.ldb * 2;
    const size_t tstepA = (KIND == 5) ? (size_t)g.K * BM * 2 : 2 * hstepA, tstepB = 2 * hstepB;
    const unsigned ldsw = (unsigned)wid * 1024u;
    const int aoff = lds_byte(wr * 64 + fr, fq * 8), boff = lds_byte(wc * 32 + fr, fq * 8);
#define PG8_SA(b, h) (((b) * 2 + (h)) * HTB)
#define PG8_SB(b, h) ((4 + (b) * 2 + (h)) * HTB)
#define PG8_STAGE(bufoff, gbase, voff) do { _Pragma("unroll") for (int _i = 0; _i < 2; ++_i) \
        __builtin_amdgcn_global_load_lds((const unsigned*)((const char*)(gbase) + (voff)[_i]), (LAS unsigned*)(lds + (bufoff) + ldsw + _i * 8192), 16, 0, 0); } while (0)
#define PG8_LDA(dst, b, h) do { _Pragma("unroll") for (int m = 0; m < 4; ++m) _Pragma("unroll") for (int k = 0; k < 2; ++k) dst[m][k] = *(const LAS bf16x8*)(lds + PG8_SA(b, h) + aoff + m * 2048 + k * 1024); } while (0)
#define PG8_LDB(dst, b, h) do { _Pragma("unroll") for (int n = 0; n < 2; ++n) _Pragma("unroll") for (int k = 0; k < 2; ++k) dst[n][k] = *(const LAS bf16x8*)(lds + PG8_SB(b, h) + boff + n * 2048 + k * 1024); } while (0)
#define PG8_MMA(ai, bj, At, Bt) do { __builtin_amdgcn_s_setprio(1); _Pragma("unroll") for (int m = 0; m < 4; ++m) _Pragma("unroll") for (int n = 0; n < 2; ++n) _Pragma("unroll") for (int k = 0; k < 2; ++k) \
        acc[ai][bj][m][n] = __builtin_amdgcn_mfma_f32_16x16x32_bf16(Bt[n][k], At[m][k], acc[ai][bj][m][n], 0, 0, 0); __builtin_amdgcn_s_setprio(0); } while (0)
#define PG8_WAIT_V(n) asm volatile("s_waitcnt vmcnt(" #n ")" ::: "memory")
#define PG8_WAIT_L(n) asm volatile("s_waitcnt lgkmcnt(" #n ")" ::: "memory")
#define PG8_BAR __builtin_amdgcn_s_barrier()
#define PG8_SCHED __builtin_amdgcn_sched_barrier(0)
    Unit cur, nxt; int ui = 0;
    if (!S.next(0, cur)) return;
    f32x4 acc[2][2][4][2];
#pragma unroll
    for (int a = 0; a < 2; ++a)
#pragma unroll
        for (int b = 0; b < 2; ++b)
#pragma unroll
            for (int m = 0; m < 4; ++m)
#pragma unroll
                for (int n = 0; n < 2; ++n) acc[a][b][m][n] = (f32x4){0.f, 0.f, 0.f, 0.f};
    bf16x8 At[4][2], B0[2][2], B1[2][2];
    const char* cA = unitA<KIND>(g, cur.pm, cur.pn, tstepA); const char* cB = unitB<KIND>(g, cur.pm, cur.pn, tstepB);
    PG8_STAGE(PG8_SB(0, 0), cB, voffB); PG8_STAGE(PG8_SB(0, 1), cB + hstepB, voffB); PG8_STAGE(PG8_SA(0, 0), cA, voffA); PG8_STAGE(PG8_SA(0, 1), cA + hstepA, voffA);
    if (wr == 1) PG8_BAR;
    PG8_WAIT_V(2); PG8_BAR;
    PG8_STAGE(PG8_SB(1, 0), cB + kstep, voffB); PG8_STAGE(PG8_SA(1, 0), cA + kstepA, voffA); PG8_STAGE(PG8_SB(1, 1), cB + hstepB + kstep, voffB);
    PG8_WAIT_V(6); PG8_BAR;
    for (;;) {
        const bool has_next = S.next(ui + 1, nxt);
        const char* nA = has_next ? unitA<KIND>(g, nxt.pm, nxt.pn, tstepA) : cA; const char* nB = has_next ? unitB<KIND>(g, nxt.pm, nxt.pn, tstepB) : cB;
        for (int t = 0; t < nt; t += 2) {
            const bool last = (t == nt - 2);
            const char* a1 = cA + (size_t)(t + 1) * kstepA;
            const char* a2 = last ? nA : cA + (size_t)(t + 2) * kstepA; const char* b2 = last ? nB : cB + (size_t)(t + 2) * kstep;
            const char* a3 = a2 + kstepA; const char* b3 = b2 + kstep;
            PG8_LDB(B0, 0, 0); PG8_LDB(B1, 0, 1); PG8_SCHED; PG8_LDA(At, 0, 0); PG8_STAGE(PG8_SA(1, 1), a1 + hstepA, voffA);
            PG8_WAIT_V(8); PG8_WAIT_L(0); PG8_BAR; PG8_MMA(0, 0, At, B0); PG8_MMA(0, 1, At, B1); PG8_BAR; PG8_SCHED;
            PG8_LDA(At, 0, 1); PG8_STAGE(PG8_SB(0, 0), b2, voffB); PG8_STAGE(PG8_SB(0, 1), b2 + hstepB, voffB); PG8_STAGE(PG8_SA(0, 0), a2, voffA);
            PG8_WAIT_V(8); PG8_WAIT_L(0); PG8_BAR; PG8_MMA(1, 0, At, B0); PG8_MMA(1, 1, At, B1); PG8_BAR; PG8_SCHED;
            PG8_LDB(B0, 1, 0); PG8_LDB(B1, 1, 1); PG8_SCHED; PG8_LDA(At, 1, 0); PG8_STAGE(PG8_SA(0, 1), a2 + hstepA, voffA);
            PG8_WAIT_V(8); PG8_WAIT_L(0); PG8_BAR; PG8_MMA(0, 0, At, B0); PG8_MMA(0, 1, At, B1); PG8_BAR; PG8_SCHED;
            PG8_LDA(At, 1, 1); PG8_STAGE(PG8_SB(1, 0), b3, voffB); PG8_STAGE(PG8_SB(1, 1), b3 + hstepB, voffB); PG8_STAGE(PG8_SA(1, 0), a3, voffA);
            PG8_WAIT_V(8); PG8_WAIT_L(0); PG8_BAR; PG8_MMA(1, 0, At, B0); PG8_MMA(1, 1, At, B1); PG8_BAR; PG8_SCHED;
        }
        if (wr == 0) PG8_BAR;
        E(acc, cur, wr, wc, fr, fq);
        if (!has_next) break;
#pragma unroll
        for (int a = 0; a < 2; ++a)
#pragma unroll
            for (int b = 0; b < 2; ++b)
#pragma unroll
                for (int m = 0; m < 4; ++m)
#pragma unroll
                    for (int n = 0; n < 2; ++n) acc[a][b][m][n] = (f32x4){0.f, 0.f, 0.f, 0.f};
        cur = nxt; cA = nA; cB = nB; ++ui;
        if (wr == 1) PG8_BAR;
    }
    PG8_WAIT_V(0);
    PG8_BAR;
#undef PG8_SA
#undef PG8_SB
#undef PG8_STAGE
#undef PG8_LDA
#undef PG8_LDB
#undef PG8_MMA
#undef PG8_WAIT_V
#undef PG8_WAIT_L
#undef PG8_BAR
#undef PG8_SCHED
}
}

struct MatDesc { const float* src; int ldw, K, N; bf16_t* dst; int ldt; const float* ks; const float* ns; };

__device__ __forceinline__ void transpose_item(const MatDesc& d, LAS float* scr, int item, int lane) {
    const int nblk = d.N / 32, kb = item / nblk, nb = item % nblk, k0 = 64 * kb, n0 = 32 * nb;
    const int n4 = lane & 7, rr = lane >> 3;
    f32x4 nsv = (f32x4){1.f, 1.f, 1.f, 1.f};
    if (d.ns) nsv = *(const f32x4*)(d.ns + n0 + 4 * n4);
    f32x4 v[8];
#pragma unroll
    for (int j = 0; j < 8; ++j) v[j] = *(const f32x4*)(d.src + (size_t)(k0 + rr + 8 * j) * d.ldw + n0 + 4 * n4);
#pragma unroll
    for (int j = 0; j < 8; ++j) { const int kk = rr + 8 * j; f32x4 w = v[j] * nsv; if (d.ks) w = w * d.ks[k0 + kk];
        scr[kk * 33 + 4 * n4 + 0] = w[0]; scr[kk * 33 + 4 * n4 + 1] = w[1]; scr[kk * 33 + 4 * n4 + 2] = w[2]; scr[kk * 33 + 4 * n4 + 3] = w[3]; }
    asm volatile("s_waitcnt lgkmcnt(0)" ::: "memory");
    const int c = lane & 7;
#pragma unroll
    for (int j = 0; j < 4; ++j) { const int n = (lane >> 3) + 8 * j; const LAS float* s = scr + (8 * c) * 33 + n;
        u32x4 o; o.x = cvt_pk_bf16(s[0 * 33], s[1 * 33]); o.y = cvt_pk_bf16(s[2 * 33], s[3 * 33]); o.z = cvt_pk_bf16(s[4 * 33], s[5 * 33]); o.w = cvt_pk_bf16(s[6 * 33], s[7 * 33]);
        *(u32x4*)(d.dst + (size_t)(n0 + n) * d.ldt + k0 + 8 * c) = o; }
    asm volatile("s_waitcnt lgkmcnt(0)" ::: "memory");
}

enum { I_X = 0, I_MEM, I_G_MIX, I_G_MEM, I_G_MEMKV, I_G_FFN, I_G_FINAL, I_POOL_W, I_POOL_SCALE, I_SGU_WIN, I_SGU_LNG, I_SGU_LNB, I_SGU_WS, I_SGU_BS, I_SGU_WOUT, I_WQ, I_WKV, I_WO, I_W1, I_W2 };

__device__ __forceinline__ MatDesc get_mat(const Params& P, int id) {
    MatDesc d; d.ks = nullptr; d.ns = nullptr;
    unsigned char* ws = P.ws;
    if (id < 24) {
        const int L = id / 6, t = id % 6;
        if (t == 0)      { d.src = P.in[I_WQ] + (size_t)L * D * D; d.ldw = D; d.K = D; d.N = D; d.dst = (bf16_t*)(ws + WS_WQ) + (size_t)L * D * D; d.ldt = D; d.ks = P.in[I_G_MEM] + L * D; }
        else if (t == 1) { d.src = P.in[I_WKV] + (size_t)L * D * 2 * D; d.ldw = 2 * D; d.K = D; d.N = D; d.dst = (bf16_t*)(ws + WS_WK) + (size_t)L * D * D; d.ldt = D; d.ks = P.in[I_G_MEMKV] + L * D; }
        else if (t == 2) { d.src = P.in[I_WKV] + (size_t)L * D * 2 * D + D; d.ldw = 2 * D; d.K = D; d.N = D; d.dst = (bf16_t*)(ws + WS_WV) + (size_t)L * D * D; d.ldt = D; d.ks = P.in[I_G_MEMKV] + L * D; }
        else if (t == 3) { d.src = P.in[I_WO] + (size_t)L * D * D; d.ldw = D; d.K = D; d.N = D; d.dst = (bf16_t*)(ws + WS_WO) + (size_t)L * D * D; d.ldt = D; }
        else if (t == 4) { d.src = P.in[I_W1] + (size_t)L * D * FF; d.ldw = FF; d.K = D; d.N = FF; d.dst = (bf16_t*)(ws + WS_W1) + (size_t)L * D * FF; d.ldt = D; d.ks = P.in[I_G_FFN] + L * D; }
        else             { d.src = P.in[I_W2] + (size_t)L * D * FF; d.ldw = D; d.K = FF; d.N = D; d.dst = (bf16_t*)(ws + WS_W2) + (size_t)L * D * FF; d.ldt = FF; }
    } else if (id < 28) {
        const int j = (id - 24) >> 1, t = (id - 24) & 1;
        if (t == 0) { d.src = P.in[I_SGU_WIN] + (size_t)j * D * 2 * D; d.ldw = 2 * D; d.K = D; d.N = 2 * D; d.dst = (bf16_t*)(ws + WS_WIN) + (size_t)j * D * 2 * D; d.ldt = D; d.ks = P.in[I_G_MIX] + (2 * j + 1) * D; }
        else        { d.src = P.in[I_SGU_WOUT] + (size_t)j * D * D; d.ldw = D; d.K = D; d.N = D; d.dst = (bf16_t*)(ws + WS_WOUT) + (size_t)j * D * D; d.ldt = D; }
    } else {
        const int jg = id - 28, j = jg >> 2, g = jg & 3;
        d.src = P.in[I_POOL_W] + (size_t)jg * 256 * 256; d.ldw = 256; d.K = 256; d.N = 256; d.dst = (bf16_t*)(ws + WS_PW) + (size_t)jg * 256 * 256; d.ldt = 256;
        d.ks = P.in[I_G_MIX] + (2 * j) * D + g * 256; d.ns = P.in[I_POOL_SCALE] + j * D + g * 256;
    }
    return d;
}
__device__ __forceinline__ int mat_items(int id) {
    if (id < 24) { const int t = id % 6; return (t == 0) ? 0 : ((t >= 4) ? 2048 : 512); }
    if (id < 28) return ((id - 24) & 1) ? 512 : 1024;
    return 32;
}

__device__ __forceinline__ void prologue_phase(const Params& P, LAS unsigned char* lds, int G) {
    int tid_ = tid_now(); asm volatile("" : "+v"(tid_));
    const int tid = tid_, lane = tid & 63, wave = __builtin_amdgcn_readfirstlane(tid >> 6);
    LAS float* scr = (LAS float*)(lds + wave * 16384);
    const int gw = blockIdx.x * 8 + wave, NGW = G * 8;
    constexpr int NITEMS = 4 * (3 * 512 + 2 * 2048) + 2 * (1024 + 512) + 8 * 32;
    for (int it = gw; it < NITEMS; it += NGW) {
        int r = it, id = 0;
        for (; id < 36; ++id) { const int n = mat_items(id); if (r < n) break; r -= n; }
        const MatDesc d = get_mat(P, id);
        transpose_item(d, scr, r, lane);
    }
    { const float* wq = P.in[I_WQ]; const float* gq = P.in[I_G_MEM]; bf16_t* wqb = (bf16_t*)(P.ws + WS_WQ);
      for (int r = gw; r < DEPTH * D; r += NGW) { const float gk = gq[r]; const f32x4* xr = (const f32x4*)(wq + (size_t)r * D) + lane; u32x2* o = (u32x2*)(wqb + (size_t)r * D) + lane;
#pragma unroll
        for (int j = 0; j < 4; ++j) { const f32x4 v = xr[64 * j] * gk; u32x2 w; w.x = cvt_pk_bf16(v[0], v[1]); w.y = cvt_pk_bf16(v[2], v[3]); o[64 * j] = w; } } }
    const float* mem = P.in[I_MEM]; bf16_t* memb = (bf16_t*)(P.ws + WS_MEMB); float* rstd_mem = (float*)(P.ws + WS_RSTDMEM);
    for (int r = gw; r < MR; r += NGW) {
        const f32x4* xr = (const f32x4*)(mem + (size_t)r * D) + lane; f32x4 v[4]; float s = 0.f;
#pragma unroll
        for (int j = 0; j < 4; ++j) { v[j] = xr[64 * j]; s += (v[j][0] * v[j][0] + v[j][1] * v[j][1]) + (v[j][2] * v[j][2] + v[j][3] * v[j][3]); }
        s = wave_sum(s, lane);
        if (lane == 0) rstd_mem[r] = 1.0f / sqrtf(s * (1.0f / D) + EPS);
        u32x2* o = (u32x2*)(memb + (size_t)r * D) + lane;
#pragma unroll
        for (int j = 0; j < 4; ++j) { u32x2 w; w.x = cvt_pk_bf16(v[j][0], v[j][1]); w.y = cvt_pk_bf16(v[j][2], v[j][3]); o[64 * j] = w; }
    }
    const float* x = P.in[I_X]; float* ssq0 = (float*)(P.ws + WS_SSQ0);
    for (int r = gw; r < M; r += 2 * NGW) {
        const int r1 = (r + NGW < M) ? r + NGW : r;
        f32x4 va[4], vb[4];
#pragma unroll
        for (int j = 0; j < 4; ++j) { va[j] = ((const f32x4*)(x + (size_t)r * D) + lane)[64 * j]; vb[j] = ((const f32x4*)(x + (size_t)r1 * D) + lane)[64 * j]; }
        float s = 0.f, t = 0.f;
#pragma unroll
        for (int j = 0; j < 4; ++j) { s += (va[j][0] * va[j][0] + va[j][1] * va[j][1]) + (va[j][2] * va[j][2] + va[j][3] * va[j][3]); t += (vb[j][0] * vb[j][0] + vb[j][1] * vb[j][1]) + (vb[j][2] * vb[j][2] + vb[j][3] * vb[j][3]); }
        s = wave_sum(s, lane); t = wave_sum(t, lane);
        if (lane < 16) { ssq0[(size_t)r * 16 + lane] = (lane == 0) ? s : 0.f; if (r1 != r) ssq0[(size_t)r1 * 16 + lane] = (lane == 0) ? t : 0.f; }
    }
}

template <int W>
__device__ __forceinline__ void pool_block(const f32x2 (&prev)[16], const f32x2 (&cur)[16], bool seq_start, bf16_t* outp  ) {
#pragma unroll
    for (int i = 0; i < 16; ++i) {
        f32x2 s = cur[i];
#pragma unroll
        for (int j = 1; j < W; ++j) { s += (i - j >= 0) ? cur[(i - j) & 15] : prev[(16 + i - j) & 15]; }
        float inv = 1.0f / (float)W;
        if (i < W - 1 && seq_start) inv = 1.0f / (float)(i + 1);
        const f32x2 o = s * inv - cur[i];
        *(unsigned*)(outp + (size_t)i * D) = cvt_pk_bf16(o[0], o[1]);
    }
}
template <bool F32IN> __device__ __forceinline__ f32x2 pool_ld(const void* x, size_t idx) {
    if (F32IN) return *(const f32x2*)((const float*)x + idx);
    const unsigned r = *(const unsigned*)((const bf16_t*)x + idx); return (f32x2){__uint_as_float(r << 16), __uint_as_float(r & 0xffff0000u)};
}
template <bool F32IN>
__device__ __forceinline__ void pool_a_phase(LAS unsigned char* lds, const void* x, const float* ssq, bf16_t* PA, int G) {
    LAS float* rs = (LAS float*)lds;
    int tid_ = tid_now(); asm volatile("" : "+v"(tid_));
    const int tid = tid_, ch = 2 * tid, group = __builtin_amdgcn_readfirstlane(tid >> 7);
    for (int chunk = blockIdx.x; chunk < M / 64; chunk += G) {
        const int t0 = chunk * 64; const bool sstart = (t0 & (SEQ - 1)) == 0;
        __syncthreads();
        if (tid < 80) {
            float r = 0.f;
            if (!(sstart && tid < 16)) { const f32x4* p = (const f32x4*)(ssq + (size_t)(t0 - 16 + tid) * 16); const f32x4 a = p[0], b = p[1], c = p[2], d = p[3];
                const float s = (((a[0] + a[1]) + (a[2] + a[3])) + ((b[0] + b[1]) + (b[2] + b[3]))) + (((c[0] + c[1]) + (c[2] + c[3])) + ((d[0] + d[1]) + (d[2] + d[3])));
                r = 1.0f / sqrtf(s * (1.0f / D) + EPS); }
            rs[tid] = r;
        }
        __syncthreads();
        f32x2 prev[16], cur[16];
        if (sstart) {
#pragma unroll
            for (int i = 0; i < 16; ++i) prev[i] = (f32x2){0.f, 0.f};
        } else {
#pragma unroll
            for (int i = 0; i < 16; ++i) prev[i] = pool_ld<F32IN>(x, (size_t)(t0 - 16 + i) * D + ch) * rs[i];
        }
        for (int blk = 0; blk < 4; ++blk) {
#pragma unroll
            for (int i = 0; i < 16; ++i) cur[i] = pool_ld<F32IN>(x, (size_t)(t0 + blk * 16 + i) * D + ch) * rs[16 + blk * 16 + i];
            bf16_t* outp = PA + (size_t)(t0 + blk * 16) * D + ch;
            const bool ss = sstart && blk == 0;
            if (group == 0) pool_block<2>(prev, cur, ss, outp);
            else if (group == 1) pool_block<4>(prev, cur, ss, outp);
            else if (group == 2) pool_block<8>(prev, cur, ss, outp);
            else pool_block<16>(prev, cur, ss, outp);
#pragma unroll
            for (int i = 0; i < 16; ++i) prev[i] = cur[i];
        }
    }
}

__device__ __forceinline__ void sgu_spatial_phase(LAS unsigned char* lds, const bf16_t* Z, const float* vstat, const float* wsf, const float* bsf, const float* lng, const float* lnb, bf16_t* T1, int G) {
    constexpr int APITCH = 272;
    LAS unsigned char* Aimg = lds;
    LAS unsigned char* VT = lds + 34816;
    LAS float* mu = (LAS float*)(lds + 34816 + 67584); LAS float* rsd = mu + 128;
    int tid_ = tid_now(); asm volatile("" : "+v"(tid_));
    const int tid = tid_, lane = tid & 63, wave = __builtin_amdgcn_readfirstlane(tid >> 6);
    const int g = blockIdx.x & 3;
    bool first = true;
    for (int u = blockIdx.x; u < (M / 128) * 4; u += G) {
        const int nb = u >> 2; const size_t rowb = (size_t)nb * 128;
        __syncthreads();
        if (tid < 128) {
            const f32x4* p = (const f32x4*)(vstat + (rowb + tid) * 32); float s1 = 0.f, s2 = 0.f;
#pragma unroll
            for (int i = 0; i < 4; ++i) { const f32x4 a = p[i], b = p[4 + i]; s1 += (a[0] + a[1]) + (a[2] + a[3]); s2 += (b[0] + b[1]) + (b[2] + b[3]); }
            const float m = s1 * (1.0f / D), var = s2 * (1.0f / D) - m * m;
            mu[tid] = m; rsd[tid] = 1.0f / sqrtf(fmaxf(var, 0.f) + EPS);
        }
        if (first) {
            first = false;
            const float* wg = wsf + (size_t)g * 128 * 128;
#pragma unroll
            for (int i = 0; i < 8; ++i) { const int e = (tid + 512 * i) * 4, p = e >> 7, q = e & 127; f32x4 v = *(const f32x4*)(wg + e);
                if ((p >> 6) < (q >> 6)) v = (f32x4){0.f, 0.f, 0.f, 0.f};
                u32x2 w; w.x = cvt_pk_bf16(v[0], v[1]); w.y = cvt_pk_bf16(v[2], v[3]); *(LAS u32x2*)(Aimg + p * APITCH + q * 2) = w; }
        }
        __syncthreads();
        {
            const int cp = tid & 31, c0 = 8 * cp; float gg[8], bb[8];
#pragma unroll
            for (int e = 0; e < 8; ++e) { gg[e] = lng[g * 256 + c0 + e]; bb[e] = lnb[g * 256 + c0 + e]; }
#pragma unroll 2
            for (int i = 0; i < 8; ++i) {
                const int q = (tid >> 5) + 16 * i;
                const u32x4 raw = *(const u32x4*)(Z + (rowb + q) * 2048 + 1024 + g * 256 + c0);
                const float m = mu[q], r = rsd[q];
                const unsigned wv[4] = {raw.x, raw.y, raw.z, raw.w};
#pragma unroll
                for (int e = 0; e < 8; ++e) {
                    const float v = __uint_as_float((e & 1) ? (wv[e >> 1] & 0xffff0000u) : (wv[e >> 1] << 16));
                    const float y = (v - m) * r * gg[e] + bb[e];
                    const unsigned pk = cvt_pk_bf16(y, y);
                    const int c = c0 + e, chunk = (q >> 3) ^ ((c >> 3) & 15) ^ (c & 7);
                    *(LAS unsigned short*)(VT + c * 256 + chunk * 16 + (q & 7) * 2) = (unsigned short)pk;
                }
            }
        }
        __syncthreads();
        f32x4 acc[2][8];
#pragma unroll
        for (int ct = 0; ct < 2; ++ct)
#pragma unroll
            for (int pt = 0; pt < 8; ++pt) acc[ct][pt] = (f32x4){0.f, 0.f, 0.f, 0.f};
        const int l16 = lane & 15, l4 = lane >> 4;
#pragma unroll
        for (int ks = 0; ks < 4; ++ks) {
            bf16x8 af[2], bfr[8];
#pragma unroll
            for (int ct = 0; ct < 2; ++ct) { const int c = wave * 32 + ct * 16 + l16, chunk = (4 * ks + l4) ^ ((c >> 3) & 15) ^ (c & 7); af[ct] = *(const LAS bf16x8*)(VT + c * 256 + chunk * 16); }
#pragma unroll
            for (int pt = 0; pt < 8; ++pt) bfr[pt] = *(const LAS bf16x8*)(Aimg + (pt * 16 + l16) * APITCH + (32 * ks + 8 * l4) * 2);
#pragma unroll
            for (int ct = 0; ct < 2; ++ct)
#pragma unroll
                for (int pt = 0; pt < 8; ++pt) acc[ct][pt] = __builtin_amdgcn_mfma_f32_16x16x32_bf16(af[ct], bfr[pt], acc[ct][pt], 0, 0, 0);
        }
        u32x4 uu[8];
#pragma unroll
        for (int i = 0; i < 8; ++i) { const int piece = tid + 512 * i; uu[i] = *(const u32x4*)(Z + (rowb + (piece >> 5)) * 2048 + g * 256 + (piece & 31) * 8); }
        __syncthreads();
        LAS unsigned char* SS = VT;
#pragma unroll
        for (int pt = 0; pt < 8; ++pt) {
            const int p = pt * 16 + l16; const float bsv = bsf[g * 128 + p];
#pragma unroll
            for (int ct = 0; ct < 2; ++ct) {
                const f32x4 s = acc[ct][pt] + bsv;
                u32x2 w; w.x = cvt_pk_bf16(s[0], s[1]); w.y = cvt_pk_bf16(s[2], s[3]);
                *(LAS u32x2*)(SS + p * 528 + (wave * 32 + ct * 16 + 4 * l4) * 2) = w;
            }
        }
        __syncthreads();
#pragma unroll
        for (int i = 0; i < 8; ++i) {
            const int piece = tid + 512 * i, p = piece >> 5, part = piece & 31;
            const u32x4 sv = *(const LAS u32x4*)(SS + p * 528 + part * 16);
            const unsigned ua[4] = {uu[i].x, uu[i].y, uu[i].z, uu[i].w}, sa[4] = {sv.x, sv.y, sv.z, sv.w}; unsigned r[4];
#pragma unroll
            for (int e = 0; e < 4; ++e) r[e] = cvt_pk_bf16(__uint_as_float(ua[e] << 16) * __uint_as_float(sa[e] << 16), __uint_as_float(ua[e] & 0xffff0000u) * __uint_as_float(sa[e] & 0xffff0000u));
            u32x4 w; w.x = r[0]; w.y = r[1]; w.z = r[2]; w.w = r[3];
            __builtin_nontemporal_store(w, (u32x4*)(T1 + (rowb + p) * D + g * 256 + part * 8));
        }
    }
}

__device__ __forceinline__ void final_norm_phase(const bf16_t* xb, float* out, const float* gain, int G) {
    int tid_ = tid_now(); asm volatile("" : "+v"(tid_));
    const int tid = tid_, lane = tid & 63, wave = tid >> 6, gw = blockIdx.x * 8 + wave, NGW = G * 8;
    f32x4 gv[4];
#pragma unroll
    for (int j = 0; j < 2; ++j) { gv[2 * j] = *(const f32x4*)(gain + 512 * j + 8 * lane); gv[2 * j + 1] = *(const f32x4*)(gain + 512 * j + 8 * lane + 4); }
    for (int r = gw; r < M; r += NGW) {
        f32x4 v[4]; float s = 0.f;
#pragma unroll
        for (int j = 0; j < 2; ++j) { const u32x4 q = *(const u32x4*)(xb + (size_t)r * D + 512 * j + 8 * lane);
            v[2 * j] = (f32x4){__uint_as_float(q.x << 16), __uint_as_float(q.x & 0xffff0000u), __uint_as_float(q.y << 16), __uint_as_float(q.y & 0xffff0000u)};
            v[2 * j + 1] = (f32x4){__uint_as_float(q.z << 16), __uint_as_float(q.z & 0xffff0000u), __uint_as_float(q.w << 16), __uint_as_float(q.w & 0xffff0000u)}; }
#pragma unroll
        for (int j = 0; j < 4; ++j) s += (v[j][0] * v[j][0] + v[j][1] * v[j][1]) + (v[j][2] * v[j][2] + v[j][3] * v[j][3]);
        s = wave_sum(s, lane);
        const float rs = 1.0f / sqrtf(s * (1.0f / D) + EPS);
#pragma unroll
        for (int j = 0; j < 2; ++j) { *(f32x4*)(out + (size_t)r * D + 512 * j + 8 * lane) = v[2 * j] * rs * gv[2 * j]; *(f32x4*)(out + (size_t)r * D + 512 * j + 8 * lane + 4) = v[2 * j + 1] * rs * gv[2 * j + 1]; }
    }
}

#define XB_TMO      128
#define XB_XCNT(j)  (256  + 64 * (j))
#define XB_XSUB(j)  (1280 + 64 * (j))
#define XB_XGEN(j)  (2304 + 64 * (j))
#define XB_TOP      3328
#define XB_TOPGEN   3392
#define XCD_BAR_WORDS 3456
#define XB_SPIN_CAP (1u << 20)
__device__ __forceinline__ unsigned xb_ld(unsigned* p)              { return __hip_atomic_load(p, __ATOMIC_RELAXED, __HIP_MEMORY_SCOPE_AGENT); }
__device__ __forceinline__ unsigned xb_add(unsigned* p, unsigned v) { return __hip_atomic_fetch_add(p, v, __ATOMIC_RELAXED, __HIP_MEMORY_SCOPE_AGENT); }
__device__ __forceinline__ unsigned xb_xcc_id() { return (unsigned)__builtin_amdgcn_s_getreg((3 << 11) | 20) & 0xFu; }
#define XB_SPIN(cond, bar) do { unsigned _sp = 0; while (cond) { __builtin_amdgcn_s_sleep(1); \
    if ((++_sp & 255u) == 0u) { if (xb_ld(&(bar)[XB_TMO])) break; if (_sp > XB_SPIN_CAP) { atomicAdd(&(bar)[XB_TMO], 1u); break; } } } } while (0)
struct XcdBarrier { unsigned* bar; unsigned x; volatile LAS unsigned* st; };
__device__ __forceinline__ XcdBarrier xcd_barrier_post(unsigned* bar, volatile LAS unsigned* st) {
    XcdBarrier b; b.bar = bar; b.x = xb_xcc_id(); b.st = st;
    if (tid_now() == 0) (void)xb_add(&bar[XB_XCNT(b.x)], 1u);
    return b;
}
__device__ __forceinline__ void xcd_barrier_complete(unsigned* bar, unsigned x, unsigned& nloc, unsigned& nx) {
    const unsigned G = gridDim.x * gridDim.y * gridDim.z;
    unsigned sum, cnt, mine, sp = 0u;
    for (;;) {
        sum = 0u; cnt = 0u; mine = 0u;
#pragma unroll
        for (unsigned j = 0; j < 16; ++j) { const unsigned c = xb_ld(&bar[XB_XCNT(j)]); sum += c; cnt += (c > 0u) ? 1u : 0u; mine = (j == x) ? c : mine; }
        if (sum == G) break;
        __builtin_amdgcn_s_sleep(1);
        if ((++sp & 255u) == 0u) { if (xb_ld(&bar[XB_TMO])) break; if (sp > XB_SPIN_CAP) { atomicAdd(&bar[XB_TMO], 1u); break; } }
    }
    nloc = mine > 0u ? mine : 1u; nx = cnt > 0u ? cnt : 1u;
}
__device__ __forceinline__ void xcd_barrier(const XcdBarrier& b) {
    asm volatile("s_waitcnt vmcnt(0)" ::: "memory");
    __syncthreads();
    if (tid_now() == 0) {
        unsigned* bar = b.bar;
        __builtin_amdgcn_s_waitcnt(0);
        unsigned nloc = b.st[0], nx = b.st[1];
        if (nloc == 0u) { xcd_barrier_complete(bar, b.x, nloc, nx); b.st[0] = nloc; b.st[1] = nx; }
        const unsigned old = xb_add(&bar[XB_XSUB(b.x)], 1u);
        const unsigned gen = old / nloc;
        if (old + 1u == (gen + 1u) * nloc) {
            __builtin_amdgcn_fence(__ATOMIC_RELEASE, "agent");
            asm volatile("s_waitcnt vmcnt(0)" ::: "memory");
            const unsigned og = xb_add(&bar[XB_TOP], 1u);
            const unsigned tg = og / nx;
            if (og + 1u == (tg + 1u) * nx) xb_add(&bar[XB_TOPGEN], 1u);
            else XB_SPIN(xb_ld(&bar[XB_TOPGEN]) == tg, bar);
            __builtin_amdgcn_fence(__ATOMIC_ACQUIRE, "agent");
            xb_add(&bar[XB_XGEN(b.x)], 1u);
            asm volatile("s_waitcnt vmcnt(0)" ::: "memory");
        } else {
            XB_SPIN(xb_ld(&bar[XB_XGEN(b.x)]) == gen, bar);
            __builtin_amdgcn_fence(__ATOMIC_ACQUIRE, "agent");
            asm volatile("s_waitcnt vmcnt(0)" ::: "memory");
        }
    }
    __syncthreads();
}

constexpr int NPHASES = 35;
__host__ __device__ inline bool phase_empty(int ph) { if (ph < 2 || ph >= 34) return false; const int L = (ph - 2) >> 3, k = (ph - 2) & 7; return (k == 2 && (L & 1) == 0) || k == 4; }

__global__ void __launch_bounds__(512, 2) fwd_megakernel(Params P) {
    extern __shared__ __attribute__((aligned(16))) unsigned char lds_raw[];
    LAS unsigned char* lds = (LAS unsigned char*)lds_raw;
    cg::grid_group grid = cg::this_grid();
    const int G = gridDim.x;
    typedef const Params __attribute__((address_space(4))) CParams;
    volatile LAS unsigned* MISC = (volatile LAS unsigned*)(lds + 131072 + 320);
    { const int t0 = threadIdx.x;
      if ((t0 & 63) == 0) ((volatile LAS int*)(lds + WIDTAB_OFF))[(unsigned)__builtin_amdgcn_s_getreg((5 << 11) | 4) & 63u] = t0 >> 6;
      if (t0 < 32) MISC[t0] = 0u; }
    __syncthreads();
    const int ph_lo = P.ph_lo, ph_hi = P.ph_hi;
    XcdBarrier bar; bar.bar = (unsigned*)(P.ws + WS_CTL); bar.x = 0; bar.st = MISC + 8;
    if (ph_hi - ph_lo > 1) bar = xcd_barrier_post((unsigned*)(P.ws + WS_CTL), MISC + 8);

    for (int ph = ph_lo; ph < ph_hi; ++ph) {
        const CParams* KP = (const CParams*)__builtin_amdgcn_kernarg_segment_ptr(); asm volatile("" : "+s"(KP));
        unsigned char* ws = KP->ws;
        bf16_t* T1 = (bf16_t*)(ws + WS_T1); bf16_t* ZB = (bf16_t*)(ws + WS_Z); bf16_t* HB = (bf16_t*)(ws + WS_H);
        bf16_t* XB = (bf16_t*)(ws + WS_XB); bf16_t* KVALL = (bf16_t*)(ws + WS_KVALL); bf16_t* MEMB = (bf16_t*)(ws + WS_MEMB); bf16_t* MQ = (bf16_t*)(ws + WS_MQ); bf16_t* VWO = (bf16_t*)(ws + WS_VWO);
        float* SSQ[2] = {(float*)(ws + WS_SSQ0), (float*)(ws + WS_SSQ1)};
        float* VSTAT = (float*)(ws + WS_VSTAT); float* RSTDMEM = (float*)(ws + WS_RSTDMEM);
        if (phase_empty(ph)) continue;
        if (ph == 0) {
            { Params Pl; for (int i = 0; i < 20; ++i) Pl.in[i] = KP->in[i]; Pl.out = KP->out; Pl.ws = ws; Pl.ph_lo = 0; Pl.ph_hi = 0; prologue_phase(Pl, lds, G); }
        } else if (ph == 1) {
            pg8::StaticOrder S; S.init(MR, 8192, G, (int)blockIdx.x);
            pg8::Gemm g{MEMB, (const bf16_t*)(ws + WS_WK), MR, 8192, D, D, D}; pg8::EpiAct<4> E{KVALL, 8192, nullptr, 1.f, RSTDMEM, nullptr}; pg8::gemm_phase<0>(lds, g, S, E);
        } else if (ph == 34) {
            final_norm_phase(XB, KP->out, KP->in[I_G_FINAL], G);
        } else {
            const int L = (ph - 2) >> 3, k = (ph - 2) & 7, j = L >> 1; const bool odd = (L & 1) != 0;
            if (k == 0) {
                const float* ssq_r = SSQ[(3 * L) & 1];
                if (!odd) { if (L == 0) pool_a_phase<true>(lds, KP->in[I_X], ssq_r, T1, G); else pool_a_phase<false>(lds, XB, ssq_r, T1, G); }
                else { pg8::Gemm g{XB, (const bf16_t*)(ws + WS_WIN) + (size_t)j * D * 2 * D, M, 2 * D, D, D, D}; pg8::StaticOrder S; S.init(M, 2 * D, G, (int)blockIdx.x);
                    pg8::EpiAct<2> E{ZB, 2 * D, ssq_r, 1.f, nullptr, VSTAT}; pg8::gemm_phase<0>(lds, g, S, E); }
                __syncthreads();
                { pg8::Gemm g{KVALL + L * 1024, (const bf16_t*)(ws + WS_WQ) + (size_t)L * D * D, 4 * MR, D, 256, 8192, D}; pg8::StaticOrder S; S.init(4 * MR, D, G, (int)blockIdx.x);
                  pg8::EpiAct<5> E{MQ, D, nullptr, QSCALE, nullptr, nullptr}; pg8::gemm_phase<3>(lds, g, S, E); }
                { pg8::Gemm g{(const bf16_t*)(ws + WS_WO) + (size_t)L * D * D, KVALL + 4096 + L * 1024, D, 4 * MR, 256, D, 8192}; pg8::StaticOrder S; S.init(D, 4 * MR, G, (int)blockIdx.x);
                  pg8::EpiAct<6> E{VWO, D, nullptr, 1.f, nullptr, nullptr}; pg8::gemm_phase<4>(lds, g, S, E); }
            } else if (k == 1 && odd) {
                sgu_spatial_phase(lds, ZB, VSTAT, KP->in[I_SGU_WS] + (size_t)j * 4 * 128 * 128, KP->in[I_SGU_BS] + j * 512, KP->in[I_SGU_LNG] + j * D, KP->in[I_SGU_LNB] + j * D, T1, G);
            } else if (k == 3) {
                pg8::Gemm g{XB, MQ, M, D, D, D, D}; pg8::StaticOrder S; S.init(M, D, G, (int)blockIdx.x);
                pg8::EpiSoftmax E{T1, SSQ[(3 * L + 1) & 1], (LAS float*)(lds + 131072 + 1024)}; pg8::gemm_phase<2>(lds, g, S, E);
            } else if (k == 6) {
                pg8::Gemm g{XB, (const bf16_t*)(ws + WS_W1) + (size_t)L * D * FF, M, FF, D, D, D}; pg8::StaticOrder S; S.init(M, FF, G, (int)blockIdx.x);
                pg8::EpiAct<1> E{HB, FF, SSQ[(3 * L + 2) & 1], 1.f, nullptr, nullptr}; pg8::gemm_phase<0>(lds, g, S, E);
            } else {
                pg8::StaticOrder S; S.init(M, D, G, (int)blockIdx.x);
                if (k == 1) {
                    pg8::Gemm g{T1, (const bf16_t*)(ws + WS_PW) + (size_t)j * 4 * 256 * 256, M, D, 256, D, 256};
                    if (L == 0) { pg8::EpiResid<true> E{KP->in[I_X], XB, SSQ[(3 * L + 1) & 1]}; pg8::gemm_phase<1>(lds, g, S, E); }
                    else { pg8::EpiResid<false> E{nullptr, XB, SSQ[(3 * L + 1) & 1]}; pg8::gemm_phase<1>(lds, g, S, E); }
                } else if (k == 5) {
                    pg8::Gemm g{T1, VWO, M, D, D, D, D}; pg8::EpiResid<false> E{nullptr, XB, SSQ[(3 * L + 2) & 1]}; pg8::gemm_phase<2>(lds, g, S, E);
                } else {
                    pg8::Gemm g; int upd;
                    if (k == 2) { g = pg8::Gemm{T1, (const bf16_t*)(ws + WS_WOUT) + (size_t)j * D * D, M, D, D, D, D}; upd = 3 * L; }
                    else        { g = pg8::Gemm{HB, (const bf16_t*)(ws + WS_W2) + (size_t)L * D * FF, M, D, FF, 64, FF}; upd = 3 * L + 2; }
                    pg8::EpiResid<false> E{nullptr, XB, SSQ[(upd + 1) & 1]};
                    if (k == 2) pg8::gemm_phase<0>(lds, g, S, E); else pg8::gemm_phase<5>(lds, g, S, E);
                }
            }
        }
        if (ph + 1 < ph_hi) { if (ph == 0) grid.sync(); else xcd_barrier(bar); }
    }
}

extern "C" void kernel_launch(void* const* d_in, const int* in_sizes, int n_in, void* d_out, int out_size, void* d_ws, size_t ws_size, hipStream_t stream) {
    static int grid = 0;
    if (grid == 0) {
        if (n_in != 20 || in_sizes[0] != M * D || out_size != M * D || ws_size < WS_END) { fprintf(stderr, "kernel_launch: unexpected shapes (n_in %d, in0 %d, out %d, ws %zu); nothing launched\n", n_in, n_in > 0 ? in_sizes[0] : -1, out_size, ws_size); grid = -1; return; }
        int dev = 0, cus = 0, per_cu = 0;
        if (hipGetDevice(&dev) != hipSuccess || hipDeviceGetAttribute(&cus, hipDeviceAttributeMultiprocessorCount, dev) != hipSuccess) { grid = -1; return; }
        if (hipFuncSetAttribute((const void*)fwd_megakernel, hipFuncAttributeMaxDynamicSharedMemorySize, LDS_BYTES) != hipSuccess) { fprintf(stderr, "kernel_launch: hipFuncSetAttribute failed\n"); grid = -1; return; }
        if (hipOccupancyMaxActiveBlocksPerMultiprocessor(&per_cu, (const void*)fwd_megakernel, 512, LDS_BYTES) != hipSuccess || per_cu < 1) { fprintf(stderr, "kernel_launch: occupancy query gave %d\n", per_cu); per_cu = 1; }
        (void)hipGetLastError();
        grid = cus * per_cu;
        if (grid > 256) grid = 256;
        grid &= ~7;
        if (grid < 8) { grid = -1; return; }
    }
    if (grid < 0) return;
    Params p{};
    for (int i = 0; i < 20; ++i) p.in[i] = (const float*)d_in[i];
    p.out = (float*)d_out; p.ws = (unsigned char*)d_ws;
#if MK_SINGLE
    p.ph_lo = 0; p.ph_hi = NPHASES;
    if (hipMemsetAsync((char*)d_ws + WS_CTL, 0, CTL_BYTES, stream) != hipSuccess) { fprintf(stderr, "kernel_launch: memset failed\n"); return; }
    void* args[] = {&p};
    hipError_t e = hipLaunchCooperativeKernel((const void*)fwd_megakernel, dim3(grid), dim3(512), args, LDS_BYTES, stream);
    if (e != hipSuccess) fprintf(stderr, "kernel_launch: cooperative launch failed: %s (grid %d)\n", hipGetErrorString(e), grid);
#else
    for (int ph = 0; ph < NPHASES; ++ph) {
        if (phase_empty(ph)) continue;
        p.ph_lo = ph; p.ph_hi = ph + 1;
        hipLaunchKernelGGL(fwd_megakernel, dim3(grid), dim3(512), LDS_BYTES, stream, p);
    }
#endif
}
```

```cpp
#include <hip/hip_runtime.h>
#include <hip/hip_cooperative_groups.h>
#include <cstdio>
#include <cstdint>
namespace cg = cooperative_groups;

#ifndef MK_SINGLE
#define MK_SINGLE 1
#endif

#define LAS __attribute__((address_space(3)))
typedef unsigned short bf16_t;
typedef short bf16x8 __attribute__((ext_vector_type(8)));
typedef float f32x4 __attribute__((ext_vector_type(4)));
typedef float f32x2 __attribute__((ext_vector_type(2)));
typedef float f32x16 __attribute__((ext_vector_type(16)));
typedef unsigned u32x4 __attribute__((ext_vector_type(4)));
typedef unsigned u32x2 __attribute__((ext_vector_type(2)));

constexpr int D = 1024, BATCH = 16, SEQ = 4096, DEPTH = 4, FF = 4096, NMEM = 256;
constexpr int M = BATCH * SEQ;
constexpr int MR = BATCH * NMEM;
constexpr float EPS = 1e-6f;
constexpr float QSCALE = 0.0625f * 1.4426950408889634f;

constexpr size_t MiB = 1u << 20;
constexpr size_t WS_H = 0, WS_T1 = 0, WS_O = 128 * MiB, WS_Z = 256 * MiB;
constexpr size_t WS_XB = 512 * MiB;
constexpr size_t WS_KVALL = 640 * MiB, WS_MEMB = 704 * MiB;
constexpr size_t WS_SSQ0 = 712 * MiB, WS_SSQ1 = 716 * MiB, WS_VSTAT = 720 * MiB, WS_RSTDMEM = 728 * MiB;
constexpr size_t WS_CTL = 730 * MiB, CTL_BYTES = 16384;
constexpr size_t WS_WQ = 736 * MiB, WS_WO = 744 * MiB, WS_W1 = 752 * MiB, WS_W2 = 784 * MiB, WS_WK = 816 * MiB, WS_WV = 824 * MiB;
constexpr size_t WS_WIN = 832 * MiB, WS_WOUT = 840 * MiB, WS_PW = 844 * MiB;
constexpr size_t WS_MQ = 848 * MiB, WS_VWO = 880 * MiB, WS_END = 912 * MiB;

constexpr int LDS_BYTES = 147456;

struct Params {
    const float* in[20];
    float* out;
    unsigned char* ws;
    int ph_lo, ph_hi;
};

extern __shared__ __attribute__((aligned(16))) unsigned char g_lds[];
constexpr int WIDTAB_OFF = 131072 + 512;
__device__ __forceinline__ int tid_now() {
    unsigned m = ~0u; asm volatile("" : "+s"(m));
    const int lane = (int)__builtin_amdgcn_mbcnt_hi(m, __builtin_amdgcn_mbcnt_lo(m, 0u));
    const unsigned hw = (unsigned)__builtin_amdgcn_s_getreg((5 << 11) | 4) & 63u;
    const int wid = __builtin_amdgcn_readfirstlane(((volatile LAS int*)((LAS unsigned char*)g_lds + WIDTAB_OFF))[hw]);
    return wid * 64 + lane;
}
__device__ __forceinline__ unsigned cvt_pk_bf16(float lo, float hi) { unsigned r; asm volatile("v_cvt_pk_bf16_f32 %0, %1, %2" : "=v"(r) : "v"(lo), "v"(hi)); return r; }
__device__ __forceinline__ float sx(float v, int o, int lane) { return __builtin_bit_cast(float, __builtin_amdgcn_ds_bpermute((lane ^ o) << 2, __builtin_bit_cast(int, v))); }
__device__ __forceinline__ float wave_sum(float v, int lane) {
#pragma unroll
    for (int o = 1; o < 64; o <<= 1) v += sx(v, o, lane);
    return v;
}
__device__ __forceinline__ float gelu_tanh(float x) {
    const float y = 0.7978845608028654f * (x + 0.044715f * x * x * x);
    const float e = __builtin_amdgcn_exp2f(-2.0f * 1.4426950408889634f * y);
    return x * __builtin_amdgcn_rcpf(1.0f + e);
}

namespace pg8 {
constexpr int BM = 256, BK = 64, HALF = 128, HTB = HALF * BK * 2, STAGE_BYTES = 8 * HTB, NXCD = 8, WGM = 8;
__host__ __device__ __forceinline__ int lds_byte(int r, int c) { const int st = (r >> 4) * 2 + (c >> 5), rr = r & 15, cc = c & 31, ob = rr * 64 + cc * 2; return st * 1024 + (ob ^ (((ob >> 9) & 1) << 5)); }
__host__ __device__ __forceinline__ void stage_rc(int b, int& R, int& C) { const int st = b / 1024, sb = b % 1024, swz = sb ^ (((sb >> 9) & 1) << 5); R = (st >> 1) * 16 + swz / 64; C = (st & 1) * 32 + (swz % 64) / 2; }
__host__ __device__ __forceinline__ int perm32(int rho) { const int n = rho >> 4, i = rho & 15; return 8 * (i >> 2) + 4 * n + (i & 3); }

struct Unit { int pm, pn; };
struct Gemm { const bf16_t* A; const bf16_t* Bt; int M, N, K, lda, ldb; };
template <int KIND> __device__ __forceinline__ const char* unitA(const Gemm& g, int pm, int pn, size_t tstepA) {
    size_t off = (size_t)((KIND == 3) ? (pm & 15) : pm) * tstepA;
    if (KIND == 1) off += (size_t)pn * 512; if (KIND == 3) off += (size_t)(pm >> 4) * 512; if (KIND == 4) off += (size_t)(pn >> 4) * 512;
    return (const char*)g.A + off;
}
template <int KIND> __device__ __forceinline__ const char* unitB(const Gemm& g, int pm, int pn, size_t tstepB) {
    size_t off = (size_t)((KIND == 4) ? (pn & 15) : pn) * tstepB;
    if (KIND == 2) off += (size_t)(pm >> 4) * 2097152; if (KIND == 3) off += (size_t)(pm >> 4) * 512; if (KIND == 4) off += (size_t)(pn >> 4) * 512;
    return (const char*)g.Bt + off;
}

struct StaticOrder {
    int nM, nN, nwg, G, c;
    __device__ void init(int M_, int N_, int G_, int c_) { nM = M_ / BM; nN = N_ / BM; nwg = nM * nN; G = G_; c = c_; }
    __device__ bool next(int i, Unit& u) const {
        const long L = (long)i * G + c; if (L >= nwg) return false;
        int wgid = (int)L; { const int q = nwg / NXCD, r = nwg % NXCD, xcd = wgid % NXCD, off = wgid / NXCD; wgid = (xcd < r ? xcd * (q + 1) : r * (q + 1) + (xcd - r) * q) + off; }
        const int nig = WGM * nN, gid = wgid / nig, fm = gid * WGM, gsz = (nM - fm) < WGM ? (nM - fm) : WGM;
        u.pm = fm + ((wgid % nig) % gsz); u.pn = (wgid % nig) / gsz; return true;
    }
};

__device__ __forceinline__ float rstd_from_slots(const float* ssq, int row, int fq, int lane) {
    const f32x4 v = *(const f32x4*)(ssq + (size_t)row * 16 + fq * 4);
    float s = (v[0] + v[1]) + (v[2] + v[3]);
    s += sx(s, 16, lane); s += sx(s, 32, lane);
    return __builtin_amdgcn_rsqf(s * (1.0f / 1024.0f) + EPS);
}

template <int MODE> struct EpiAct {
    bf16_t* O; int ldc; const float* ssq; float scale; const float* rvec; float* vstat;
    __device__ __forceinline__ void operator()(const f32x4 (&acc)[2][2][4][2], const Unit& u, int, int, int, int) const {
        int t_ = tid_now(); asm volatile("" : "+v"(t_));
        const int wid_ = __builtin_amdgcn_readfirstlane(t_ >> 6), wr = wid_ >> 2, wc = wid_ & 3, fr = t_ & 15, fq = (t_ & 63) >> 4;
        const int row0 = u.pm * BM + wr * 64 + fr, col0 = u.pn * BM + wc * 32 + 8 * fq;
        f32x4 cs[2][2];
        if (MODE == 3) {
#pragma unroll
            for (int bj = 0; bj < 2; ++bj) { cs[bj][0] = *(const f32x4*)(rvec + col0 + bj * HALF); cs[bj][1] = *(const f32x4*)(rvec + col0 + bj * HALF + 4); }
        }
#pragma unroll
        for (int ai = 0; ai < 2; ++ai)
#pragma unroll
            for (int m = 0; m < 4; ++m) {
                const int row = row0 + ai * HALF + m * 16;
                float rs = 1.f;
                if (MODE == 0 || MODE == 1 || MODE == 2) rs = rstd_from_slots(ssq, row, fq, fq * 16 + fr);
                if (MODE == 0) rs *= scale;
                if (MODE == 4) rs = rvec[row];
                bf16_t* rowp = O + (size_t)row * ldc + col0;
                if (MODE == 5) { const int rl = row - u.pm * BM; rowp = O + ((size_t)(u.pm & 15) << 20) + (size_t)((u.pm >> 4) * 256 + rl) * 1024 + col0; rs = scale; }
                if (MODE == 6) { rowp = O + ((size_t)(u.pn & 15) << 20) + (size_t)row * 1024 + (u.pn >> 4) * 256 + (col0 - u.pn * BM); }
                float s1 = 0.f, s2 = 0.f;
#pragma unroll
                for (int bj = 0; bj < 2; ++bj) {
                    f32x4 v0 = acc[ai][bj][m][0] * rs, v1 = acc[ai][bj][m][1] * rs;
                    if (MODE == 3) { v0 = acc[ai][bj][m][0] * cs[bj][0]; v1 = acc[ai][bj][m][1] * cs[bj][1]; }
                    if (MODE == 1) {
#pragma unroll
                        for (int j = 0; j < 4; ++j) { const float a = v0[j] > 0.f ? v0[j] : 0.f, b = v1[j] > 0.f ? v1[j] : 0.f; v0[j] = a * a; v1[j] = b * b; }
                    }
                    if (MODE == 2) {
#pragma unroll
                        for (int j = 0; j < 4; ++j) { v0[j] = gelu_tanh(v0[j]); v1[j] = gelu_tanh(v1[j]); }
#pragma unroll
                        for (int j = 0; j < 4; ++j) { s1 += v0[j] + v1[j]; s2 += v0[j] * v0[j] + v1[j] * v1[j]; }
                    }
                    u32x4 w; w.x = cvt_pk_bf16(v0[0], v0[1]); w.y = cvt_pk_bf16(v0[2], v0[3]); w.z = cvt_pk_bf16(v1[0], v1[1]); w.w = cvt_pk_bf16(v1[2], v1[3]);
                    bf16_t* sp = rowp + bj * HALF;
                    if (MODE == 1) { const int col = col0 + bj * HALF; sp = O + (((size_t)(u.pm * (ldc >> 6) + (col >> 6)) * BM + (row - u.pm * BM)) << 6) + (col & 63); }
                    __builtin_nontemporal_store(w, (u32x4*)sp);
                }
                if (MODE == 2) {
                    { const int ln = fq * 16 + fr; s1 += sx(s1, 16, ln); s1 += sx(s1, 32, ln); s2 += sx(s2, 16, ln); s2 += sx(s2, 32, ln); }
                    if (u.pn >= 4 && fq == 0) { vstat[(size_t)row * 32 + (u.pn - 4) * 4 + wc] = s1; vstat[(size_t)row * 32 + 16 + (u.pn - 4) * 4 + wc] = s2; }
                }
            }
    }
};
struct EpiSoftmax {
    bf16_t* O; const float* ssq; LAS float* red;
    __device__ __forceinline__ void operator()(f32x4 (&acc)[2][2][4][2], const Unit& u, int, int, int, int) const {
        int t_ = tid_now(); asm volatile("" : "+v"(t_));
        const int wid_ = __builtin_amdgcn_readfirstlane(t_ >> 6), wr = wid_ >> 2, wc = wid_ & 3, fr = t_ & 15, fq = (t_ & 63) >> 4;
        const int row0 = u.pm * BM + wr * 64 + fr, col0 = u.pn * BM + wc * 32 + 8 * fq, lane = fq * 16 + fr;
#pragma unroll
        for (int ai = 0; ai < 2; ++ai)
#pragma unroll
            for (int m = 0; m < 4; ++m) {
                const int rl = ai * HALF + wr * 64 + m * 16 + fr;
                const float rs = rstd_from_slots(ssq, u.pm * BM + rl, fq, lane);
                float mx = -3.0e38f;
#pragma unroll
                for (int bj = 0; bj < 2; ++bj)
#pragma unroll
                    for (int n = 0; n < 2; ++n) { acc[ai][bj][m][n] = acc[ai][bj][m][n] * rs;
#pragma unroll
                        for (int j = 0; j < 4; ++j) mx = fmaxf(mx, acc[ai][bj][m][n][j]); }
                mx = fmaxf(mx, sx(mx, 16, lane)); mx = fmaxf(mx, sx(mx, 32, lane));
                if (fq == 0) red[rl * 4 + wc] = mx;
            }
        asm volatile("s_waitcnt lgkmcnt(0)" ::: "memory"); __builtin_amdgcn_s_barrier(); asm volatile("" ::: "memory");
#pragma unroll
        for (int ai = 0; ai < 2; ++ai)
#pragma unroll
            for (int m = 0; m < 4; ++m) {
                const int rl = ai * HALF + wr * 64 + m * 16 + fr;
                const f32x4 r4 = *(const LAS f32x4*)(red + rl * 4);
                const float mx = fmaxf(fmaxf(r4[0], r4[1]), fmaxf(r4[2], r4[3]));
                float sm = 0.f;
#pragma unroll
                for (int bj = 0; bj < 2; ++bj)
#pragma unroll
                    for (int n = 0; n < 2; ++n)
#pragma unroll
                        for (int j = 0; j < 4; ++j) { const float e = __builtin_amdgcn_exp2f(acc[ai][bj][m][n][j] - mx); acc[ai][bj][m][n][j] = e; sm += e; }
                sm += sx(sm, 16, lane); sm += sx(sm, 32, lane);
                if (fq == 0) red[1024 + rl * 4 + wc] = sm;
            }
        asm volatile("s_waitcnt lgkmcnt(0)" ::: "memory"); __builtin_amdgcn_s_barrier(); asm volatile("" ::: "memory");
#pragma unroll
        for (int ai = 0; ai < 2; ++ai)
#pragma unroll
            for (int m = 0; m < 4; ++m) {
                const int rl = ai * HALF + wr * 64 + m * 16 + fr;
                const f32x4 r4 = *(const LAS f32x4*)(red + 1024 + rl * 4);
                const float inv = 1.0f / ((r4[0] + r4[1]) + (r4[2] + r4[3]));
                bf16_t* rowp = O + (size_t)(row0 + ai * HALF + m * 16) * D + col0;
#pragma unroll
                for (int bj = 0; bj < 2; ++bj) {
                    const f32x4 v0 = acc[ai][bj][m][0] * inv, v1 = acc[ai][bj][m][1] * inv;
                    u32x4 w; w.x = cvt_pk_bf16(v0[0], v0[1]); w.y = cvt_pk_bf16(v0[2], v0[3]); w.z = cvt_pk_bf16(v1[0], v1[1]); w.w = cvt_pk_bf16(v1[2], v1[3]);
                    __builtin_nontemporal_store(w, (u32x4*)(rowp + bj * HALF));
                }
            }
    }
};
template <bool F32IN> struct EpiResid {
    const float* xin; bf16_t* xb; float* ssq;
    __device__ __forceinline__ void operator()(const f32x4 (&acc)[2][2][4][2], const Unit& u, int, int, int, int) const {
        int t_ = tid_now(); asm volatile("" : "+v"(t_));
        const int wid_ = __builtin_amdgcn_readfirstlane(t_ >> 6), wr = wid_ >> 2, wc = wid_ & 3, fr = t_ & 15, fq = (t_ & 63) >> 4;
        const int row0 = u.pm * BM + wr * 64 + fr, col0 = u.pn * BM + wc * 32 + 8 * fq;
#pragma unroll
        for (int ai = 0; ai < 2; ++ai)
#pragma unroll
            for (int m = 0; m < 4; ++m) {
                const int row = row0 + ai * HALF + m * 16; const size_t off = (size_t)row * D + col0;
                float ss = 0.f;
#pragma unroll
                for (int bj = 0; bj < 2; ++bj) {
                    f32x4 a0, a1;
                    if (F32IN) { a0 = *(const f32x4*)(xin + off + bj * HALF); a1 = *(const f32x4*)(xin + off + bj * HALF + 4); }
                    else { const u32x4 r = *(const u32x4*)(xb + off + bj * HALF);
                        a0 = (f32x4){__uint_as_float(r.x << 16), __uint_as_float(r.x & 0xffff0000u), __uint_as_float(r.y << 16), __uint_as_float(r.y & 0xffff0000u)};
                        a1 = (f32x4){__uint_as_float(r.z << 16), __uint_as_float(r.z & 0xffff0000u), __uint_as_float(r.w << 16), __uint_as_float(r.w & 0xffff0000u)}; }
                    const f32x4 v0 = a0 + acc[ai][bj][m][0], v1 = a1 + acc[ai][bj][m][1];
                    u32x4 w; w.x = cvt_pk_bf16(v0[0], v0[1]); w.y = cvt_pk_bf16(v0[2], v0[3]); w.z = cvt_pk_bf16(v1[0], v1[1]); w.w = cvt_pk_bf16(v1[2], v1[3]);
                    __builtin_nontemporal_store(w, (u32x4*)(xb + off + bj * HALF));
                    const unsigned ww[4] = {w.x, w.y, w.z, w.w};
#pragma unroll
                    for (int j = 0; j < 4; ++j) { const float lo = __uint_as_float(ww[j] << 16), hi = __uint_as_float(ww[j] & 0xffff0000u); ss += lo * lo + hi * hi; }
                }
                { const int ln = fq * 16 + fr; ss += sx(ss, 16, ln); ss += sx(ss, 32, ln); }
                if (fq == 0) ssq[(size_t)row * 16 + u.pn * 4 + wc] = ss;
                asm volatile("" ::: "memory");
            }
    }
};

template <int KIND, class Epi>
__device__ __forceinline__ void gemm_phase(LAS unsigned char* lds, const Gemm g, const StaticOrder& S, const Epi& E) {
    int tid_ = tid_now(); asm volatile("" : "+v"(tid_));
    const int tid = tid_, wid = __builtin_amdgcn_readfirstlane(tid >> 6), lane = tid & 63, wr = wid >> 2, wc = wid & 3, fr = lane & 15, fq = lane >> 4;
    const int nt = g.K / BK;
    unsigned voffA[2], voffB[2];
#pragma unroll
    for (int i = 0; i < 2; ++i) { int R, C; stage_rc(tid * 16 + i * 8192, R, C); const int Rb = (R & ~31) + perm32(R & 31);
        voffA[i] = (unsigned)(R * g.lda + C) * 2u; voffB[i] = (unsigned)(Rb * g.ldb + C) * 2u; }
    const size_t kstep = (size_t)(BK * 2), kstepA = (KIND == 5) ? (size_t)(BM * BK * 2) : kstep;
    const size_t hstepA = (size_t)HALF * g.lda * 2, hstepB = (size_t)HALF * g.ldb * 2;
    const size_t tstepA = (KIND == 5) ? (size_t)g.K * BM * 2 : 2 * hstepA, tstepB = 2 * hstepB;
    const unsigned ldsw = (unsigned)wid * 1024u;
    const int aoff = lds_byte(wr * 64 + fr, fq * 8), boff = lds_byte(wc * 32 + fr, fq * 8);
#define PG8_SA(b, h) (((b) * 2 + (h)) * HTB)
#define PG8_SB(b, h) ((4 + (b) * 2 + (h)) * HTB)
#define PG8_STAGE(bufoff, gbase, voff) do { _Pragma("unroll") for (int _i = 0; _i < 2; ++_i) \
        __builtin_amdgcn_global_load_lds((const unsigned*)((const char*)(gbase) + (voff)[_i]), (LAS unsigned*)(lds + (bufoff) + ldsw + _i * 8192), 16, 0, 0); } while (0)
#define PG8_LDA(dst, b, h) do { _Pragma("unroll") for (int m = 0; m < 4; ++m) _Pragma("unroll") for (int k = 0; k < 2; ++k) dst[m][k] = *(const LAS bf16x8*)(lds + PG8_SA(b, h) + aoff + m * 2048 + k * 1024); } while (0)
#define PG8_LDB(dst, b, h) do { _Pragma("unroll") for (int n = 0; n < 2; ++n) _Pragma("unroll") for (int k = 0; k < 2; ++k) dst[n][k] = *(const LAS bf16x8*)(lds + PG8_SB(b, h) + boff + n * 2048 + k * 1024); } while (0)
#define PG8_MMA(ai, bj, At, Bt) do { __builtin_amdgcn_s_setprio(1); _Pragma("unroll") for (int m = 0; m < 4; ++m) _Pragma("unroll") for (int n = 0; n < 2; ++n) _Pragma("unroll") for (int k = 0; k < 2; ++k) \
        acc[ai][bj][m][n] = __builtin_amdgcn_mfma_f32_16x16x32_bf16(Bt[n][k], At[m][k], acc[ai][bj][m][n], 0, 0, 0); __builtin_amdgcn_s_setprio(0); } while (0)
#define PG8_WAIT_V(n) asm volatile("s_waitcnt vmcnt(" #n ")" ::: "memory")
#define PG8_WAIT_L(n) asm volatile("s_waitcnt lgkmcnt(" #n ")" ::: "memory")
#define PG8_BAR __builtin_amdgcn_s_barrier()
#define PG8_SCHED __builtin_amdgcn_sched_barrier(0)
    Unit cur, nxt; int ui = 0;
    if (!S.next(0, cur)) return;
    f32x4 acc[2][2][4][2];
#pragma unroll
    for (int a = 0; a < 2; ++a)
#pragma unroll
        for (int b = 0; b < 2; ++b)
#pragma unroll
            for (int m = 0; m < 4; ++m)
#pragma unroll
                for (int n = 0; n < 2; ++n) acc[a][b][m][n] = (f32x4){0.f, 0.f, 0.f, 0.f};
    bf16x8 At[4][2], B0[2][2], B1[2][2];
    const char* cA = unitA<KIND>(g, cur.pm, cur.pn, tstepA); const char* cB = unitB<KIND>(g, cur.pm, cur.pn, tstepB);
    PG8_STAGE(PG8_SB(0, 0), cB, voffB); PG8_STAGE(PG8_SB(0, 1), cB + hstepB, voffB); PG8_STAGE(PG8_SA(0, 0), cA, voffA); PG8_STAGE(PG8_SA(0, 1), cA + hstepA, voffA);
    if (wr == 1) PG8_BAR;
    PG8_WAIT_V(2); PG8_BAR;
    PG8_STAGE(PG8_SB(1, 0), cB + kstep, voffB); PG8_STAGE(PG8_SA(1, 0), cA + kstepA, voffA); PG8_STAGE(PG8_SB(1, 1), cB + hstepB + kstep, voffB);
    PG8_WAIT_V(6); PG8_BAR;
    for (;;) {
        const bool has_next = S.next(ui + 1, nxt);
        const char* nA = has_next ? unitA<KIND>(g, nxt.pm, nxt.pn, tstepA) : cA; const char* nB = has_next ? unitB<KIND>(g, nxt.pm, nxt.pn, tstepB) : cB;
        for (int t = 0; t < nt; t += 2) {
            const bool last = (t == nt - 2);
            const char* a1 = cA + (size_t)(t + 1) * kstepA;
            const char* a2 = last ? nA : cA + (size_t)(t + 2) * kstepA; const char* b2 = last ? nB : cB + (size_t)(t + 2) * kstep;
            const char* a3 = a2 + kstepA; const char* b3 = b2 + kstep;
            PG8_LDB(B0, 0, 0); PG8_LDB(B1, 0, 1); PG8_SCHED; PG8_LDA(At, 0, 0); PG8_STAGE(PG8_SA(1, 1), a1 + hstepA, voffA);
            PG8_WAIT_V(8); PG8_WAIT_L(0); PG8_BAR; PG8_MMA(0, 0, At, B0); PG8_MMA(0, 1, At, B1); PG8_BAR; PG8_SCHED;
            PG8_LDA(At, 0, 1); PG8_STAGE(PG8_SB(0, 0), b2, voffB); PG8_STAGE(PG8_SB(0, 1), b2 + hstepB, voffB); PG8_STAGE(PG8_SA(0, 0), a2, voffA);
            PG8_WAIT_V(8); PG8_WAIT_L(0); PG8_BAR; PG8_MMA(1, 0, At, B0); PG8_MMA(1, 1, At, B1); PG8_BAR; PG8_SCHED;
            PG8_LDB(B0, 1, 0); PG8_LDB(B1, 1, 1); PG8_SCHED; PG8_LDA(At, 1, 0); PG8_STAGE(PG8_SA(0, 1), a2 + hstepA, voffA);
            PG8_WAIT_V(8); PG8_WAIT_L(0); PG8_BAR; PG8_MMA(0, 0, At, B0); PG8_MMA(0, 1, At, B1); PG8_BAR; PG8_SCHED;
            PG8_LDA(At, 1, 1); PG8_STAGE(PG8_SB(1, 0), b3, voffB); PG8_STAGE(PG8_SB(1, 1), b3 + hstepB, voffB); PG8_STAGE(PG8_SA(1, 0), a3, voffA);
            PG8_WAIT_V(8); PG8_WAIT_L(0); PG8_BAR; PG8_MMA(1, 0, At, B0); PG8_MMA(1, 1, At, B1); PG8_BAR; PG8_SCHED;
        }
        if (wr == 0) PG8_BAR;
        E(acc, cur, wr, wc, fr, fq);
        if (!has_next) break;
#pragma unroll
        for (int a = 0; a < 2; ++a)
#pragma unroll
            for (int b = 0; b < 2; ++b)
#pragma unroll
                for (int m = 0; m < 4; ++m)
#pragma unroll
                    for (int n = 0; n < 2; ++n) acc[a][b][m][n] = (f32x4){0.f, 0.f, 0.f, 0.f};
        cur = nxt; cA = nA; cB = nB; ++ui;
        if (wr == 1) PG8_BAR;
    }
    PG8_WAIT_V(0);
    PG8_BAR;
#undef PG8_SA
#undef PG8_SB
#undef PG8_STAGE
#undef PG8_LDA
#undef PG8_LDB
#undef PG8_MMA
#undef PG8_WAIT_V
#undef PG8_WAIT_L
#undef PG8_BAR
#undef PG8_SCHED
}
}

struct MatDesc { const float* src; int ldw, K, N; bf16_t* dst; int ldt; const float* ks; const float* ns; };

__device__ __forceinline__ void transpose_item(const MatDesc& d, LAS float* scr, int item, int lane) {
    const int nblk = d.N / 32, kb = item / nblk, nb = item % nblk, k0 = 64 * kb, n0 = 32 * nb;
    const int n4 = lane & 7, rr = lane >> 3;
    f32x4 nsv = (f32x4){1.f, 1.f, 1.f, 1.f};
    if (d.ns) nsv = *(const f32x4*)(d.ns + n0 + 4 * n4);
    f32x4 v[8];
#pragma unroll
    for (int j = 0; j < 8; ++j) v[j] = *(const f32x4*)(d.src + (size_t)(k0 + rr + 8 * j) * d.ldw + n0 + 4 * n4);
#pragma unroll
    for (int j = 0; j < 8; ++j) { const int kk = rr + 8 * j; f32x4 w = v[j] * nsv; if (d.ks) w = w * d.ks[k0 + kk];
        scr[kk * 33 + 4 * n4 + 0] = w[0]; scr[kk * 33 + 4 * n4 + 1] = w[1]; scr[kk * 33 + 4 * n4 + 2] = w[2]; scr[kk * 33 + 4 * n4 + 3] = w[3]; }
    asm volatile("s_waitcnt lgkmcnt(0)" ::: "memory");
    const int c = lane & 7;
#pragma unroll
    for (int j = 0; j < 4; ++j) { const int n = (lane >> 3) + 8 * j; const LAS float* s = scr + (8 * c) * 33 + n;
        u32x4 o; o.x = cvt_pk_bf16(s[0 * 33], s[1 * 33]); o.y = cvt_pk_bf16(s[2 * 33], s[3 * 33]); o.z = cvt_pk_bf16(s[4 * 33], s[5 * 33]); o.w = cvt_pk_bf16(s[6 * 33], s[7 * 33]);
        *(u32x4*)(d.dst + (size_t)(n0 + n) * d.ldt + k0 + 8 * c) = o; }
    asm volatile("s_waitcnt lgkmcnt(0)" ::: "memory");
}

enum { I_X = 0, I_MEM, I_G_MIX, I_G_MEM, I_G_MEMKV, I_G_FFN, I_G_FINAL, I_POOL_W, I_POOL_SCALE, I_SGU_WIN, I_SGU_LNG, I_SGU_LNB, I_SGU_WS, I_SGU_BS, I_SGU_WOUT, I_WQ, I_WKV, I_WO, I_W1, I_W2 };

__device__ __forceinline__ MatDesc get_mat(const Params& P, int id) {
    MatDesc d; d.ks = nullptr; d.ns = nullptr;
    unsigned char* ws = P.ws;
    if (id < 24) {
        const int L = id / 6, t = id % 6;
        if (t == 0)      { d.src = P.in[I_WQ] + (size_t)L * D * D; d.ldw = D; d.K = D; d.N = D; d.dst = (bf16_t*)(ws + WS_WQ) + (size_t)L * D * D; d.ldt = D; d.ks = P.in[I_G_MEM] + L * D; }
        else if (t == 1) { d.src = P.in[I_WKV] + (size_t)L * D * 2 * D; d.ldw = 2 * D; d.K = D; d.N = D; d.dst = (bf16_t*)(ws + WS_WK) + (size_t)L * D * D; d.ldt = D; d.ks = P.in[I_G_MEMKV] + L * D; }
        else if (t == 2) { d.src = P.in[I_WKV] + (size_t)L * D * 2 * D + D; d.ldw = 2 * D; d.K = D; d.N = D; d.dst = (bf16_t*)(ws + WS_WV) + (size_t)L * D * D; d.ldt = D; d.ks = P.in[I_G_MEMKV] + L * D; }
        else if (t == 3) { d.src = P.in[I_WO] + (size_t)L * D * D; d.ldw = D; d.K = D; d.N = D; d.dst = (bf16_t*)(ws + WS_WO) + (size_t)L * D * D; d.ldt = D; }
        else if (t == 4) { d.src = P.in[I_W1] + (size_t)L * D * FF; d.ldw = FF; d.K = D; d.N = FF; d.dst = (bf16_t*)(ws + WS_W1) + (size_t)L * D * FF; d.ldt = D; d.ks = P.in[I_G_FFN] + L * D; }
        else             { d.src = P.in[I_W2] + (size_t)L * D * FF; d.ldw = D; d.K = FF; d.N = D; d.dst = (bf16_t*)(ws + WS_W2) + (size_t)L * D * FF; d.ldt = FF; }
    } else if (id < 28) {
        const int j = (id - 24) >> 1, t = (id - 24) & 1;
        if (t == 0) { d.src = P.in[I_SGU_WIN] + (size_t)j * D * 2 * D; d.ldw = 2 * D; d.K = D; d.N = 2 * D; d.dst = (bf16_t*)(ws + WS_WIN) + (size_t)j * D * 2 * D; d.ldt = D; d.ks = P.in[I_G_MIX] + (2 * j + 1) * D; }
        else        { d.src = P.in[I_SGU_WOUT] + (size_t)j * D * D; d.ldw = D; d.K = D; d.N = D; d.dst = (bf16_t*)(ws + WS_WOUT) + (size_t)j * D * D; d.ldt = D; }
    } else {
        const int jg = id - 28, j = jg >> 2, g = jg & 3;
        d.src = P.in[I_POOL_W] + (size_t)jg * 256 * 256; d.ldw = 256; d.K = 256; d.N = 256; d.dst = (bf16_t*)(ws + WS_PW) + (size_t)jg * 256 * 256; d.ldt = 256;
        d.ks = P.in[I_G_MIX] + (2 * j) * D + g * 256; d.ns = P.in[I_POOL_SCALE] + j * D + g * 256;
    }
    return d;
}
__device__ __forceinline__ int mat_items(int id) {
    if (id < 24) { const int t = id % 6; return (t == 0) ? 0 : ((t >= 4) ? 2048 : 512); }
    if (id < 28) return ((id - 24) & 1) ? 512 : 1024;
    return 32;
}

__device__ __forceinline__ void prologue_phase(const Params& P, LAS unsigned char* lds, int G) {
    int tid_ = tid_now(); asm volatile("" : "+v"(tid_));
    const int tid = tid_, lane = tid & 63, wave = __builtin_amdgcn_readfirstlane(tid >> 6);
    LAS float* scr = (LAS float*)(lds + wave * 16384);
    const int gw = blockIdx.x * 8 + wave, NGW = G * 8;
    constexpr int NITEMS = 4 * (3 * 512 + 2 * 2048) + 2 * (1024 + 512) + 8 * 32;
    for (int it = gw; it < NITEMS; it += NGW) {
        int r = it, id = 0;
        for (; id < 36; ++id) { const int n = mat_items(id); if (r < n) break; r -= n; }
        const MatDesc d = get_mat(P, id);
        transpose_item(d, scr, r, lane);
    }
    { const float* wq = P.in[I_WQ]; const float* gq = P.in[I_G_MEM]; bf16_t* wqb = (bf16_t*)(P.ws + WS_WQ);
      for (int r = gw; r < DEPTH * D; r += NGW) { const float gk = gq[r]; const f32x4* xr = (const f32x4*)(wq + (size_t)r * D) + lane; u32x2* o = (u32x2*)(wqb + (size_t)r * D) + lane;
#pragma unroll
        for (int j = 0; j < 4; ++j) { const f32x4 v = xr[64 * j] * gk; u32x2 w; w.x = cvt_pk_bf16(v[0], v[1]); w.y = cvt_pk_bf16(v[2], v[3]); o[64 * j] = w; } } }
    const float* mem = P.in[I_MEM]; bf16_t* memb = (bf16_t*)(P.ws + WS_MEMB); float* rstd_mem = (float*)(P.ws + WS_RSTDMEM);
    for (int r = gw; r < MR; r += NGW) {
        const f32x4* xr = (const f32x4*)(mem + (size_t)r * D) + lane; f32x4 v[4]; float s = 0.f;
#pragma unroll
        for (int j = 0; j < 4; ++j) { v[j] = xr[64 * j]; s += (v[j][0] * v[j][0] + v[j][1] * v[j][1]) + (v[j][2] * v[j][2] + v[j][3] * v[j][3]); }
        s = wave_sum(s, lane);
        if (lane == 0) rstd_mem[r] = 1.0f / sqrtf(s * (1.0f / D) + EPS);
        u32x2* o = (u32x2*)(memb + (size_t)r * D) + lane;
#pragma unroll
        for (int j = 0; j < 4; ++j) { u32x2 w; w.x = cvt_pk_bf16(v[j][0], v[j][1]); w.y = cvt_pk_bf16(v[j][2], v[j][3]); o[64 * j] = w; }
    }
    const float* x = P.in[I_X]; float* ssq0 = (float*)(P.ws + WS_SSQ0);
    for (int r = gw; r < M; r += 2 * NGW) {
        const int r1 = (r + NGW < M) ? r + NGW : r;
        f32x4 va[4], vb[4];
#pragma unroll
        for (int j = 0; j < 4; ++j) { va[j] = ((const f32x4*)(x + (size_t)r * D) + lane)[64 * j]; vb[j] = ((const f32x4*)(x + (size_t)r1 * D) + lane)[64 * j]; }
        float s = 0.f, t = 0.f;
#pragma unroll
        for (int j = 0; j < 4; ++j) { s += (va[j][0] * va[j][0] + va[j][1] * va[j][1]) + (va[j][2] * va[j][2] + va[j][3] * va[j][3]); t += (vb[j][0] * vb[j][0] + vb[j][1] * vb[j][1]) + (vb[j][2] * vb[j][2] + vb[j][3] * vb[j][3]); }
        s = wave_sum(s, lane); t = wave_sum(t, lane);
        if (lane < 16) { ssq0[(size_t)r * 16 + lane] = (lane == 0) ? s : 0.f; if (r1 != r) ssq0[(size_t)r1 * 16 + lane] = (lane == 0) ? t : 0.f; }
    }
}

template <int W>
__device__ __forceinline__ void pool_block(const f32x2 (&prev)[16], const f32x2 (&cur)[16], bool seq_start, bf16_t* outp  ) {
#pragma unroll
    for (int i = 0; i < 16; ++i) {
        f32x2 s = cur[i];
#pragma unroll
        for (int j = 1; j < W; ++j) { s += (i - j >= 0) ? cur[(i - j) & 15] : prev[(16 + i - j) & 15]; }
        float inv = 1.0f / (float)W;
        if (i < W - 1 && seq_start) inv = 1.0f / (float)(i + 1);
        const f32x2 o = s * inv - cur[i];
        *(unsigned*)(outp + (size_t)i * D) = cvt_pk_bf16(o[0], o[1]);
    }
}
template <bool F32IN> __device__ __forceinline__ f32x2 pool_ld(const void* x, size_t idx) {
    if (F32IN) return *(const f32x2*)((const float*)x + idx);
    const unsigned r = *(const unsigned*)((const bf16_t*)x + idx); return (f32x2){__uint_as_float(r << 16), __uint_as_float(r & 0xffff0000u)};
}
template <bool F32IN>
__device__ __forceinline__ void pool_a_phase(LAS unsigned char* lds, const void* x, const float* ssq, bf16_t* PA, int G) {
    LAS float* rs = (LAS float*)lds;
    int tid_ = tid_now(); asm volatile("" : "+v"(tid_));
    const int tid = tid_, ch = 2 * tid, group = __builtin_amdgcn_readfirstlane(tid >> 7);
    for (int chunk = blockIdx.x; chunk < M / 64; chunk += G) {
        const int t0 = chunk * 64; const bool sstart = (t0 & (SEQ - 1)) == 0;
        __syncthreads();
        if (tid < 80) {
            float r = 0.f;
            if (!(sstart && tid < 16)) { const f32x4* p = (const f32x4*)(ssq + (size_t)(t0 - 16 + tid) * 16); const f32x4 a = p[0], b = p[1], c = p[2], d = p[3];
                const float s = (((a[0] + a[1]) + (a[2] + a[3])) + ((b[0] + b[1]) + (b[2] + b[3]))) + (((c[0] + c[1]) + (c[2] + c[3])) + ((d[0] + d[1]) + (d[2] + d[3])));
                r = 1.0f / sqrtf(s * (1.0f / D) + EPS); }
            rs[tid] = r;
        }
        __syncthreads();
        f32x2 prev[16], cur[16];
        if (sstart) {
#pragma unroll
            for (int i = 0; i < 16; ++i) prev[i] = (f32x2){0.f, 0.f};
        } else {
#pragma unroll
            for (int i = 0; i < 16; ++i) prev[i] = pool_ld<F32IN>(x, (size_t)(t0 - 16 + i) * D + ch) * rs[i];
        }
        for (int blk = 0; blk < 4; ++blk) {
#pragma unroll
            for (int i = 0; i < 16; ++i) cur[i] = pool_ld<F32IN>(x, (size_t)(t0 + blk * 16 + i) * D + ch) * rs[16 + blk * 16 + i];
            bf16_t* outp = PA + (size_t)(t0 + blk * 16) * D + ch;
            const bool ss = sstart && blk == 0;
            if (group == 0) pool_block<2>(prev, cur, ss, outp);
            else if (group == 1) pool_block<4>(prev, cur, ss, outp);
            else if (group == 2) pool_block<8>(prev, cur, ss, outp);
            else pool_block<16>(prev, cur, ss, outp);
#pragma unroll
            for (int i = 0; i < 16; ++i) prev[i] = cur[i];
        }
    }
}

__device__ __forceinline__ void sgu_spatial_phase(LAS unsigned char* lds, const bf16_t* Z, const float* vstat, const float* wsf, const float* bsf, const float* lng, const float* lnb, bf16_t* T1, int G) {
    constexpr int APITCH = 272;
    LAS unsigned char* Aimg = lds;
    LAS unsigned char* VT = lds + 34816;
    LAS float* mu = (LAS float*)(lds + 34816 + 67584); LAS float* rsd = mu + 128;
    int tid_ = tid_now(); asm volatile("" : "+v"(tid_));
    const int tid = tid_, lane = tid & 63, wave = __builtin_amdgcn_readfirstlane(tid >> 6);
    const int g = blockIdx.x & 3;
    bool first = true;
    for (int u = blockIdx.x; u < (M / 128) * 4; u += G) {
        const int nb = u >> 2; const size_t rowb = (size_t)nb * 128;
        __syncthreads();
        if (tid < 128) {
            const f32x4* p = (const f32x4*)(vstat + (rowb + tid) * 32); float s1 = 0.f, s2 = 0.f;
#pragma unroll
            for (int i = 0; i < 4; ++i) { const f32x4 a = p[i], b = p[4 + i]; s1 += (a[0] + a[1]) + (a[2] + a[3]); s2 += (b[0] + b[1]) + (b[2] + b[3]); }
            const float m = s1 * (1.0f / D), var = s2 * (1.0f / D) - m * m;
            mu[tid] = m; rsd[tid] = 1.0f / sqrtf(fmaxf(var, 0.f) + EPS);
        }
        if (first) {
            first = false;
            const float* wg = wsf + (size_t)g * 128 * 128;
#pragma unroll
            for (int i = 0; i < 8; ++i) { const int e = (tid + 512 * i) * 4, p = e >> 7, q = e & 127; f32x4 v = *(const f32x4*)(wg + e);
                if ((p >> 6) < (q >> 6)) v = (f32x4){0.f, 0.f, 0.f, 0.f};
                u32x2 w; w.x = cvt_pk_bf16(v[0], v[1]); w.y = cvt_pk_bf16(v[2], v[3]); *(LAS u32x2*)(Aimg + p * APITCH + q * 2) = w; }
        }
        __syncthreads();
        {
            const int cp = tid & 31, c0 = 8 * cp; float gg[8], bb[8];
#pragma unroll
            for (int e = 0; e < 8; ++e) { gg[e] = lng[g * 256 + c0 + e]; bb[e] = lnb[g * 256 + c0 + e]; }
#pragma unroll 2
            for (int i = 0; i < 8; ++i) {
                const int q = (tid >> 5) + 16 * i;
                const u32x4 raw = *(const u32x4*)(Z + (rowb + q) * 2048 + 1024 + g * 256 + c0);
                const float m = mu[q], r = rsd[q];
                const unsigned wv[4] = {raw.x, raw.y, raw.z, raw.w};
#pragma unroll
                for (int e = 0; e < 8; ++e) {
                    const float v = __uint_as_float((e & 1) ? (wv[e >> 1] & 0xffff0000u) : (wv[e >> 1] << 16));
                    const float y = (v - m) * r * gg[e] + bb[e];
                    const unsigned pk = cvt_pk_bf16(y, y);
                    const int c = c0 + e, chunk = (q >> 3) ^ ((c >> 3) & 15) ^ (c & 7);
                    *(LAS unsigned short*)(VT + c * 256 + chunk * 16 + (q & 7) * 2) = (unsigned short)pk;
                }
            }
        }
        __syncthreads();
        f32x4 acc[2][8];
#pragma unroll
        for (int ct = 0; ct < 2; ++ct)
#pragma unroll
            for (int pt = 0; pt < 8; ++pt) acc[ct][pt] = (f32x4){0.f, 0.f, 0.f, 0.f};
        const int l16 = lane & 15, l4 = lane >> 4;
#pragma unroll
        for (int ks = 0; ks < 4; ++ks) {
            bf16x8 af[2], bfr[8];
#pragma unroll
            for (int ct = 0; ct < 2; ++ct) { const int c = wave * 32 + ct * 16 + l16, chunk = (4 * ks + l4) ^ ((c >> 3) & 15) ^ (c & 7); af[ct] = *(const LAS bf16x8*)(VT + c * 256 + chunk * 16); }
#pragma unroll
            for (int pt = 0; pt < 8; ++pt) bfr[pt] = *(const LAS bf16x8*)(Aimg + (pt * 16 + l16) * APITCH + (32 * ks + 8 * l4) * 2);
#pragma unroll
            for (int ct = 0; ct < 2; ++ct)
#pragma unroll
                for (int pt = 0; pt < 8; ++pt) acc[ct][pt] = __builtin_amdgcn_mfma_f32_16x16x32_bf16(af[ct], bfr[pt], acc[ct][pt], 0, 0, 0);
        }
        u32x4 uu[8];
#pragma unroll
        for (int i = 0; i < 8; ++i) { const int piece = tid + 512 * i; uu[i] = *(const u32x4*)(Z + (rowb + (piece >> 5)) * 2048 + g * 256 + (piece & 31) * 8); }
        __syncthreads();
        LAS unsigned char* SS = VT;
#pragma unroll
        for (int pt = 0; pt < 8; ++pt) {
            const int p = pt * 16 + l16; const float bsv = bsf[g * 128 + p];
#pragma unroll
            for (int ct = 0; ct < 2; ++ct) {
                const f32x4 s = acc[ct][pt] + bsv;
                u32x2 w; w.x = cvt_pk_bf16(s[0], s[1]); w.y = cvt_pk_bf16(s[2], s[3]);
                *(LAS u32x2*)(SS + p * 528 + (wave * 32 + ct * 16 + 4 * l4) * 2) = w;
            }
        }
        __syncthreads();
#pragma unroll
        for (int i = 0; i < 8; ++i) {
            const int piece = tid + 512 * i, p = piece >> 5, part = piece & 31;
            const u32x4 sv = *(const LAS u32x4*)(SS + p * 528 + part * 16);
            const unsigned ua[4] = {uu[i].x, uu[i].y, uu[i].z, uu[i].w}, sa[4] = {sv.x, sv.y, sv.z, sv.w}; unsigned r[4];
#pragma unroll
            for (int e = 0; e < 4; ++e) r[e] = cvt_pk_bf16(__uint_as_float(ua[e] << 16) * __uint_as_float(sa[e] << 16), __uint_as_float(ua[e] & 0xffff0000u) * __uint_as_float(sa[e] & 0xffff0000u));
            u32x4 w; w.x = r[0]; w.y = r[1]; w.z = r[2]; w.w = r[3];
            __builtin_nontemporal_store(w, (u32x4*)(T1 + (rowb + p) * D + g * 256 + part * 8));
        }
    }
}

__device__ __forceinline__ void final_norm_phase(const bf16_t* xb, float* out, const float* gain, int G) {
    int tid_ = tid_now(); asm volatile("" : "+v"(tid_));
    const int tid = tid_, lane = tid & 63, wave = tid >> 6, gw = blockIdx.x * 8 + wave, NGW = G * 8;
    f32x4 gv[4];
#pragma unroll
    for (int j = 0; j < 2; ++j) { gv[2 * j] = *(const f32x4*)(gain + 512 * j + 8 * lane); gv[2 * j + 1] = *(const f32x4*)(gain + 512 * j + 8 * lane + 4); }
    for (int r = gw; r < M; r += NGW) {
        f32x4 v[4]; float s = 0.f;
#pragma unroll
        for (int j = 0; j < 2; ++j) { const u32x4 q = *(const u32x4*)(xb + (size_t)r * D + 512 * j + 8 * lane);
            v[2 * j] = (f32x4){__uint_as_float(q.x << 16), __uint_as_float(q.x & 0xffff0000u), __uint_as_float(q.y << 16), __uint_as_float(q.y & 0xffff0000u)};
            v[2 * j + 1] = (f32x4){__uint_as_float(q.z << 16), __uint_as_float(q.z & 0xffff0000u), __uint_as_float(q.w << 16), __uint_as_float(q.w & 0xffff0000u)}; }
#pragma unroll
        for (int j = 0; j < 4; ++j) s += (v[j][0] * v[j][0] + v[j][1] * v[j][1]) + (v[j][2] * v[j][2] + v[j][3] * v[j][3]);
        s = wave_sum(s, lane);
        const float rs = 1.0f / sqrtf(s * (1.0f / D) + EPS);
#pragma unroll
        for (int j = 0; j < 2; ++j) { *(f32x4*)(out + (size_t)r * D + 512 * j + 8 * lane) = v[2 * j] * rs * gv[2 * j]; *(f32x4*)(out + (size_t)r * D + 512 * j + 8 * lane + 4) = v[2 * j + 1] * rs * gv[2 * j + 1]; }
    }
}

#define XB_TMO      128
#define XB_XCNT(j)  (256  + 64 * (j))
#define XB_XSUB(j)  (1280 + 64 * (j))
#define XB_XGEN(j)  (2304 + 64 * (j))
#define XB_TOP      3328
#define XB_TOPGEN   3392
#define XCD_BAR_WORDS 3456
#define XB_SPIN_CAP (1u << 20)
__device__ __forceinline__ unsigned xb_ld(unsigned* p)              { return __hip_atomic_load(p, __ATOMIC_RELAXED, __HIP_MEMORY_SCOPE_AGENT); }
__device__ __forceinline__ unsigned xb_add(unsigned* p, unsigned v) { return __hip_atomic_fetch_add(p, v, __ATOMIC_RELAXED, __HIP_MEMORY_SCOPE_AGENT); }
__device__ __forceinline__ unsigned xb_xcc_id() { return (unsigned)__builtin_amdgcn_s_getreg((3 << 11) | 20) & 0xFu; }
#define XB_SPIN(cond, bar) do { unsigned _sp = 0; while (cond) { __builtin_amdgcn_s_sleep(1); \
    if ((++_sp & 255u) == 0u) { if (xb_ld(&(bar)[XB_TMO])) break; if (_sp > XB_SPIN_CAP) { atomicAdd(&(bar)[XB_TMO], 1u); break; } } } } while (0)
struct XcdBarrier { unsigned* bar; unsigned x; volatile LAS unsigned* st; };
__device__ __forceinline__ XcdBarrier xcd_barrier_post(unsigned* bar, volatile LAS unsigned* st) {
    XcdBarrier b; b.bar = bar; b.x = xb_xcc_id(); b.st = st;
    if (tid_now() == 0) (void)xb_add(&bar[XB_XCNT(b.x)], 1u);
    return b;
}
__device__ __forceinline__ void xcd_barrier_complete(unsigned* bar, unsigned x, unsigned& nloc, unsigned& nx) {
    const unsigned G = gridDim.x * gridDim.y * gridDim.z;
    unsigned sum, cnt, mine, sp = 0u;
    for (;;) {
        sum = 0u; cnt = 0u; mine = 0u;
#pragma unroll
        for (unsigned j = 0; j < 16; ++j) { const unsigned c = xb_ld(&bar[XB_XCNT(j)]); sum += c; cnt += (c > 0u) ? 1u : 0u; mine = (j == x) ? c : mine; }
        if (sum == G) break;
        __builtin_amdgcn_s_sleep(1);
        if ((++sp & 255u) == 0u) { if (xb_ld(&bar[XB_TMO])) break; if (sp > XB_SPIN_CAP) { atomicAdd(&bar[XB_TMO], 1u); break; } }
    }
    nloc = mine > 0u ? mine : 1u; nx = cnt > 0u ? cnt : 1u;
}
__device__ __forceinline__ void xcd_barrier(const XcdBarrier& b) {
    asm volatile("s_waitcnt vmcnt(0)" ::: "memory");
    __syncthreads();
    if (tid_now() == 0) {
        unsigned* bar = b.bar;
        __builtin_amdgcn_s_waitcnt(0);
        unsigned nloc = b.st[0], nx = b.st[1];
        if (nloc == 0u) { xcd_barrier_complete(bar, b.x, nloc, nx); b.st[0] = nloc; b.st[1] = nx; }
        const unsigned old = xb_add(&bar[XB_XSUB(b.x)], 1u);
        const unsigned gen = old / nloc;
        if (old + 1u == (gen + 1u) * nloc) {
            __builtin_amdgcn_fence(__ATOMIC_RELEASE, "agent");
            asm volatile("s_waitcnt vmcnt(0)" ::: "memory");
            const unsigned og = xb_add(&bar[XB_TOP], 1u);
            const unsigned tg = og / nx;
            if (og + 1u == (tg + 1u) * nx) xb_add(&bar[XB_TOPGEN], 1u);
            else XB_SPIN(xb_ld(&bar[XB_TOPGEN]) == tg, bar);
            __builtin_amdgcn_fence(__ATOMIC_ACQUIRE, "agent");
            xb_add(&bar[XB_XGEN(b.x)], 1u);
            asm volatile("s_waitcnt vmcnt(0)" ::: "memory");
        } else {
            XB_SPIN(xb_ld(&bar[XB_XGEN(b.x)]) == gen, bar);
            __builtin_amdgcn_fence(__ATOMIC_ACQUIRE, "agent");
            asm volatile("s_waitcnt vmcnt(0)" ::: "memory");
        }
    }
    __syncthreads();
}

constexpr int NPHASES = 35;
__host__ __device__ inline bool phase_empty(int ph) { if (ph < 2 || ph >= 34) return false; const int L = (ph - 2) >> 3, k = (ph - 2) & 7; return (k == 2 && (L & 1) == 0) || k == 4; }

__global__ void __launch_bounds__(512, 2) fwd_megakernel(Params P) {
    extern __shared__ __attribute__((aligned(16))) unsigned char lds_raw[];
    LAS unsigned char* lds = (LAS unsigned char*)lds_raw;
    cg::grid_group grid = cg::this_grid();
    const int G = gridDim.x;
    typedef const Params __attribute__((address_space(4))) CParams;
    volatile LAS unsigned* MISC = (volatile LAS unsigned*)(lds + 131072 + 320);
    { const int t0 = threadIdx.x;
      if ((t0 & 63) == 0) ((volatile LAS int*)(lds + WIDTAB_OFF))[(unsigned)__builtin_amdgcn_s_getreg((5 << 11) | 4) & 63u] = t0 >> 6;
      if (t0 < 32) MISC[t0] = 0u; }
    __syncthreads();
    const int ph_lo = P.ph_lo, ph_hi = P.ph_hi;
    XcdBarrier bar; bar.bar = (unsigned*)(P.ws + WS_CTL); bar.x = 0; bar.st = MISC + 8;
    if (ph_hi - ph_lo > 1) bar = xcd_barrier_post((unsigned*)(P.ws + WS_CTL), MISC + 8);

    for (int ph = ph_lo; ph < ph_hi; ++ph) {
        const CParams* KP = (const CParams*)__builtin_amdgcn_kernarg_segment_ptr(); asm volatile("" : "+s"(KP));
        unsigned char* ws = KP->ws;
        bf16_t* T1 = (bf16_t*)(ws + WS_T1); bf16_t* ZB = (bf16_t*)(ws + WS_Z); bf16_t* HB = (bf16_t*)(ws + WS_H);
        bf16_t* XB = (bf16_t*)(ws + WS_XB); bf16_t* KVALL = (bf16_t*)(ws + WS_KVALL); bf16_t* MEMB = (bf16_t*)(ws + WS_MEMB); bf16_t* MQ = (bf16_t*)(ws + WS_MQ); bf16_t* VWO = (bf16_t*)(ws + WS_VWO);
        float* SSQ[2] = {(float*)(ws + WS_SSQ0), (float*)(ws + WS_SSQ1)};
        float* VSTAT = (float*)(ws + WS_VSTAT); float* RSTDMEM = (float*)(ws + WS_RSTDMEM);
        if (phase_empty(ph)) continue;
        if (ph == 0) {
            { Params Pl; for (int i = 0; i < 20; ++i) Pl.in[i] = KP->in[i]; Pl.out = KP->out; Pl.ws = ws; Pl.ph_lo = 0; Pl.ph_hi = 0; prologue_phase(Pl, lds, G); }
        } else if (ph == 1) {
            pg8::StaticOrder S; S.init(MR, 8192, G, (int)blockIdx.x);
            pg8::Gemm g{MEMB, (const bf16_t*)(ws + WS_WK), MR, 8192, D, D, D}; pg8::EpiAct<4> E{KVALL, 8192, nullptr, 1.f, RSTDMEM, nullptr}; pg8::gemm_phase<0>(lds, g, S, E);
        } else if (ph == 34) {
            final_norm_phase(XB, KP->out, KP->in[I_G_FINAL], G);
        } else {
            const int L = (ph - 2) >> 3, k = (ph - 2) & 7, j = L >> 1; const bool odd = (L & 1) != 0;
            if (k == 0) {
                const float* ssq_r = SSQ[(3 * L) & 1];
                if (!odd) { if (L == 0) pool_a_phase<true>(lds, KP->in[I_X], ssq_r, T1, G); else pool_a_phase<false>(lds, XB, ssq_r, T1, G); }
                else { pg8::Gemm g{XB, (const bf16_t*)(ws + WS_WIN) + (size_t)j * D * 2 * D, M, 2 * D, D, D, D}; pg8::StaticOrder S; S.init(M, 2 * D, G, (int)blockIdx.x);
                    pg8::EpiAct<2> E{ZB, 2 * D, ssq_r, 1.f, nullptr, VSTAT}; pg8::gemm_phase<0>(lds, g, S, E); }
                __syncthreads();
                { pg8::Gemm g{KVALL + L * 1024, (const bf16_t*)(ws + WS_WQ) + (size_t)L * D * D, 4 * MR, D, 256, 8192, D}; pg8::StaticOrder S; S.init(4 * MR, D, G, (int)blockIdx.x);
                  pg8::EpiAct<5> E{MQ, D, nullptr, QSCALE, nullptr, nullptr}; pg8::gemm_phase<3>(lds, g, S, E); }
                { pg8::Gemm g{(const bf16_t*)(ws + WS_WO) + (size_t)L * D * D, KVALL + 4096 + L * 1024, D, 4 * MR, 256, D, 8192}; pg8::StaticOrder S; S.init(D, 4 * MR, G, (int)blockIdx.x);
                  pg8::EpiAct<6> E{VWO, D, nullptr, 1.f, nullptr, nullptr}; pg8::gemm_phase<4>(lds, g, S, E); }
            } else if (k == 1 && odd) {
                sgu_spatial_phase(lds, ZB, VSTAT, KP->in[I_SGU_WS] + (size_t)j * 4 * 128 * 128, KP->in[I_SGU_BS] + j * 512, KP->in[I_SGU_LNG] + j * D, KP->in[I_SGU_LNB] + j * D, T1, G);
            } else if (k == 3) {
                pg8::Gemm g{XB, MQ, M, D, D, D, D}; pg8::StaticOrder S; S.init(M, D, G, (int)blockIdx.x);
                pg8::EpiSoftmax E{T1, SSQ[(3 * L + 1) & 1], (LAS float*)(lds + 131072 + 1024)}; pg8::gemm_phase<2>(lds, g, S, E);
            } else if (k == 6) {
                pg8::Gemm g{XB, (const bf16_t*)(ws + WS_W1) + (size_t)L * D * FF, M, FF, D, D, D}; pg8::StaticOrder S; S.init(M, FF, G, (int)blockIdx.x);
                pg8::EpiAct<1> E{HB, FF, SSQ[(3 * L + 2) & 1], 1.f, nullptr, nullptr}; pg8::gemm_phase<0>(lds, g, S, E);
            } else {
                pg8::StaticOrder S; S.init(M, D, G, (int)blockIdx.x);
                if (k == 1) {
                    pg8::Gemm g{T1, (const bf16_t*)(ws + WS_PW) + (size_t)j * 4 * 256 * 256, M, D, 256, D, 256};
                    if (L == 0) { pg8::EpiResid<true> E{KP->in[I_X], XB, SSQ[(3 * L + 1) & 1]}; pg8::gemm_phase<1>(lds, g, S, E); }
                    else { pg8::EpiResid<false> E{nullptr, XB, SSQ[(3 * L + 1) & 1]}; pg8::gemm_phase<1>(lds, g, S, E); }
                } else if (k == 5) {
                    pg8::Gemm g{T1, VWO, M, D, D, D, D}; pg8::EpiResid<false> E{nullptr, XB, SSQ[(3 * L + 2) & 1]}; pg8::gemm_phase<2>(lds, g, S, E);
                } else {
                    pg8::Gemm g; int upd;
                    if (k == 2) { g = pg8::Gemm{T1, (const bf16_t*)(ws + WS_WOUT) + (size_t)j * D * D, M, D, D, D, D}; upd = 3 * L; }
                    else        { g = pg8::Gemm{HB, (const bf16_t*)(ws + WS_W2) + (size_t)L * D * FF, M, D, FF, 64, FF}; upd = 3 * L + 2; }
                    pg8::EpiResid<false> E{nullptr, XB, SSQ[(upd + 1) & 1]};
                    if (k == 2) pg8::gemm_phase<0>(lds, g, S, E); else pg8::gemm_phase<5>(lds, g, S, E);
                }
            }
        }
        if (ph + 1 < ph_hi) { if (ph == 0) grid.sync(); else xcd_barrier(bar); }
    }
}

extern "C" void kernel_launch(void* const* d_in, const int* in_sizes, int n_in, void* d_out, int out_size, void* d_ws, size_t ws_size, hipStream_t stream) {
    static int grid = 0;
    if (grid == 0) {
        if (n_in != 20 || in_sizes[0] != M * D || out_size != M * D || ws_size < WS_END) { fprintf(stderr, "kernel_launch: unexpected shapes (n_in %d, in0 %d, out %d, ws %zu); nothing launched\n", n_in, n_in > 0 ? in_sizes[0] : -1, out_size, ws_size); grid = -1; return; }
        int dev = 0, cus = 0, per_cu = 0;
        if (hipGetDevice(&dev) != hipSuccess || hipDeviceGetAttribute(&cus, hipDeviceAttributeMultiprocessorCount, dev) != hipSuccess) { grid = -1; return; }
        if (hipFuncSetAttribute((const void*)fwd_megakernel, hipFuncAttributeMaxDynamicSharedMemorySize, LDS_BYTES) != hipSuccess) { fprintf(stderr, "kernel_launch: hipFuncSetAttribute failed\n"); grid = -1; return; }
        if (hipOccupancyMaxActiveBlocksPerMultiprocessor(&per_cu, (const void*)fwd_megakernel, 512, LDS_BYTES) != hipSuccess || per_cu < 1) { fprintf(stderr, "kernel_launch: occupancy query gave %d\n", per_cu); per_cu = 1; }
        (void)hipGetLastError();
        grid = cus * per_cu;
        if (grid > 256) grid = 256;
        grid &= ~7;
        if (grid < 8) { grid = -1; return; }
    }
    if (grid < 0) return;
    Params p{};
    for (int i = 0; i < 20; ++i) p.in[i] = (const float*)d_in[i];
    p.out = (float*)d_out; p.ws = (unsigned char*)d_ws;
#if MK_SINGLE
    p.ph_lo = 0; p.ph_hi = NPHASES;
    if (hipMemsetAsync((char*)d_ws + WS_CTL, 0, CTL_BYTES, stream) != hipSuccess) { fprintf(stderr, "kernel_launch: memset failed\n"); return; }
    void* args[] = {&p};
    hipError_t e = hipLaunchCooperativeKernel((const void*)fwd_megakernel, dim3(grid), dim3(512), args, LDS_BYTES, stream);
    if (e != hipSuccess) fprintf(stderr, "kernel_launch: cooperative launch failed: %s (grid %d)\n", hipGetErrorString(e), grid);
#else
    for (int ph = 0; ph < NPHASES; ++ph) {
        if (phase_empty(ph)) continue;
        p.ph_lo = ph; p.ph_hi = ph + 1;
        hipLaunchKernelGGL(fwd_megakernel, dim3(grid), dim3(512), LDS_BYTES, stream, p);
    }
#endif
}
```

```cpp
#include <hip/hip_runtime.h>
#include <hip/hip_cooperative_groups.h>
#include <cstdio>
#include <cstdint>
namespace cg = cooperative_groups;

#ifndef MK_SINGLE
#define MK_SINGLE 1
#endif

#define LAS __attribute__((address_space(3)))
typedef unsigned short bf16_t;
typedef short bf16x8 __attribute__((ext_vector_type(8)));
typedef float f32x4 __attribute__((ext_vector_type(4)));
typedef float f32x2 __attribute__((ext_vector_type(2)));
typedef float f32x16 __attribute__((ext_vector_type(16)));
typedef unsigned u32x4 __attribute__((ext_vector_type(4)));
typedef unsigned u32x2 __attribute__((ext_vector_type(2)));

constexpr int D = 1024, BATCH = 16, SEQ = 4096, DEPTH = 4, FF = 4096, NMEM = 256;
constexpr int M = BATCH * SEQ;
constexpr int MR = BATCH * NMEM;
constexpr float EPS = 1e-6f;
constexpr float QSCALE = 0.0625f * 1.4426950408889634f;

constexpr size_t MiB = 1u << 20;
constexpr size_t WS_H = 0, WS_T1 = 0, WS_O = 128 * MiB, WS_Z = 256 * MiB;
constexpr size_t WS_XB = 512 * MiB;
constexpr size_t WS_KVALL = 640 * MiB, WS_MEMB = 704 * MiB;
constexpr size_t WS_SSQ0 = 712 * MiB, WS_SSQ1 = 716 * MiB, WS_VSTAT = 720 * MiB, WS_RSTDMEM = 728 * MiB;
constexpr size_t WS_CTL = 730 * MiB, CTL_BYTES = 16384;
constexpr size_t WS_WQ = 736 * MiB, WS_WO = 744 * MiB, WS_W1 = 752 * MiB, WS_W2 = 784 * MiB, WS_WK = 816 * MiB, WS_WV = 824 * MiB;
constexpr size_t WS_WIN = 832 * MiB, WS_WOUT = 840 * MiB, WS_PW = 844 * MiB;
constexpr size_t WS_MQ = 848 * MiB, WS_VWO = 880 * MiB, WS_END = 912 * MiB;

constexpr int LDS_BYTES = 147456;

struct Params {
    const float* in[20];
    float* out;
    unsigned char* ws;
    int ph_lo, ph_hi;
};

extern __shared__ __attribute__((aligned(16))) unsigned char g_lds[];
constexpr int WIDTAB_OFF = 131072 + 512;
__device__ __forceinline__ int tid_now() {
    unsigned m = ~0u; asm volatile("" : "+s"(m));
    const int lane = (int)__builtin_amdgcn_mbcnt_hi(m, __builtin_amdgcn_mbcnt_lo(m, 0u));
    const unsigned hw = (unsigned)__builtin_amdgcn_s_getreg((5 << 11) | 4) & 63u;
    const int wid = __builtin_amdgcn_readfirstlane(((volatile LAS int*)((LAS unsigned char*)g_lds + WIDTAB_OFF))[hw]);
    return wid * 64 + lane;
}
__device__ __forceinline__ unsigned cvt_pk_bf16(float lo, float hi) { unsigned r; asm volatile("v_cvt_pk_bf16_f32 %0, %1, %2" : "=v"(r) : "v"(lo), "v"(hi)); return r; }
__device__ __forceinline__ float sx(float v, int o, int lane) { return __builtin_bit_cast(float, __builtin_amdgcn_ds_bpermute((lane ^ o) << 2, __builtin_bit_cast(int, v))); }
__device__ __forceinline__ float wave_sum(float v, int lane) {
#pragma unroll
    for (int o = 1; o < 64; o <<= 1) v += sx(v, o, lane);
    return v;
}
__device__ __forceinline__ float gelu_tanh(float x) {
    const float y = 0.7978845608028654f * (x + 0.044715f * x * x * x);
    const float e = __builtin_amdgcn_exp2f(-2.0f * 1.4426950408889634f * y);
    return x * __builtin_amdgcn_rcpf(1.0f + e);
}

namespace pg8 {
constexpr int BM = 256, BK = 64, HALF = 128, HTB = HALF * BK * 2, STAGE_BYTES = 8 * HTB, NXCD = 8, WGM = 8;
__host__ __device__ __forceinline__ int lds_byte(int r, int c) { const int st = (r >> 4) * 2 + (c >> 5), rr = r & 15, cc = c & 31, ob = rr * 64 + cc * 2; return st * 1024 + (ob ^ (((ob >> 9) & 1) << 5)); }
__host__ __device__ __forceinline__ void stage_rc(int b, int& R, int& C) { const int st = b / 1024, sb = b % 1024, swz = sb ^ (((sb >> 9) & 1) << 5); R = (st >> 1) * 16 + swz / 64; C = (st & 1) * 32 + (swz % 64) / 2; }
__host__ __device__ __forceinline__ int perm32(int rho) { const int n = rho >> 4, i = rho & 15; return 8 * (i >> 2) + 4 * n + (i & 3); }

struct Unit { int pm, pn, pidx; };
struct Gemm { const bf16_t* A; const bf16_t* Bt; int M, N, K, lda, ldb; };
template <int KIND> __device__ __forceinline__ const char* unitA(const Gemm& g, int pm, int pn, size_t tstepA) {
    size_t off = (size_t)((KIND == 3) ? (pm & 15) : pm) * tstepA;
    if (KIND == 1) off += (size_t)pn * 512; if (KIND == 3) off += (size_t)(pm >> 4) * 512; if (KIND == 4) off += (size_t)(pn >> 4) * 512;
    return (const char*)g.A + off;
}
template <int KIND> __device__ __forceinline__ const char* unitB(const Gemm& g, int pm, int pn, size_t tstepB) {
    size_t off = (size_t)((KIND == 4) ? (pn & 15) : pn) * tstepB;
    if (KIND == 2) off += (size_t)(pm >> 4) * 2097152; if (KIND == 3) off += (size_t)(pm >> 4) * 512; if (KIND == 4) off += (size_t)(pn >> 4) * 512;
    return (const char*)g.Bt + off;
}

struct StaticOrder {
    int nM, nN, nwg, G, c;
    __device__ void init(int M_, int N_, int G_, int c_) { nM = M_ / BM; nN = N_ / BM; nwg = nM * nN; G = G_; c = c_; }
    __device__ bool next(int i, Unit& u) const {
        const long L = (long)i * G + c; if (L >= nwg) return false;
        int wgid = (int)L; { const int q = nwg / NXCD, r = nwg % NXCD, xcd = wgid % NXCD, off = wgid / NXCD; wgid = (xcd < r ? xcd * (q + 1) : r * (q + 1) + (xcd - r) * q) + off; }
        const int nig = WGM * nN, gid = wgid / nig, fm = gid * WGM, gsz = (nM - fm) < WGM ? (nM - fm) : WGM;
        u.pm = fm + ((wgid % nig) % gsz); u.pn = (wgid % nig) / gsz; return true;
    }
};

__device__ __forceinline__ float rstd_from_slots(const float* ssq, int row, int fq, int lane) {
    const f32x4 v = *(const f32x4*)(ssq + (size_t)row * 16 + fq * 4);
    float s = (v[0] + v[1]) + (v[2] + v[3]);
    s += sx(s, 16, lane); s += sx(s, 32, lane);
    return __builtin_amdgcn_rsqf(s * (1.0f / 1024.0f) + EPS);
}

constexpr int RSTD_TAB_OFF = 140288;
__device__ __forceinline__ void fill_rstd_table(LAS float* tab, const float* ssq, const StaticOrder& S) {
    int t = tid_now(); asm volatile("" : "+v"(t));
    Unit u; int d = 0, last = -1, p0 = -1, p1 = -1, p2 = -1, p3 = -1;
    for (int i = 0; S.next(i, u); ++i) if (u.pm != last) { if (d == 0) p0 = u.pm; else if (d == 1) p1 = u.pm; else if (d == 2) p2 = u.pm; else if (d == 3) p3 = u.pm; ++d; last = u.pm; }
#pragma unroll
    for (int k = 0; k < 2; ++k) {
        const int e = (t >> 8) + 2 * k, pm = (e == 0) ? p0 : (e == 1) ? p1 : (e == 2) ? p2 : p3;
        if (pm >= 0) { const f32x4* p = (const f32x4*)(ssq + (size_t)(pm * BM + (t & 255)) * 16); const f32x4 a = p[0], b = p[1], c = p[2], dd = p[3];
            const float s = (((a[0] + a[1]) + (a[2] + a[3])) + ((b[0] + b[1]) + (b[2] + b[3]))) + (((c[0] + c[1]) + (c[2] + c[3])) + ((dd[0] + dd[1]) + (dd[2] + dd[3])));
            tab[e * 256 + (t & 255)] = __builtin_amdgcn_rsqf(s * (1.0f / 1024.0f) + EPS); }
    }
    __syncthreads();
}
template <int MODE> struct EpiAct {
    bf16_t* O; int ldc; const float* ssq; float scale; const float* rvec; float* vstat; LAS float* tab;
    __device__ __forceinline__ void operator()(const f32x4 (&acc)[2][2][4][2], const Unit& u, int, int, int, int) const {
        int t_ = tid_now(); asm volatile("" : "+v"(t_));
        const int wid_ = __builtin_amdgcn_readfirstlane(t_ >> 6), wr = wid_ >> 2, wc = wid_ & 3, fr = t_ & 15, fq = (t_ & 63) >> 4;
        const int row0 = u.pm * BM + wr * 64 + fr, col0 = u.pn * BM + wc * 32 + 8 * fq;
        f32x4 cs[2][2];
        if (MODE == 3) {
#pragma unroll
            for (int bj = 0; bj < 2; ++bj) { cs[bj][0] = *(const f32x4*)(rvec + col0 + bj * HALF); cs[bj][1] = *(const f32x4*)(rvec + col0 + bj * HALF + 4); }
        }
#pragma unroll
        for (int ai = 0; ai < 2; ++ai)
#pragma unroll
            for (int m = 0; m < 4; ++m) {
                const int row = row0 + ai * HALF + m * 16;
                float rs = 1.f;
                if (MODE == 0 || MODE == 1 || MODE == 2) rs = (tab != nullptr && u.pidx < 4) ? tab[u.pidx * 256 + (row - u.pm * BM)] : rstd_from_slots(ssq, row, fq, fq * 16 + fr);
                if (MODE == 0) rs *= scale;
                if (MODE == 4) rs = rvec[row];
                bf16_t* rowp = O + (size_t)row * ldc + col0;
                if (MODE == 5) { const int rl = row - u.pm * BM; rowp = O + ((size_t)(u.pm & 15) << 20) + (size_t)((u.pm >> 4) * 256 + rl) * 1024 + col0; rs = scale; }
                if (MODE == 6) { rowp = O + ((size_t)(u.pn & 15) << 20) + (size_t)row * 1024 + (u.pn >> 4) * 256 + (col0 - u.pn * BM); }
                float s1 = 0.f, s2 = 0.f;
#pragma unroll
                for (int bj = 0; bj < 2; ++bj) {
                    f32x4 v0 = acc[ai][bj][m][0] * rs, v1 = acc[ai][bj][m][1] * rs;
                    if (MODE == 3) { v0 = acc[ai][bj][m][0] * cs[bj][0]; v1 = acc[ai][bj][m][1] * cs[bj][1]; }
                    if (MODE == 1) {
#pragma unroll
                        for (int j = 0; j < 4; ++j) { const float a = v0[j] > 0.f ? v0[j] : 0.f, b = v1[j] > 0.f ? v1[j] : 0.f; v0[j] = a * a; v1[j] = b * b; }
                    }
                    if (MODE == 2) {
#pragma unroll
                        for (int j = 0; j < 4; ++j) { v0[j] = gelu_tanh(v0[j]); v1[j] = gelu_tanh(v1[j]); }
#pragma unroll
                        for (int j = 0; j < 4; ++j) { s1 += v0[j] + v1[j]; s2 += v0[j] * v0[j] + v1[j] * v1[j]; }
                    }
                    u32x4 w; w.x = cvt_pk_bf16(v0[0], v0[1]); w.y = cvt_pk_bf16(v0[2], v0[3]); w.z = cvt_pk_bf16(v1[0], v1[1]); w.w = cvt_pk_bf16(v1[2], v1[3]);
                    bf16_t* sp = rowp + bj * HALF;
                    if (MODE == 1) { const int col = col0 + bj * HALF; sp = O + (((size_t)(u.pm * (ldc >> 6) + (col >> 6)) * BM + (row - u.pm * BM)) << 6) + (col & 63); }
                    __builtin_nontemporal_store(w, (u32x4*)sp);
                }
                if (MODE == 2) {
                    { const int ln = fq * 16 + fr; s1 += sx(s1, 16, ln); s1 += sx(s1, 32, ln); s2 += sx(s2, 16, ln); s2 += sx(s2, 32, ln); }
                    if (u.pn >= 4 && fq == 0) { vstat[(size_t)row * 32 + (u.pn - 4) * 4 + wc] = s1; vstat[(size_t)row * 32 + 16 + (u.pn - 4) * 4 + wc] = s2; }
                }
            }
    }
};
struct EpiSoftmax {
    bf16_t* O; const float* ssq; LAS float* red; LAS float* tab;
    __device__ __forceinline__ void operator()(f32x4 (&acc)[2][2][4][2], const Unit& u, int, int, int, int) const {
        int t_ = tid_now(); asm volatile("" : "+v"(t_));
        const int wid_ = __builtin_amdgcn_readfirstlane(t_ >> 6), wr = wid_ >> 2, wc = wid_ & 3, fr = t_ & 15, fq = (t_ & 63) >> 4;
        const int row0 = u.pm * BM + wr * 64 + fr, col0 = u.pn * BM + wc * 32 + 8 * fq, lane = fq * 16 + fr;
#pragma unroll
        for (int ai = 0; ai < 2; ++ai)
#pragma unroll
            for (int m = 0; m < 4; ++m) {
                const int rl = ai * HALF + wr * 64 + m * 16 + fr;
                const float rs = (tab != nullptr && u.pidx < 4) ? tab[u.pidx * 256 + rl] : rstd_from_slots(ssq, u.pm * BM + rl, fq, lane);
                float mx = -3.0e38f;
#pragma unroll
                for (int bj = 0; bj < 2; ++bj)
#pragma unroll
                    for (int n = 0; n < 2; ++n) { acc[ai][bj][m][n] = acc[ai][bj][m][n] * rs;
#pragma unroll
                        for (int j = 0; j < 4; ++j) mx = fmaxf(mx, acc[ai][bj][m][n][j]); }
                mx = fmaxf(mx, sx(mx, 16, lane)); mx = fmaxf(mx, sx(mx, 32, lane));
                if (fq == 0) red[rl * 4 + wc] = mx;
            }
        asm volatile("s_waitcnt lgkmcnt(0)" ::: "memory"); __builtin_amdgcn_s_barrier(); asm volatile("" ::: "memory");
#pragma unroll
        for (int ai = 0; ai < 2; ++ai)
#pragma unroll
            for (int m = 0; m < 4; ++m) {
                const int rl = ai * HALF + wr * 64 + m * 16 + fr;
                const f32x4 r4 = *(const LAS f32x4*)(red + rl * 4);
                const float mx = fmaxf(fmaxf(r4[0], r4[1]), fmaxf(r4[2], r4[3]));
                float sm = 0.f;
#pragma unroll
                for (int bj = 0; bj < 2; ++bj)
#pragma unroll
                    for (int n = 0; n < 2; ++n)
#pragma unroll
                        for (int j = 0; j < 4; ++j) { const float e = __builtin_amdgcn_exp2f(acc[ai][bj][m][n][j] - mx); acc[ai][bj][m][n][j] = e; sm += e; }
                sm += sx(sm, 16, lane); sm += sx(sm, 32, lane);
                if (fq == 0) red[1024 + rl * 4 + wc] = sm;
            }
        asm volatile("s_waitcnt lgkmcnt(0)" ::: "memory"); __builtin_amdgcn_s_barrier(); asm volatile("" ::: "memory");
#pragma unroll
        for (int ai = 0; ai < 2; ++ai)
#pragma unroll
            for (int m = 0; m < 4; ++m) {
                const int rl = ai * HALF + wr * 64 + m * 16 + fr;
                const f32x4 r4 = *(const LAS f32x4*)(red + 1024 + rl * 4);
                const float inv = 1.0f / ((r4[0] + r4[1]) + (r4[2] + r4[3]));
                bf16_t* rowp = O + (size_t)(row0 + ai * HALF + m * 16) * D + col0;
#pragma unroll
                for (int bj = 0; bj < 2; ++bj) {
                    const f32x4 v0 = acc[ai][bj][m][0] * inv, v1 = acc[ai][bj][m][1] * inv;
                    u32x4 w; w.x = cvt_pk_bf16(v0[0], v0[1]); w.y = cvt_pk_bf16(v0[2], v0[3]); w.z = cvt_pk_bf16(v1[0], v1[1]); w.w = cvt_pk_bf16(v1[2], v1[3]);
                    __builtin_nontemporal_store(w, (u32x4*)(rowp + bj * HALF));
                }
            }
    }
};
template <bool F32IN> struct EpiResid {
    const float* xin; bf16_t* xb; float* ssq;
    __device__ __forceinline__ void operator()(const f32x4 (&acc)[2][2][4][2], const Unit& u, int, int, int, int) const {
        int t_ = tid_now(); asm volatile("" : "+v"(t_));
        const int wid_ = __builtin_amdgcn_readfirstlane(t_ >> 6), wr = wid_ >> 2, wc = wid_ & 3, fr = t_ & 15, fq = (t_ & 63) >> 4;
        const int row0 = u.pm * BM + wr * 64 + fr, col0 = u.pn * BM + wc * 32 + 8 * fq;
#pragma unroll
        for (int ai = 0; ai < 2; ++ai)
#pragma unroll
            for (int m = 0; m < 4; ++m) {
                const int row = row0 + ai * HALF + m * 16; const size_t off = (size_t)row * D + col0;
                float ss = 0.f;
#pragma unroll
                for (int bj = 0; bj < 2; ++bj) {
                    f32x4 a0, a1;
                    if (F32IN) { a0 = *(const f32x4*)(xin + off + bj * HALF); a1 = *(const f32x4*)(xin + off + bj * HALF + 4); }
                    else { const u32x4 r = *(const u32x4*)(xb + off + bj * HALF);
                        a0 = (f32x4){__uint_as_float(r.x << 16), __uint_as_float(r.x & 0xffff0000u), __uint_as_float(r.y << 16), __uint_as_float(r.y & 0xffff0000u)};
                        a1 = (f32x4){__uint_as_float(r.z << 16), __uint_as_float(r.z & 0xffff0000u), __uint_as_float(r.w << 16), __uint_as_float(r.w & 0xffff0000u)}; }
                    const f32x4 v0 = a0 + acc[ai][bj][m][0], v1 = a1 + acc[ai][bj][m][1];
                    u32x4 w; w.x = cvt_pk_bf16(v0[0], v0[1]); w.y = cvt_pk_bf16(v0[2], v0[3]); w.z = cvt_pk_bf16(v1[0], v1[1]); w.w = cvt_pk_bf16(v1[2], v1[3]);
                    __builtin_nontemporal_store(w, (u32x4*)(xb + off + bj * HALF));
                    const unsigned ww[4] = {w.x, w.y, w.z, w.w};
#pragma unroll
                    for (int j = 0; j < 4; ++j) { const float lo = __uint_as_float(ww[j] << 16), hi = __uint_as_float(ww[j] & 0xffff0000u); ss += lo * lo + hi * hi; }
                }
                { const int ln = fq * 16 + fr; ss += sx(ss, 16, ln); ss += sx(ss, 32, ln); }
                if (fq == 0) ssq[(size_t)row * 16 + u.pn * 4 + wc] = ss;
                asm volatile("" ::: "memory");
            }
    }
};

template <int KIND, class Epi>
__device__ __forceinline__ void gemm_phase(LAS unsigned char* lds, const Gemm g, const StaticOrder& S, const Epi& E) {
    int tid_ = tid_now(); asm volatile("" : "+v"(tid_));
    const int tid = tid_, wid = __builtin_amdgcn_readfirstlane(tid >> 6), lane = tid & 63, wr = wid >> 2, wc = wid & 3, fr = lane & 15, fq = lane >> 4;
    const int nt = g.K / BK;
    unsigned voffA[2], voffB[2];
#pragma unroll
    for (int i = 0; i < 2; ++i) { int R, C; stage_rc(tid * 16 + i * 8192, R, C); const int Rb = (R & ~31) + perm32(R & 31);
        voffA[i] = (unsigned)(R * g.lda + C) * 2u; voffB[i] = (unsigned)(Rb * g.ldb + C) * 2u; }
    const size_t kstep = (size_t)(BK * 2), kstepA = (KIND == 5) ? (size_t)(BM * BK * 2) : kstep;
    const size_t hstepA = (size_t)HALF * g.lda * 2, hstepB = (size_t)HALF * g.ldb * 2;
    const size_t tstepA = (KIND == 5) ? (size_t)g.K * BM * 2 : 2 * hstepA, tstepB = 2 * hstepB;
    const unsigned ldsw = (unsigned)wid * 1024u;
    const int aoff = lds_byte(wr * 64 + fr, fq * 8), boff = lds_byte(wc * 32 + fr, fq * 8);
#define PG8_SA(b, h) (((b) * 2 + (h)) * HTB)
#define PG8_SB(b, h) ((4 + (b) * 2 + (h)) * HTB)
#define PG8_STAGE(bufoff, gbase, voff) do { _Pragma("unroll") for (int _i = 0; _i < 2; ++_i) \
        __builtin_amdgcn_global_load_lds((const unsigned*)((const char*)(gbase) + (voff)[_i]), (LAS unsigned*)(lds + (bufoff) + ldsw + _i * 8192), 16, 0, 0); } while (0)
#define PG8_LDA(dst, b, h) do { _Pragma("unroll") for (int m = 0; m < 4; ++m) _Pragma("unroll") for (int k = 0; k < 2; ++k) dst[m][k] = *(const LAS bf16x8*)(lds + PG8_SA(b, h) + aoff + m * 2048 + k * 1024); } while (0)
#define PG8_LDB(dst, b, h) do { _Pragma("unroll") for (int n = 0; n < 2; ++n) _Pragma("unroll") for (int k = 0; k < 2; ++k) dst[n][k] = *(const LAS bf16x8*)(lds + PG8_SB(b, h) + boff + n * 2048 + k * 1024); } while (0)
#define PG8_MMA(ai, bj, At, Bt) do { __builtin_amdgcn_s_setprio(1); _Pragma("unroll") for (int m = 0; m < 4; ++m) _Pragma("unroll") for (int n = 0; n < 2; ++n) _Pragma("unroll") for (int k = 0; k < 2; ++k) \
        acc[ai][bj][m][n] = __builtin_amdgcn_mfma_f32_16x16x32_bf16(Bt[n][k], At[m][k], acc[ai][bj][m][n], 0, 0, 0); __builtin_amdgcn_s_setprio(0); } while (0)
#define PG8_WAIT_V(n) asm volatile("s_waitcnt vmcnt(" #n ")" ::: "memory")
#define PG8_WAIT_L(n) asm volatile("s_waitcnt lgkmcnt(" #n ")" ::: "memory")
#define PG8_BAR __builtin_amdgcn_s_barrier()
#define PG8_SCHED __builtin_amdgcn_sched_barrier(0)
    Unit cur, nxt; int ui = 0;
    if (!S.next(0, cur)) return;
    cur.pidx = 0;
    f32x4 acc[2][2][4][2];
#pragma unroll
    for (int a = 0; a < 2; ++a)
#pragma unroll
        for (int b = 0; b < 2; ++b)
#pragma unroll
            for (int m = 0; m < 4; ++m)
#pragma unroll
                for (int n = 0; n < 2; ++n) acc[a][b][m][n] = (f32x4){0.f, 0.f, 0.f, 0.f};
    bf16x8 At[4][2], B0[2][2], B1[2][2];
    const char* cA = unitA<KIND>(g, cur.pm, cur.pn, tstepA); const char* cB = unitB<KIND>(g, cur.pm, cur.pn, tstepB);
    PG8_STAGE(PG8_SB(0, 0), cB, voffB); PG8_STAGE(PG8_SB(0, 1), cB + hstepB, voffB); PG8_STAGE(PG8_SA(0, 0), cA, voffA); PG8_STAGE(PG8_SA(0, 1), cA + hstepA, voffA);
    if (wr == 1) PG8_BAR;
    PG8_WAIT_V(2); PG8_BAR;
    PG8_STAGE(PG8_SB(1, 0), cB + kstep, voffB); PG8_STAGE(PG8_SA(1, 0), cA + kstepA, voffA); PG8_STAGE(PG8_SB(1, 1), cB + hstepB + kstep, voffB);
    PG8_WAIT_V(6); PG8_BAR;
    for (;;) {
        const bool has_next = S.next(ui + 1, nxt);
        nxt.pidx = (has_next && nxt.pm != cur.pm) ? cur.pidx + 1 : cur.pidx;
        const char* nA = has_next ? unitA<KIND>(g, nxt.pm, nxt.pn, tstepA) : cA; const char* nB = has_next ? unitB<KIND>(g, nxt.pm, nxt.pn, tstepB) : cB;
        for (int t = 0; t < nt; t += 2) {
            const bool last = (t == nt - 2);
            const char* a1 = cA + (size_t)(t + 1) * kstepA;
            const char* a2 = last ? nA : cA + (size_t)(t + 2) * kstepA; const char* b2 = last ? nB : cB + (size_t)(t + 2) * kstep;
            const char* a3 = a2 + kstepA; const char* b3 = b2 + kstep;
            PG8_LDB(B0, 0, 0); PG8_LDB(B1, 0, 1); PG8_SCHED; PG8_LDA(At, 0, 0); PG8_STAGE(PG8_SA(1, 1), a1 + hstepA, voffA);
            PG8_WAIT_V(8); PG8_WAIT_L(0); PG8_BAR; PG8_MMA(0, 0, At, B0); PG8_MMA(0, 1, At, B1); PG8_BAR; PG8_SCHED;
            PG8_LDA(At, 0, 1); PG8_STAGE(PG8_SB(0, 0), b2, voffB); PG8_STAGE(PG8_SB(0, 1), b2 + hstepB, voffB); PG8_STAGE(PG8_SA(0, 0), a2, voffA);
            PG8_WAIT_V(8); PG8_WAIT_L(0); PG8_BAR; PG8_MMA(1, 0, At, B0); PG8_MMA(1, 1, At, B1); PG8_BAR; PG8_SCHED;
            PG8_LDB(B0, 1, 0); PG8_LDB(B1, 1, 1); PG8_SCHED; PG8_LDA(At, 1, 0); PG8_STAGE(PG8_SA(0, 1), a2 + hstepA, voffA);
            PG8_WAIT_V(8); PG8_WAIT_L(0); PG8_BAR; PG8_MMA(0, 0, At, B0); PG8_MMA(0, 1, At, B1); PG8_BAR; PG8_SCHED;
            PG8_LDA(At, 1, 1); PG8_STAGE(PG8_SB(1, 0), b3, voffB); PG8_STAGE(PG8_SB(1, 1), b3 + hstepB, voffB); PG8_STAGE(PG8_SA(1, 0), a3, voffA);
            PG8_WAIT_V(8); PG8_WAIT_L(0); PG8_BAR; PG8_MMA(1, 0, At, B0); PG8_MMA(1, 1, At, B1); PG8_BAR; PG8_SCHED;
        }
        if (wr == 0) PG8_BAR;
        E(acc, cur, wr, wc, fr, fq);
        if (!has_next) break;
#pragma unroll
        for (int a = 0; a < 2; ++a)
#pragma unroll
            for (int b = 0; b < 2; ++b)
#pragma unroll
                for (int m = 0; m < 4; ++m)
#pragma unroll
                    for (int n = 0; n < 2; ++n) acc[a][b][m][n] = (f32x4){0.f, 0.f, 0.f, 0.f};
        cur = nxt; cA = nA; cB = nB; ++ui;
        if (wr == 1) PG8_BAR;
    }
    PG8_WAIT_V(0);
    PG8_BAR;
#undef PG8_SA
#undef PG8_SB
#undef PG8_STAGE
#undef PG8_LDA
#undef PG8_LDB
#undef PG8_MMA
#undef PG8_WAIT_V
#undef PG8_WAIT_L
#undef PG8_BAR
#undef PG8_SCHED
}
}

struct MatDesc { const float* src; int ldw, K, N; bf16_t* dst; int ldt; const float* ks; const float* ns; };

__device__ __forceinline__ void transpose_item(const MatDesc& d, LAS float* scr, int item, int lane) {
    const int nblk = d.N / 32, kb = item / nblk, nb = item % nblk, k0 = 64 * kb, n0 = 32 * nb;
    const int n4 = lane & 7, rr = lane >> 3;
    f32x4 nsv = (f32x4){1.f, 1.f, 1.f, 1.f};
    if (d.ns) nsv = *(const f32x4*)(d.ns + n0 + 4 * n4);
    f32x4 v[8];
#pragma unroll
    for (int j = 0; j < 8; ++j) v[j] = *(const f32x4*)(d.src + (size_t)(k0 + rr + 8 * j) * d.ldw + n0 + 4 * n4);
#pragma unroll
    for (int j = 0; j < 8; ++j) { const int kk = rr + 8 * j; f32x4 w = v[j] * nsv; if (d.ks) w = w * d.ks[k0 + kk];
        scr[kk * 33 + 4 * n4 + 0] = w[0]; scr[kk * 33 + 4 * n4 + 1] = w[1]; scr[kk * 33 + 4 * n4 + 2] = w[2]; scr[kk * 33 + 4 * n4 + 3] = w[3]; }
    asm volatile("s_waitcnt lgkmcnt(0)" ::: "memory");
    const int c = lane & 7;
#pragma unroll
    for (int j = 0; j < 4; ++j) { const int n = (lane >> 3) + 8 * j; const LAS float* s = scr + (8 * c) * 33 + n;
        u32x4 o; o.x = cvt_pk_bf16(s[0 * 33], s[1 * 33]); o.y = cvt_pk_bf16(s[2 * 33], s[3 * 33]); o.z = cvt_pk_bf16(s[4 * 33], s[5 * 33]); o.w = cvt_pk_bf16(s[6 * 33], s[7 * 33]);
        *(u32x4*)(d.dst + (size_t)(n0 + n) * d.ldt + k0 + 8 * c) = o; }
    asm volatile("s_waitcnt lgkmcnt(0)" ::: "memory");
}

enum { I_X = 0, I_MEM, I_G_MIX, I_G_MEM, I_G_MEMKV, I_G_FFN, I_G_FINAL, I_POOL_W, I_POOL_SCALE, I_SGU_WIN, I_SGU_LNG, I_SGU_LNB, I_SGU_WS, I_SGU_BS, I_SGU_WOUT, I_WQ, I_WKV, I_WO, I_W1, I_W2 };

__device__ __forceinline__ MatDesc get_mat(const Params& P, int id) {
    MatDesc d; d.ks = nullptr; d.ns = nullptr;
    unsigned char* ws = P.ws;
    if (id < 24) {
        const int L = id / 6, t = id % 6;
        if (t == 0)      { d.src = P.in[I_WQ] + (size_t)L * D * D; d.ldw = D; d.K = D; d.N = D; d.dst = (bf16_t*)(ws + WS_WQ) + (size_t)L * D * D; d.ldt = D; d.ks = P.in[I_G_MEM] + L * D; }
        else if (t == 1) { d.src = P.in[I_WKV] + (size_t)L * D * 2 * D; d.ldw = 2 * D; d.K = D; d.N = D; d.dst = (bf16_t*)(ws + WS_WK) + (size_t)L * D * D; d.ldt = D; d.ks = P.in[I_G_MEMKV] + L * D; }
        else if (t == 2) { d.src = P.in[I_WKV] + (size_t)L * D * 2 * D + D; d.ldw = 2 * D; d.K = D; d.N = D; d.dst = (bf16_t*)(ws + WS_WV) + (size_t)L * D * D; d.ldt = D; d.ks = P.in[I_G_MEMKV] + L * D; }
        else if (t == 3) { d.src = P.in[I_WO] + (size_t)L * D * D; d.ldw = D; d.K = D; d.N = D; d.dst = (bf16_t*)(ws + WS_WO) + (size_t)L * D * D; d.ldt = D; }
        else if (t == 4) { d.src = P.in[I_W1] + (size_t)L * D * FF; d.ldw = FF; d.K = D; d.N = FF; d.dst = (bf16_t*)(ws + WS_W1) + (size_t)L * D * FF; d.ldt = D; d.ks = P.in[I_G_FFN] + L * D; }
        else             { d.src = P.in[I_W2] + (size_t)L * D * FF; d.ldw = D; d.K = FF; d.N = D; d.dst = (bf16_t*)(ws + WS_W2) + (size_t)L * D * FF; d.ldt = FF; }
    } else if (id < 28) {
        const int j = (id - 24) >> 1, t = (id - 24) & 1;
        if (t == 0) { d.src = P.in[I_SGU_WIN] + (size_t)j * D * 2 * D; d.ldw = 2 * D; d.K = D; d.N = 2 * D; d.dst = (bf16_t*)(ws + WS_WIN) + (size_t)j * D * 2 * D; d.ldt = D; d.ks = P.in[I_G_MIX] + (2 * j + 1) * D; }
        else        { d.src = P.in[I_SGU_WOUT] + (size_t)j * D * D; d.ldw = D; d.K = D; d.N = D; d.dst = (bf16_t*)(ws + WS_WOUT) + (size_t)j * D * D; d.ldt = D; }
    } else {
        const int jg = id - 28, j = jg >> 2, g = jg & 3;
        d.src = P.in[I_POOL_W] + (size_t)jg * 256 * 256; d.ldw = 256; d.K = 256; d.N = 256; d.dst = (bf16_t*)(ws + WS_PW) + (size_t)jg * 256 * 256; d.ldt = 256;
        d.ks = P.in[I_G_MIX] + (2 * j) * D + g * 256; d.ns = P.in[I_POOL_SCALE] + j * D + g * 256;
    }
    return d;
}
__device__ __forceinline__ int mat_items(int id) {
    if (id < 24) { const int t = id % 6; return (t == 0) ? 0 : ((t >= 4) ? 2048 : 512); }
    if (id < 28) return ((id - 24) & 1) ? 512 : 1024;
    return 32;
}

__device__ __forceinline__ void prologue_phase(const Params& P, LAS unsigned char* lds, int G) {
    int tid_ = tid_now(); asm volatile("" : "+v"(tid_));
    const int tid = tid_, lane = tid & 63, wave = __builtin_amdgcn_readfirstlane(tid >> 6);
    LAS float* scr = (LAS float*)(lds + wave * 16384);
    const int gw = blockIdx.x * 8 + wave, NGW = G * 8;
    constexpr int NITEMS = 4 * (3 * 512 + 2 * 2048) + 2 * (1024 + 512) + 8 * 32;
    for (int it = gw; it < NITEMS; it += NGW) {
        int r = it, id = 0;
        for (; id < 36; ++id) { const int n = mat_items(id); if (r < n) break; r -= n; }
        const MatDesc d = get_mat(P, id);
        transpose_item(d, scr, r, lane);
    }
    { const float* wq = P.in[I_WQ]; const float* gq = P.in[I_G_MEM]; bf16_t* wqb = (bf16_t*)(P.ws + WS_WQ);
      for (int r = gw; r < DEPTH * D; r += NGW) { const float gk = gq[r]; const f32x4* xr = (const f32x4*)(wq + (size_t)r * D) + lane; u32x2* o = (u32x2*)(wqb + (size_t)r * D) + lane;
#pragma unroll
        for (int j = 0; j < 4; ++j) { const f32x4 v = xr[64 * j] * gk; u32x2 w; w.x = cvt_pk_bf16(v[0], v[1]); w.y = cvt_pk_bf16(v[2], v[3]); o[64 * j] = w; } } }
    const float* mem = P.in[I_MEM]; bf16_t* memb = (bf16_t*)(P.ws + WS_MEMB); float* rstd_mem = (float*)(P.ws + WS_RSTDMEM);
    for (int r = gw; r < MR; r += NGW) {
        const f32x4* xr = (const f32x4*)(mem + (size_t)r * D) + lane; f32x4 v[4]; float s = 0.f;
#pragma unroll
        for (int j = 0; j < 4; ++j) { v[j] = xr[64 * j]; s += (v[j][0] * v[j][0] + v[j][1] * v[j][1]) + (v[j][2] * v[j][2] + v[j][3] * v[j][3]); }
        s = wave_sum(s, lane);
        if (lane == 0) rstd_mem[r] = 1.0f / sqrtf(s * (1.0f / D) + EPS);
        u32x2* o = (u32x2*)(memb + (size_t)r * D) + lane;
#pragma unroll
        for (int j = 0; j < 4; ++j) { u32x2 w; w.x = cvt_pk_bf16(v[j][0], v[j][1]); w.y = cvt_pk_bf16(v[j][2], v[j][3]); o[64 * j] = w; }
    }
    const float* x = P.in[I_X]; float* ssq0 = (float*)(P.ws + WS_SSQ0);
    for (int r = gw; r < M; r += 2 * NGW) {
        const int r1 = (r + NGW < M) ? r + NGW : r;
        f32x4 va[4], vb[4];
#pragma unroll
        for (int j = 0; j < 4; ++j) { va[j] = ((const f32x4*)(x + (size_t)r * D) + lane)[64 * j]; vb[j] = ((const f32x4*)(x + (size_t)r1 * D) + lane)[64 * j]; }
        float s = 0.f, t = 0.f;
#pragma unroll
        for (int j = 0; j < 4; ++j) { s += (va[j][0] * va[j][0] + va[j][1] * va[j][1]) + (va[j][2] * va[j][2] + va[j][3] * va[j][3]); t += (vb[j][0] * vb[j][0] + vb[j][1] * vb[j][1]) + (vb[j][2] * vb[j][2] + vb[j][3] * vb[j][3]); }
        s = wave_sum(s, lane); t = wave_sum(t, lane);
        if (lane < 16) { ssq0[(size_t)r * 16 + lane] = (lane == 0) ? s : 0.f; if (r1 != r) ssq0[(size_t)r1 * 16 + lane] = (lane == 0) ? t : 0.f; }
    }
}

template <int W>
__device__ __forceinline__ void pool_block(const f32x2 (&prev)[16], const f32x2 (&cur)[16], bool seq_start, bf16_t* outp  ) {
#pragma unroll
    for (int i = 0; i < 16; ++i) {
        f32x2 s = cur[i];
#pragma unroll
        for (int j = 1; j < W; ++j) { s += (i - j >= 0) ? cur[(i - j) & 15] : prev[(16 + i - j) & 15]; }
        float inv = 1.0f / (float)W;
        if (i < W - 1 && seq_start) inv = 1.0f / (float)(i + 1);
        const f32x2 o = s * inv - cur[i];
        *(unsigned*)(outp + (size_t)i * D) = cvt_pk_bf16(o[0], o[1]);
    }
}
template <bool F32IN> __device__ __forceinline__ f32x2 pool_ld(const void* x, size_t idx) {
    if (F32IN) return *(const f32x2*)((const float*)x + idx);
    const unsigned r = *(const unsigned*)((const bf16_t*)x + idx); return (f32x2){__uint_as_float(r << 16), __uint_as_float(r & 0xffff0000u)};
}
template <bool F32IN>
__device__ __forceinline__ void pool_a_phase(LAS unsigned char* lds, const void* x, const float* ssq, bf16_t* PA, int G) {
    LAS float* rs = (LAS float*)lds;
    int tid_ = tid_now(); asm volatile("" : "+v"(tid_));
    const int tid = tid_, ch = 2 * tid, group = __builtin_amdgcn_readfirstlane(tid >> 7);
    for (int chunk = blockIdx.x; chunk < M / 64; chunk += G) {
        const int t0 = chunk * 64; const bool sstart = (t0 & (SEQ - 1)) == 0;
        __syncthreads();
        if (tid < 80) {
            float r = 0.f;
            if (!(sstart && tid < 16)) { const f32x4* p = (const f32x4*)(ssq + (size_t)(t0 - 16 + tid) * 16); const f32x4 a = p[0], b = p[1], c = p[2], d = p[3];
                const float s = (((a[0] + a[1]) + (a[2] + a[3])) + ((b[0] + b[1]) + (b[2] + b[3]))) + (((c[0] + c[1]) + (c[2] + c[3])) + ((d[0] + d[1]) + (d[2] + d[3])));
                r = 1.0f / sqrtf(s * (1.0f / D) + EPS); }
            rs[tid] = r;
        }
        __syncthreads();
        f32x2 prev[16], cur[16];
        if (sstart) {
#pragma unroll
            for (int i = 0; i < 16; ++i) prev[i] = (f32x2){0.f, 0.f};
        } else {
#pragma unroll
            for (int i = 0; i < 16; ++i) prev[i] = pool_ld<F32IN>(x, (size_t)(t0 - 16 + i) * D + ch) * rs[i];
        }
        for (int blk = 0; blk < 4; ++blk) {
#pragma unroll
            for (int i = 0; i < 16; ++i) cur[i] = pool_ld<F32IN>(x, (size_t)(t0 + blk * 16 + i) * D + ch) * rs[16 + blk * 16 + i];
            bf16_t* outp = PA + (size_t)(t0 + blk * 16) * D + ch;
            const bool ss = sstart && blk == 0;
            if (group == 0) pool_block<2>(prev, cur, ss, outp);
            else if (group == 1) pool_block<4>(prev, cur, ss, outp);
            else if (group == 2) pool_block<8>(prev, cur, ss, outp);
            else pool_block<16>(prev, cur, ss, outp);
#pragma unroll
            for (int i = 0; i < 16; ++i) prev[i] = cur[i];
        }
    }
}

__device__ __forceinline__ void sgu_spatial_phase(LAS unsigned char* lds, const bf16_t* Z, const float* vstat, const float* wsf, const float* bsf, const float* lng, const float* lnb, bf16_t* T1, int G) {
    constexpr int APITCH = 272;
    LAS unsigned char* Aimg = lds;
    LAS unsigned char* VT = lds + 34816;
    LAS float* mu = (LAS float*)(lds + 34816 + 67584); LAS float* rsd = mu + 128;
    int tid_ = tid_now(); asm volatile("" : "+v"(tid_));
    const int tid = tid_, lane = tid & 63, wave = __builtin_amdgcn_readfirstlane(tid >> 6);
    const int g = blockIdx.x & 3;
    bool first = true;
    for (int u = blockIdx.x; u < (M / 128) * 4; u += G) {
        const int nb = u >> 2; const size_t rowb = (size_t)nb * 128;
        __syncthreads();
        if (tid < 128) {
            const f32x4* p = (const f32x4*)(vstat + (rowb + tid) * 32); float s1 = 0.f, s2 = 0.f;
#pragma unroll
            for (int i = 0; i < 4; ++i) { const f32x4 a = p[i], b = p[4 + i]; s1 += (a[0] + a[1]) + (a[2] + a[3]); s2 += (b[0] + b[1]) + (b[2] + b[3]); }
            const float m = s1 * (1.0f / D), var = s2 * (1.0f / D) - m * m;
            mu[tid] = m; rsd[tid] = 1.0f / sqrtf(fmaxf(var, 0.f) + EPS);
        }
        if (first) {
            first = false;
            const float* wg = wsf + (size_t)g * 128 * 128;
#pragma unroll
            for (int i = 0; i < 8; ++i) { const int e = (tid + 512 * i) * 4, p = e >> 7, q = e & 127; f32x4 v = *(const f32x4*)(wg + e);
                if ((p >> 6) < (q >> 6)) v = (f32x4){0.f, 0.f, 0.f, 0.f};
                u32x2 w; w.x = cvt_pk_bf16(v[0], v[1]); w.y = cvt_pk_bf16(v[2], v[3]); *(LAS u32x2*)(Aimg + p * APITCH + q * 2) = w; }
        }
        __syncthreads();
        {
            const int cp = tid & 31, c0 = 8 * cp; float gg[8], bb[8];
#pragma unroll
            for (int e = 0; e < 8; ++e) { gg[e] = lng[g * 256 + c0 + e]; bb[e] = lnb[g * 256 + c0 + e]; }
#pragma unroll 2
            for (int i = 0; i < 8; ++i) {
                const int q = (tid >> 5) + 16 * i;
                const u32x4 raw = *(const u32x4*)(Z + (rowb + q) * 2048 + 1024 + g * 256 + c0);
                const float m = mu[q], r = rsd[q];
                const unsigned wv[4] = {raw.x, raw.y, raw.z, raw.w};
#pragma unroll
                for (int e = 0; e < 8; ++e) {
                    const float v = __uint_as_float((e & 1) ? (wv[e >> 1] & 0xffff0000u) : (wv[e >> 1] << 16));
                    const float y = (v - m) * r * gg[e] + bb[e];
                    const unsigned pk = cvt_pk_bf16(y, y);
                    const int c = c0 + e, chunk = (q >> 3) ^ ((c >> 3) & 15) ^ (c & 7);
                    *(LAS unsigned short*)(VT + c * 256 + chunk * 16 + (q & 7) * 2) = (unsigned short)pk;
                }
            }
        }
        __syncthreads();
        f32x4 acc[2][8];
#pragma unroll
        for (int ct = 0; ct < 2; ++ct)
#pragma unroll
            for (int pt = 0; pt < 8; ++pt) acc[ct][pt] = (f32x4){0.f, 0.f, 0.f, 0.f};
        const int l16 = lane & 15, l4 = lane >> 4;
#pragma unroll
        for (int ks = 0; ks < 4; ++ks) {
            bf16x8 af[2], bfr[8];
#pragma unroll
            for (int ct = 0; ct < 2; ++ct) { const int c = wave * 32 + ct * 16 + l16, chunk = (4 * ks + l4) ^ ((c >> 3) & 15) ^ (c & 7); af[ct] = *(const LAS bf16x8*)(VT + c * 256 + chunk * 16); }
#pragma unroll
            for (int pt = 0; pt < 8; ++pt) bfr[pt] = *(const LAS bf16x8*)(Aimg + (pt * 16 + l16) * APITCH + (32 * ks + 8 * l4) * 2);
#pragma unroll
            for (int ct = 0; ct < 2; ++ct)
#pragma unroll
                for (int pt = 0; pt < 8; ++pt) acc[ct][pt] = __builtin_amdgcn_mfma_f32_16x16x32_bf16(af[ct], bfr[pt], acc[ct][pt], 0, 0, 0);
        }
        u32x4 uu[8];
#pragma unroll
        for (int i = 0; i < 8; ++i) { const int piece = tid + 512 * i; uu[i] = *(const u32x4*)(Z + (rowb + (piece >> 5)) * 2048 + g * 256 + (piece & 31) * 8); }
        __syncthreads();
        LAS unsigned char* SS = VT;
#pragma unroll
        for (int pt = 0; pt < 8; ++pt) {
            const int p = pt * 16 + l16; const float bsv = bsf[g * 128 + p];
#pragma unroll
            for (int ct = 0; ct < 2; ++ct) {
                const f32x4 s = acc[ct][pt] + bsv;
                u32x2 w; w.x = cvt_pk_bf16(s[0], s[1]); w.y = cvt_pk_bf16(s[2], s[3]);
                *(LAS u32x2*)(SS + p * 528 + (wave * 32 + ct * 16 + 4 * l4) * 2) = w;
            }
        }
        __syncthreads();
#pragma unroll
        for (int i = 0; i < 8; ++i) {
            const int piece = tid + 512 * i, p = piece >> 5, part = piece & 31;
            const u32x4 sv = *(const LAS u32x4*)(SS + p * 528 + part * 16);
            const unsigned ua[4] = {uu[i].x, uu[i].y, uu[i].z, uu[i].w}, sa[4] = {sv.x, sv.y, sv.z, sv.w}; unsigned r[4];
#pragma unroll
            for (int e = 0; e < 4; ++e) r[e] = cvt_pk_bf16(__uint_as_float(ua[e] << 16) * __uint_as_float(sa[e] << 16), __uint_as_float(ua[e] & 0xffff0000u) * __uint_as_float(sa[e] & 0xffff0000u));
            u32x4 w; w.x = r[0]; w.y = r[1]; w.z = r[2]; w.w = r[3];
            __builtin_nontemporal_store(w, (u32x4*)(T1 + (rowb + p) * D + g * 256 + part * 8));
        }
    }
}

__device__ __forceinline__ void final_norm_phase(const bf16_t* xb, float* out, const float* gain, int G) {
    int tid_ = tid_now(); asm volatile("" : "+v"(tid_));
    const int tid = tid_, lane = tid & 63, wave = tid >> 6, gw = blockIdx.x * 8 + wave, NGW = G * 8;
    f32x4 gv[4];
#pragma unroll
    for (int j = 0; j < 2; ++j) { gv[2 * j] = *(const f32x4*)(gain + 512 * j + 8 * lane); gv[2 * j + 1] = *(const f32x4*)(gain + 512 * j + 8 * lane + 4); }
    for (int r = gw; r < M; r += NGW) {
        f32x4 v[4]; float s = 0.f;
#pragma unroll
        for (int j = 0; j < 2; ++j) { const u32x4 q = *(const u32x4*)(xb + (size_t)r * D + 512 * j + 8 * lane);
            v[2 * j] = (f32x4){__uint_as_float(q.x << 16), __uint_as_float(q.x & 0xffff0000u), __uint_as_float(q.y << 16), __uint_as_float(q.y & 0xffff0000u)};
            v[2 * j + 1] = (f32x4){__uint_as_float(q.z << 16), __uint_as_float(q.z & 0xffff0000u), __uint_as_float(q.w << 16), __uint_as_float(q.w & 0xffff0000u)}; }
#pragma unroll
        for (int j = 0; j < 4; ++j) s += (v[j][0] * v[j][0] + v[j][1] * v[j][1]) + (v[j][2] * v[j][2] + v[j][3] * v[j][3]);
        s = wave_sum(s, lane);
        const float rs = 1.0f / sqrtf(s * (1.0f / D) + EPS);
#pragma unroll
        for (int j = 0; j < 2; ++j) { *(f32x4*)(out + (size_t)r * D + 512 * j + 8 * lane) = v[2 * j] * rs * gv[2 * j]; *(f32x4*)(out + (size_t)r * D + 512 * j + 8 * lane + 4) = v[2 * j + 1] * rs * gv[2 * j + 1]; }
    }
}

#define XB_TMO      128
#define XB_XCNT(j)  (256  + 64 * (j))
#define XB_XSUB(j)  (1280 + 64 * (j))
#define XB_XGEN(j)  (2304 + 64 * (j))
#define XB_TOP      3328
#define XB_TOPGEN   3392
#define XCD_BAR_WORDS 3456
#define XB_SPIN_CAP (1u << 20)
__device__ __forceinline__ unsigned xb_ld(unsigned* p)              { return __hip_atomic_load(p, __ATOMIC_RELAXED, __HIP_MEMORY_SCOPE_AGENT); }
__device__ __forceinline__ unsigned xb_add(unsigned* p, unsigned v) { return __hip_atomic_fetch_add(p, v, __ATOMIC_RELAXED, __HIP_MEMORY_SCOPE_AGENT); }
__device__ __forceinline__ unsigned xb_xcc_id() { return (unsigned)__builtin_amdgcn_s_getreg((3 << 11) | 20) & 0xFu; }
#define XB_SPIN(cond, bar) do { unsigned _sp = 0; while (cond) { __builtin_amdgcn_s_sleep(1); \
    if ((++_sp & 255u) == 0u) { if (xb_ld(&(bar)[XB_TMO])) break; if (_sp > XB_SPIN_CAP) { atomicAdd(&(bar)[XB_TMO], 1u); break; } } } } while (0)
struct XcdBarrier { unsigned* bar; unsigned x; volatile LAS unsigned* st; };
__device__ __forceinline__ XcdBarrier xcd_barrier_post(unsigned* bar, volatile LAS unsigned* st) {
    XcdBarrier b; b.bar = bar; b.x = xb_xcc_id(); b.st = st;
    if (tid_now() == 0) (void)xb_add(&bar[XB_XCNT(b.x)], 1u);
    return b;
}
__device__ __forceinline__ void xcd_barrier_complete(unsigned* bar, unsigned x, unsigned& nloc, unsigned& nx) {
    const unsigned G = gridDim.x * gridDim.y * gridDim.z;
    unsigned sum, cnt, mine, sp = 0u;
    for (;;) {
        sum = 0u; cnt = 0u; mine = 0u;
#pragma unroll
        for (unsigned j = 0; j < 16; ++j) { const unsigned c = xb_ld(&bar[XB_XCNT(j)]); sum += c; cnt += (c > 0u) ? 1u : 0u; mine = (j == x) ? c : mine; }
        if (sum == G) break;
        __builtin_amdgcn_s_sleep(1);
        if ((++sp & 255u) == 0u) { if (xb_ld(&bar[XB_TMO])) break; if (sp > XB_SPIN_CAP) { atomicAdd(&bar[XB_TMO], 1u); break; } }
    }
    nloc = mine > 0u ? mine : 1u; nx = cnt > 0u ? cnt : 1u;
}
__device__ __forceinline__ void xcd_barrier(const XcdBarrier& b) {
    asm volatile("s_waitcnt vmcnt(0)" ::: "memory");
    __syncthreads();
    if (tid_now() == 0) {
        unsigned* bar = b.bar;
        __builtin_amdgcn_s_waitcnt(0);
        unsigned nloc = b.st[0], nx = b.st[1];
        if (nloc == 0u) { xcd_barrier_complete(bar, b.x, nloc, nx); b.st[0] = nloc; b.st[1] = nx; }
        const unsigned old = xb_add(&bar[XB_XSUB(b.x)], 1u);
        const unsigned gen = old / nloc;
        if (old + 1u == (gen + 1u) * nloc) {
            __builtin_amdgcn_fence(__ATOMIC_RELEASE, "agent");
            asm volatile("s_waitcnt vmcnt(0)" ::: "memory");
            const unsigned og = xb_add(&bar[XB_TOP], 1u);
            const unsigned tg = og / nx;
            if (og + 1u == (tg + 1u) * nx) xb_add(&bar[XB_TOPGEN], 1u);
            else XB_SPIN(xb_ld(&bar[XB_TOPGEN]) == tg, bar);
            __builtin_amdgcn_fence(__ATOMIC_ACQUIRE, "agent");
            xb_add(&bar[XB_XGEN(b.x)], 1u);
            asm volatile("s_waitcnt vmcnt(0)" ::: "memory");
        } else {
            XB_SPIN(xb_ld(&bar[XB_XGEN(b.x)]) == gen, bar);
            __builtin_amdgcn_fence(__ATOMIC_ACQUIRE, "agent");
            asm volatile("s_waitcnt vmcnt(0)" ::: "memory");
        }
    }
    __syncthreads();
}

constexpr int NPHASES = 35;
__host__ __device__ inline bool phase_empty(int ph) { if (ph < 2 || ph >= 34) return false; const int L = (ph - 2) >> 3, k = (ph - 2) & 7; return (k == 2 && (L & 1) == 0) || k == 4; }

__global__ void __launch_bounds__(512, 2) fwd_megakernel(Params P) {
    extern __shared__ __attribute__((aligned(16))) unsigned char lds_raw[];
    LAS unsigned char* lds = (LAS unsigned char*)lds_raw;
    cg::grid_group grid = cg::this_grid();
    const int G = gridDim.x;
    typedef const Params __attribute__((address_space(4))) CParams;
    volatile LAS unsigned* MISC = (volatile LAS unsigned*)(lds + 131072 + 320);
    { const int t0 = threadIdx.x;
      if ((t0 & 63) == 0) ((volatile LAS int*)(lds + WIDTAB_OFF))[(unsigned)__builtin_amdgcn_s_getreg((5 << 11) | 4) & 63u] = t0 >> 6;
      if (t0 < 32) MISC[t0] = 0u; }
    __syncthreads();
    const int ph_lo = P.ph_lo, ph_hi = P.ph_hi;
    XcdBarrier bar; bar.bar = (unsigned*)(P.ws + WS_CTL); bar.x = 0; bar.st = MISC + 8;
    if (ph_hi - ph_lo > 1) bar = xcd_barrier_post((unsigned*)(P.ws + WS_CTL), MISC + 8);

    for (int ph = ph_lo; ph < ph_hi; ++ph) {
        const CParams* KP = (const CParams*)__builtin_amdgcn_kernarg_segment_ptr(); asm volatile("" : "+s"(KP));
        unsigned char* ws = KP->ws;
        bf16_t* T1 = (bf16_t*)(ws + WS_T1); bf16_t* ZB = (bf16_t*)(ws + WS_Z); bf16_t* HB = (bf16_t*)(ws + WS_H);
        bf16_t* XB = (bf16_t*)(ws + WS_XB); bf16_t* KVALL = (bf16_t*)(ws + WS_KVALL); bf16_t* MEMB = (bf16_t*)(ws + WS_MEMB); bf16_t* MQ = (bf16_t*)(ws + WS_MQ); bf16_t* VWO = (bf16_t*)(ws + WS_VWO);
        float* SSQ[2] = {(float*)(ws + WS_SSQ0), (float*)(ws + WS_SSQ1)};
        float* VSTAT = (float*)(ws + WS_VSTAT); float* RSTDMEM = (float*)(ws + WS_RSTDMEM);
        if (phase_empty(ph)) continue;
        if (ph == 0) {
            { Params Pl; for (int i = 0; i < 20; ++i) Pl.in[i] = KP->in[i]; Pl.out = KP->out; Pl.ws = ws; Pl.ph_lo = 0; Pl.ph_hi = 0; prologue_phase(Pl, lds, G); }
        } else if (ph == 1) {
            pg8::StaticOrder S; S.init(MR, 8192, G, (int)blockIdx.x);
            pg8::Gemm g{MEMB, (const bf16_t*)(ws + WS_WK), MR, 8192, D, D, D}; pg8::EpiAct<4> E{KVALL, 8192, nullptr, 1.f, RSTDMEM, nullptr}; pg8::gemm_phase<0>(lds, g, S, E);
        } else if (ph == 34) {
            final_norm_phase(XB, KP->out, KP->in[I_G_FINAL], G);
        } else {
            const int L = (ph - 2) >> 3, k = (ph - 2) & 7, j = L >> 1; const bool odd = (L & 1) != 0;
            if (k == 0) {
                const float* ssq_r = SSQ[(3 * L) & 1];
                if (!odd) { if (L == 0) pool_a_phase<true>(lds, KP->in[I_X], ssq_r, T1, G); else pool_a_phase<false>(lds, XB, ssq_r, T1, G); }
                else { pg8::Gemm g{XB, (const bf16_t*)(ws + WS_WIN) + (size_t)j * D * 2 * D, M, 2 * D, D, D, D}; pg8::StaticOrder S; S.init(M, 2 * D, G, (int)blockIdx.x);
                    LAS float* tab = (LAS float*)(lds + pg8::RSTD_TAB_OFF); pg8::fill_rstd_table(tab, ssq_r, S);
                    pg8::EpiAct<2> E{ZB, 2 * D, ssq_r, 1.f, nullptr, VSTAT, tab}; pg8::gemm_phase<0>(lds, g, S, E); }
                __syncthreads();
                { pg8::Gemm g{KVALL + L * 1024, (const bf16_t*)(ws + WS_WQ) + (size_t)L * D * D, 4 * MR, D, 256, 8192, D}; pg8::StaticOrder S; S.init(4 * MR, D, G, (int)blockIdx.x);
                  pg8::EpiAct<5> E{MQ, D, nullptr, QSCALE, nullptr, nullptr}; pg8::gemm_phase<3>(lds, g, S, E); }
                { pg8::Gemm g{(const bf16_t*)(ws + WS_WO) + (size_t)L * D * D, KVALL + 4096 + L * 1024, D, 4 * MR, 256, D, 8192}; pg8::StaticOrder S; S.init(D, 4 * MR, G, (int)blockIdx.x);
                  pg8::EpiAct<6> E{VWO, D, nullptr, 1.f, nullptr, nullptr}; pg8::gemm_phase<4>(lds, g, S, E); }
            } else if (k == 1 && odd) {
                sgu_spatial_phase(lds, ZB, VSTAT, KP->in[I_SGU_WS] + (size_t)j * 4 * 128 * 128, KP->in[I_SGU_BS] + j * 512, KP->in[I_SGU_LNG] + j * D, KP->in[I_SGU_LNB] + j * D, T1, G);
            } else if (k == 3) {
                pg8::Gemm g{XB, MQ, M, D, D, D, D}; pg8::StaticOrder S; S.init(M, D, G, (int)blockIdx.x);
                LAS float* tab = (LAS float*)(lds + pg8::RSTD_TAB_OFF); pg8::fill_rstd_table(tab, SSQ[(3 * L + 1) & 1], S);
                pg8::EpiSoftmax E{T1, SSQ[(3 * L + 1) & 1], (LAS float*)(lds + 131072 + 1024), tab}; pg8::gemm_phase<2>(lds, g, S, E);
            } else if (k == 6) {
                pg8::Gemm g{XB, (const bf16_t*)(ws + WS_W1) + (size_t)L * D * FF, M, FF, D, D, D}; pg8::StaticOrder S; S.init(M, FF, G, (int)blockIdx.x);
                LAS float* tab = (LAS float*)(lds + pg8::RSTD_TAB_OFF); pg8::fill_rstd_table(tab, SSQ[(3 * L + 2) & 1], S);
                pg8::EpiAct<1> E{HB, FF, SSQ[(3 * L + 2) & 1], 1.f, nullptr, nullptr, tab}; pg8::gemm_phase<0>(lds, g, S, E);
            } else {
                pg8::StaticOrder S; S.init(M, D, G, (int)blockIdx.x);
                if (k == 1) {
                    pg8::Gemm g{T1, (const bf16_t*)(ws + WS_PW) + (size_t)j * 4 * 256 * 256, M, D, 256, D, 256};
                    if (L == 0) { pg8::EpiResid<true> E{KP->in[I_X], XB, SSQ[(3 * L + 1) & 1]}; pg8::gemm_phase<1>(lds, g, S, E); }
                    else { pg8::EpiResid<false> E{nullptr, XB, SSQ[(3 * L + 1) & 1]}; pg8::gemm_phase<1>(lds, g, S, E); }
                } else if (k == 5) {
                    pg8::Gemm g{T1, VWO, M, D, D, D, D}; pg8::EpiResid<false> E{nullptr, XB, SSQ[(3 * L + 2) & 1]}; pg8::gemm_phase<2>(lds, g, S, E);
                } else {
                    pg8::Gemm g; int upd;
                    if (k == 2) { g = pg8::Gemm{T1, (const bf16_t*)(ws + WS_WOUT) + (size_t)j * D * D, M, D, D, D, D}; upd = 3 * L; }
                    else        { g = pg8::Gemm{HB, (const bf16_t*)(ws + WS_W2) + (size_t)L * D * FF, M, D, FF, 64, FF}; upd = 3 * L + 2; }
                    pg8::EpiResid<false> E{nullptr, XB, SSQ[(upd + 1) & 1]};
                    if (k == 2) pg8::gemm_phase<0>(lds, g, S, E); else pg8::gemm_phase<5>(lds, g, S, E);
                }
            }
        }
        if (ph + 1 < ph_hi) { if (ph == 0) grid.sync(); else xcd_barrier(bar); }
    }
}

extern "C" void kernel_launch(void* const* d_in, const int* in_sizes, int n_in, void* d_out, int out_size, void* d_ws, size_t ws_size, hipStream_t stream) {
    static int grid = 0;
    if (grid == 0) {
        if (n_in != 20 || in_sizes[0] != M * D || out_size != M * D || ws_size < WS_END) { fprintf(stderr, "kernel_launch: unexpected shapes (n_in %d, in0 %d, out %d, ws %zu); nothing launched\n", n_in, n_in > 0 ? in_sizes[0] : -1, out_size, ws_size); grid = -1; return; }
        int dev = 0, cus = 0, per_cu = 0;
        if (hipGetDevice(&dev) != hipSuccess || hipDeviceGetAttribute(&cus, hipDeviceAttributeMultiprocessorCount, dev) != hipSuccess) { grid = -1; return; }
        if (hipFuncSetAttribute((const void*)fwd_megakernel, hipFuncAttributeMaxDynamicSharedMemorySize, LDS_BYTES) != hipSuccess) { fprintf(stderr, "kernel_launch: hipFuncSetAttribute failed\n"); grid = -1; return; }
        if (hipOccupancyMaxActiveBlocksPerMultiprocessor(&per_cu, (const void*)fwd_megakernel, 512, LDS_BYTES) != hipSuccess || per_cu < 1) { fprintf(stderr, "kernel_launch: occupancy query gave %d\n", per_cu); per_cu = 1; }
        (void)hipGetLastError();
        grid = cus * per_cu;
        if (grid > 256) grid = 256;
        grid &= ~7;
        if (grid < 8) { grid = -1; return; }
    }
    if (grid < 0) return;
    Params p{};
    for (int i = 0; i < 20; ++i) p.in[i] = (const float*)d_in[i];
    p.out = (float*)d_out; p.ws = (unsigned char*)d_ws;
#if MK_SINGLE
    p.ph_lo = 0; p.ph_hi = NPHASES;
    if (hipMemsetAsync((char*)d_ws + WS_CTL, 0, CTL_BYTES, stream) != hipSuccess) { fprintf(stderr, "kernel_launch: memset failed\n"); return; }
    void* args[] = {&p};
    hipError_t e = hipLaunchCooperativeKernel((const void*)fwd_megakernel, dim3(grid), dim3(512), args, LDS_BYTES, stream);
    if (e != hipSuccess) fprintf(stderr, "kernel_launch: cooperative launch failed: %s (grid %d)\n", hipGetErrorString(e), grid);
#else
    for (int ph = 0; ph < NPHASES; ++ph) {
        if (phase_empty(ph)) continue;
        p.ph_lo = ph; p.ph_hi = ph + 1;
        hipLaunchKernelGGL(fwd_megakernel, dim3(grid), dim3(512), LDS_BYTES, stream, p);
    }
#endif
}
```

```cpp
#include <hip/hip_runtime.h>
#include <hip/hip_cooperative_groups.h>
#include <cstdio>
#include <cstdint>
namespace cg = cooperative_groups;

#ifndef MK_SINGLE
#define MK_SINGLE 1
#endif

#define LAS __attribute__((address_space(3)))
typedef unsigned short bf16_t;
typedef short bf16x8 __attribute__((ext_vector_type(8)));
typedef float f32x4 __attribute__((ext_vector_type(4)));
typedef float f32x2 __attribute__((ext_vector_type(2)));
typedef float f32x16 __attribute__((ext_vector_type(16)));
typedef unsigned u32x4 __attribute__((ext_vector_type(4)));
typedef unsigned u32x2 __attribute__((ext_vector_type(2)));

constexpr int D = 1024, BATCH = 16, SEQ = 4096, DEPTH = 4, FF = 4096, NMEM = 256;
constexpr int M = BATCH * SEQ;
constexpr int MR = BATCH * NMEM;
constexpr float EPS = 1e-6f;
constexpr float QSCALE = 0.0625f * 1.4426950408889634f;

constexpr size_t MiB = 1u << 20;
constexpr size_t WS_H = 0, WS_T1 = 0, WS_O = 128 * MiB, WS_Z = 256 * MiB;
constexpr size_t WS_XB = 512 * MiB;
constexpr size_t WS_KVALL = 640 * MiB, WS_MEMB = 704 * MiB;
constexpr size_t WS_SSQ0 = 712 * MiB, WS_SSQ1 = 716 * MiB, WS_VSTAT = 720 * MiB, WS_RSTDMEM = 728 * MiB;
constexpr size_t WS_CTL = 730 * MiB, CTL_BYTES = 16384;
constexpr size_t WS_WQ = 736 * MiB, WS_WO = 744 * MiB, WS_W1 = 752 * MiB, WS_W2 = 784 * MiB, WS_WK = 816 * MiB, WS_WV = 824 * MiB;
constexpr size_t WS_WIN = 832 * MiB, WS_WOUT = 840 * MiB, WS_PW = 844 * MiB;
constexpr size_t WS_MQ = 848 * MiB, WS_VWO = 880 * MiB, WS_END = 912 * MiB;

constexpr int LDS_BYTES = 147456;

struct Params {
    const float* in[20];
    float* out;
    unsigned char* ws;
    int ph_lo, ph_hi;
};

extern __shared__ __attribute__((aligned(16))) unsigned char g_lds[];
constexpr int WIDTAB_OFF = 131072 + 512;
__device__ __forceinline__ int tid_now() {
    unsigned m = ~0u; asm volatile("" : "+s"(m));
    const int lane = (int)__builtin_amdgcn_mbcnt_hi(m, __builtin_amdgcn_mbcnt_lo(m, 0u));
    const unsigned hw = (unsigned)__builtin_amdgcn_s_getreg((5 << 11) | 4) & 63u;
    const int wid = __builtin_amdgcn_readfirstlane(((volatile LAS int*)((LAS unsigned char*)g_lds + WIDTAB_OFF))[hw]);
    return wid * 64 + lane;
}
__device__ __forceinline__ unsigned cvt_pk_bf16(float lo, float hi) { unsigned r; asm volatile("v_cvt_pk_bf16_f32 %0, %1, %2" : "=v"(r) : "v"(lo), "v"(hi)); return r; }
__device__ __forceinline__ float sx(float v, int o, int lane) { return __builtin_bit_cast(float, __builtin_amdgcn_ds_bpermute((lane ^ o) << 2, __builtin_bit_cast(int, v))); }
__device__ __forceinline__ float fq_sum(float s) {
    const unsigned u = __float_as_uint(s);
    const auto r = __builtin_amdgcn_permlane16_swap(u, u, false, false);
    const float t = __uint_as_float(r[0]) + __uint_as_float(r[1]);
    const unsigned v = __float_as_uint(t);
    const auto q = __builtin_amdgcn_permlane32_swap(v, v, false, false);
    return __uint_as_float(q[0]) + __uint_as_float(q[1]);
}
__device__ __forceinline__ float fq_max(float s) {
    const unsigned u = __float_as_uint(s);
    const auto r = __builtin_amdgcn_permlane16_swap(u, u, false, false);
    const float t = fmaxf(__uint_as_float(r[0]), __uint_as_float(r[1]));
    const unsigned v = __float_as_uint(t);
    const auto q = __builtin_amdgcn_permlane32_swap(v, v, false, false);
    return fmaxf(__uint_as_float(q[0]), __uint_as_float(q[1]));
}
__device__ __forceinline__ float wave_sum(float v, int lane) {
#pragma unroll
    for (int o = 1; o < 64; o <<= 1) v += sx(v, o, lane);
    return v;
}
__device__ __forceinline__ float gelu_tanh(float x) {
    const float y = 0.7978845608028654f * (x + 0.044715f * x * x * x);
    const float e = __builtin_amdgcn_exp2f(-2.0f * 1.4426950408889634f * y);
    return x * __builtin_amdgcn_rcpf(1.0f + e);
}

namespace pg8 {
constexpr int BM = 256, BK = 64, HALF = 128, HTB = HALF * BK * 2, STAGE_BYTES = 8 * HTB, NXCD = 8, WGM = 8;
__host__ __device__ __forceinline__ int lds_byte(int r, int c) { const int st = (r >> 4) * 2 + (c >> 5), rr = r & 15, cc = c & 31, ob = rr * 64 + cc * 2; return st * 1024 + (ob ^ (((ob >> 9) & 1) << 5)); }
__host__ __device__ __forceinline__ void stage_rc(int b, int& R, int& C) { const int st = b / 1024, sb = b % 1024, swz = sb ^ (((sb >> 9) & 1) << 5); R = (st >> 1) * 16 + swz / 64; C = (st & 1) * 32 + (swz % 64) / 2; }
__host__ __device__ __forceinline__ int perm32(int rho) { const int n = rho >> 4, i = rho & 15; return 8 * (i >> 2) + 4 * n + (i & 3); }

struct Unit { int pm, pn, pidx; };
struct Gemm { const bf16_t* A; const bf16_t* Bt; int M, N, K, lda, ldb; };
template <int KIND> __device__ __forceinline__ const char* unitA(const Gemm& g, int pm, int pn, size_t tstepA) {
    size_t off = (size_t)((KIND == 3) ? (pm & 15) : pm) * tstepA;
    if (KIND == 1) off += (size_t)pn * 512; if (KIND == 3) off += (size_t)(pm >> 4) * 512; if (KIND == 4) off += (size_t)(pn >> 4) * 512;
    return (const char*)g.A + off;
}
template <int KIND> __device__ __forceinline__ const char* unitB(const Gemm& g, int pm, int pn, size_t tstepB) {
    size_t off = (size_t)((KIND == 4) ? (pn & 15) : pn) * tstepB;
    if (KIND == 2) off += (size_t)(pm >> 4) * 2097152; if (KIND == 3) off += (size_t)(pm >> 4) * 512; if (KIND == 4) off += (size_t)(pn >> 4) * 512;
    return (const char*)g.Bt + off;
}

struct StaticOrder {
    int nM, nN, nwg, G, c;
    __device__ void init(int M_, int N_, int G_, int c_) { nM = M_ / BM; nN = N_ / BM; nwg = nM * nN; G = G_; c = c_; }
    __device__ bool next(int i, Unit& u) const {
        const long L = (long)i * G + c; if (L >= nwg) return false;
        int wgid = (int)L; { const int q = nwg / NXCD, r = nwg % NXCD, xcd = wgid % NXCD, off = wgid / NXCD; wgid = (xcd < r ? xcd * (q + 1) : r * (q + 1) + (xcd - r) * q) + off; }
        const int nig = WGM * nN, gid = wgid / nig, fm = gid * WGM, gsz = (nM - fm) < WGM ? (nM - fm) : WGM;
        u.pm = fm + ((wgid % nig) % gsz); u.pn = (wgid % nig) / gsz; return true;
    }
};

__device__ __forceinline__ float rstd_from_slots(const float* ssq, int row, int fq, int lane) {
    const f32x4 v = *(const f32x4*)(ssq + (size_t)row * 16 + fq * 4);
    float s = (v[0] + v[1]) + (v[2] + v[3]);
    s = fq_sum(s); (void)lane;
    return __builtin_amdgcn_rsqf(s * (1.0f / 1024.0f) + EPS);
}

constexpr int RSTD_TAB_OFF = 140288;
__device__ __forceinline__ void fill_rstd_table(LAS float* tab, const float* ssq, const StaticOrder& S) {
    int t = tid_now(); asm volatile("" : "+v"(t));
    Unit u; int d = 0, last = -1, p0 = -1, p1 = -1, p2 = -1, p3 = -1;
    for (int i = 0; S.next(i, u); ++i) if (u.pm != last) { if (d == 0) p0 = u.pm; else if (d == 1) p1 = u.pm; else if (d == 2) p2 = u.pm; else if (d == 3) p3 = u.pm; ++d; last = u.pm; }
#pragma unroll
    for (int k = 0; k < 2; ++k) {
        const int e = (t >> 8) + 2 * k, pm = (e == 0) ? p0 : (e == 1) ? p1 : (e == 2) ? p2 : p3;
        if (pm >= 0) { const f32x4* p = (const f32x4*)(ssq + (size_t)(pm * BM + (t & 255)) * 16); const f32x4 a = p[0], b = p[1], c = p[2], dd = p[3];
            const float s = (((a[0] + a[1]) + (a[2] + a[3])) + ((b[0] + b[1]) + (b[2] + b[3]))) + (((c[0] + c[1]) + (c[2] + c[3])) + ((dd[0] + dd[1]) + (dd[2] + dd[3])));
            tab[e * 256 + (t & 255)] = __builtin_amdgcn_rsqf(s * (1.0f / 1024.0f) + EPS); }
    }
    __syncthreads();
}
template <int MODE> struct EpiAct {
    bf16_t* O; int ldc; const float* ssq; float scale; const float* rvec; float* vstat; LAS float* tab;
    __device__ __forceinline__ void operator()(const f32x4 (&acc)[2][2][4][2], const Unit& u, int, int, int, int) const {
        int t_ = tid_now(); asm volatile("" : "+v"(t_));
        const int wid_ = __builtin_amdgcn_readfirstlane(t_ >> 6), wr = wid_ >> 2, wc = wid_ & 3, fr = t_ & 15, fq = (t_ & 63) >> 4;
        const int row0 = u.pm * BM + wr * 64 + fr, col0 = u.pn * BM + wc * 32 + 8 * fq;
        f32x4 cs[2][2];
        if (MODE == 3) {
#pragma unroll
            for (int bj = 0; bj < 2; ++bj) { cs[bj][0] = *(const f32x4*)(rvec + col0 + bj * HALF); cs[bj][1] = *(const f32x4*)(rvec + col0 + bj * HALF + 4); }
        }
#pragma unroll
        for (int ai = 0; ai < 2; ++ai)
#pragma unroll
            for (int m = 0; m < 4; ++m) {
                const int row = row0 + ai * HALF + m * 16;
                float rs = 1.f;
                if (MODE == 0 || MODE == 1 || MODE == 2) rs = (tab != nullptr && u.pidx < 4) ? tab[u.pidx * 256 + (row - u.pm * BM)] : rstd_from_slots(ssq, row, fq, fq * 16 + fr);
                if (MODE == 0) rs *= scale;
                if (MODE == 4) rs = rvec[row];
                bf16_t* rowp = O + (size_t)row * ldc + col0;
                if (MODE == 5) { const int rl = row - u.pm * BM; rowp = O + ((size_t)(u.pm & 15) << 20) + (size_t)((u.pm >> 4) * 256 + rl) * 1024 + col0; rs = scale; }
                if (MODE == 6) { rowp = O + ((size_t)(u.pn & 15) << 20) + (size_t)row * 1024 + (u.pn >> 4) * 256 + (col0 - u.pn * BM); }
                float s1 = 0.f, s2 = 0.f;
#pragma unroll
                for (int bj = 0; bj < 2; ++bj) {
                    f32x4 v0 = acc[ai][bj][m][0] * rs, v1 = acc[ai][bj][m][1] * rs;
                    if (MODE == 3) { v0 = acc[ai][bj][m][0] * cs[bj][0]; v1 = acc[ai][bj][m][1] * cs[bj][1]; }
                    if (MODE == 1) {
#pragma unroll
                        for (int j = 0; j < 4; ++j) { const float a = v0[j] > 0.f ? v0[j] : 0.f, b = v1[j] > 0.f ? v1[j] : 0.f; v0[j] = a * a; v1[j] = b * b; }
                    }
                    if (MODE == 2) {
#pragma unroll
                        for (int j = 0; j < 4; ++j) { v0[j] = gelu_tanh(v0[j]); v1[j] = gelu_tanh(v1[j]); }
#pragma unroll
                        for (int j = 0; j < 4; ++j) { s1 += v0[j] + v1[j]; s2 += v0[j] * v0[j] + v1[j] * v1[j]; }
                    }
                    u32x4 w; w.x = cvt_pk_bf16(v0[0], v0[1]); w.y = cvt_pk_bf16(v0[2], v0[3]); w.z = cvt_pk_bf16(v1[0], v1[1]); w.w = cvt_pk_bf16(v1[2], v1[3]);
                    bf16_t* sp = rowp + bj * HALF;
                    if (MODE == 1) { const int col = col0 + bj * HALF; sp = O + (((size_t)(u.pm * (ldc >> 6) + (col >> 6)) * BM + (row - u.pm * BM)) << 6) + (col & 63); }
                    __builtin_nontemporal_store(w, (u32x4*)sp);
                }
                if (MODE == 2) {
                    s1 = fq_sum(s1); s2 = fq_sum(s2);
                    if (u.pn >= 4 && fq == 0) { vstat[(size_t)row * 32 + (u.pn - 4) * 4 + wc] = s1; vstat[(size_t)row * 32 + 16 + (u.pn - 4) * 4 + wc] = s2; }
                }
            }
    }
};
struct EpiSoftmax {
    bf16_t* O; const float* ssq; LAS float* red; LAS float* tab;
    __device__ __forceinline__ void operator()(f32x4 (&acc)[2][2][4][2], const Unit& u, int, int, int, int) const {
        int t_ = tid_now(); asm volatile("" : "+v"(t_));
        const int wid_ = __builtin_amdgcn_readfirstlane(t_ >> 6), wr = wid_ >> 2, wc = wid_ & 3, fr = t_ & 15, fq = (t_ & 63) >> 4;
        const int row0 = u.pm * BM + wr * 64 + fr, col0 = u.pn * BM + wc * 32 + 8 * fq, lane = fq * 16 + fr;
#pragma unroll
        for (int ai = 0; ai < 2; ++ai)
#pragma unroll
            for (int m = 0; m < 4; ++m) {
                const int rl = ai * HALF + wr * 64 + m * 16 + fr;
                const float rs = (tab != nullptr && u.pidx < 4) ? tab[u.pidx * 256 + rl] : rstd_from_slots(ssq, u.pm * BM + rl, fq, lane);
                float mx = -3.0e38f;
#pragma unroll
                for (int bj = 0; bj < 2; ++bj)
#pragma unroll
                    for (int n = 0; n < 2; ++n) { acc[ai][bj][m][n] = acc[ai][bj][m][n] * rs;
#pragma unroll
                        for (int j = 0; j < 4; ++j) mx = fmaxf(mx, acc[ai][bj][m][n][j]); }
                mx = fq_max(mx);
                if (fq == 0) red[rl * 4 + wc] = mx;
            }
        asm volatile("s_waitcnt lgkmcnt(0)" ::: "memory"); __builtin_amdgcn_s_barrier(); asm volatile("" ::: "memory");
#pragma unroll
        for (int ai = 0; ai < 2; ++ai)
#pragma unroll
            for (int m = 0; m < 4; ++m) {
                const int rl = ai * HALF + wr * 64 + m * 16 + fr;
                const f32x4 r4 = *(const LAS f32x4*)(red + rl * 4);
                const float mx = fmaxf(fmaxf(r4[0], r4[1]), fmaxf(r4[2], r4[3]));
                float sm = 0.f;
#pragma unroll
                for (int bj = 0; bj < 2; ++bj)
#pragma unroll
                    for (int n = 0; n < 2; ++n)
#pragma unroll
                        for (int j = 0; j < 4; ++j) { const float e = __builtin_amdgcn_exp2f(acc[ai][bj][m][n][j] - mx); acc[ai][bj][m][n][j] = e; sm += e; }
                sm = fq_sum(sm);
                if (fq == 0) red[1024 + rl * 4 + wc] = sm;
            }
        asm volatile("s_waitcnt lgkmcnt(0)" ::: "memory"); __builtin_amdgcn_s_barrier(); asm volatile("" ::: "memory");
#pragma unroll
        for (int ai = 0; ai < 2; ++ai)
#pragma unroll
            for (int m = 0; m < 4; ++m) {
                const int rl = ai * HALF + wr * 64 + m * 16 + fr;
                const f32x4 r4 = *(const LAS f32x4*)(red + 1024 + rl * 4);
                const float inv = 1.0f / ((r4[0] + r4[1]) + (r4[2] + r4[3]));
                bf16_t* rowp = O + (size_t)(row0 + ai * HALF + m * 16) * D + col0;
#pragma unroll
                for (int bj = 0; bj < 2; ++bj) {
                    const f32x4 v0 = acc[ai][bj][m][0] * inv, v1 = acc[ai][bj][m][1] * inv;
                    u32x4 w; w.x = cvt_pk_bf16(v0[0], v0[1]); w.y = cvt_pk_bf16(v0[2], v0[3]); w.z = cvt_pk_bf16(v1[0], v1[1]); w.w = cvt_pk_bf16(v1[2], v1[3]);
                    __builtin_nontemporal_store(w, (u32x4*)(rowp + bj * HALF));
                }
            }
    }
};
template <bool F32IN> struct EpiResid {
    const float* xin; bf16_t* xb; float* ssq;
    __device__ __forceinline__ void operator()(const f32x4 (&acc)[2][2][4][2], const Unit& u, int, int, int, int) const {
        int t_ = tid_now(); asm volatile("" : "+v"(t_));
        const int wid_ = __builtin_amdgcn_readfirstlane(t_ >> 6), wr = wid_ >> 2, wc = wid_ & 3, fr = t_ & 15, fq = (t_ & 63) >> 4;
        const int row0 = u.pm * BM + wr * 64 + fr, col0 = u.pn * BM + wc * 32 + 8 * fq;
#pragma unroll
        for (int ai = 0; ai < 2; ++ai)
#pragma unroll
            for (int m = 0; m < 4; ++m) {
                const int row = row0 + ai * HALF + m * 16; const size_t off = (size_t)row * D + col0;
                float ss = 0.f;
#pragma unroll
                for (int bj = 0; bj < 2; ++bj) {
                    f32x4 a0, a1;
                    if (F32IN) { a0 = *(const f32x4*)(xin + off + bj * HALF); a1 = *(const f32x4*)(xin + off + bj * HALF + 4); }
                    else { const u32x4 r = *(const u32x4*)(xb + off + bj * HALF);
                        a0 = (f32x4){__uint_as_float(r.x << 16), __uint_as_float(r.x & 0xffff0000u), __uint_as_float(r.y << 16), __uint_as_float(r.y & 0xffff0000u)};
                        a1 = (f32x4){__uint_as_float(r.z << 16), __uint_as_float(r.z & 0xffff0000u), __uint_as_float(r.w << 16), __uint_as_float(r.w & 0xffff0000u)}; }
                    const f32x4 v0 = a0 + acc[ai][bj][m][0], v1 = a1 + acc[ai][bj][m][1];
                    u32x4 w; w.x = cvt_pk_bf16(v0[0], v0[1]); w.y = cvt_pk_bf16(v0[2], v0[3]); w.z = cvt_pk_bf16(v1[0], v1[1]); w.w = cvt_pk_bf16(v1[2], v1[3]);
                    __builtin_nontemporal_store(w, (u32x4*)(xb + off + bj * HALF));
                    const unsigned ww[4] = {w.x, w.y, w.z, w.w};
#pragma unroll
                    for (int j = 0; j < 4; ++j) { const float lo = __uint_as_float(ww[j] << 16), hi = __uint_as_float(ww[j] & 0xffff0000u); ss += lo * lo + hi * hi; }
                }
                ss = fq_sum(ss);
                if (fq == 0) ssq[(size_t)row * 16 + u.pn * 4 + wc] = ss;
                asm volatile("" ::: "memory");
            }
    }
};

template <int KIND, class Epi>
__device__ __forceinline__ void gemm_phase(LAS unsigned char* lds, const Gemm g, const StaticOrder& S, const Epi& E) {
    int tid_ = tid_now(); asm volatile("" : "+v"(tid_));
    const int tid = tid_, wid = __builtin_amdgcn_readfirstlane(tid >> 6), lane = tid & 63, wr = wid >> 2, wc = wid & 3, fr = lane & 15, fq = lane >> 4;
    const int nt = g.K / BK;
    unsigned voffA[2], voffB[2];
#pragma unroll
    for (int i = 0; i < 2; ++i) { int R, C; stage_rc(tid * 16 + i * 8192, R, C); const int Rb = (R & ~31) + perm32(R & 31);
        voffA[i] = (unsigned)(R * g.lda + C) * 2u; voffB[i] = (unsigned)(Rb * g.ldb + C) * 2u; }
    const size_t kstep = (size_t)(BK * 2), kstepA = (KIND == 5) ? (size_t)(BM * BK * 2) : kstep;
    const size_t hstepA = (size_t)HALF * g.lda * 2, hstepB = (size_t)HALF * g.ldb * 2;
    const size_t tstepA = (KIND == 5) ? (size_t)g.K * BM * 2 : 2 * hstepA, tstepB = 2 * hstepB;
    const unsigned ldsw = (unsigned)wid * 1024u;
    const int aoff = lds_byte(wr * 64 + fr, fq * 8), boff = lds_byte(wc * 32 + fr, fq * 8);
#define PG8_SA(b, h) (((b) * 2 + (h)) * HTB)
#define PG8_SB(b, h) ((4 + (b) * 2 + (h)) * HTB)
#define PG8_STAGE(bufoff, gbase, voff) do { _Pragma("unroll") for (int _i = 0; _i < 2; ++_i) \
        __builtin_amdgcn_global_load_lds((const unsigned*)((const char*)(gbase) + (voff)[_i]), (LAS unsigned*)(lds + (bufoff) + ldsw + _i * 8192), 16, 0, 0); } while (0)
#define PG8_LDA(dst, b, h) do { _Pragma("unroll") for (int m = 0; m < 4; ++m) _Pragma("unroll") for (int k = 0; k < 2; ++k) dst[m][k] = *(const LAS bf16x8*)(lds + PG8_SA(b, h) + aoff + m * 2048 + k * 1024); } while (0)
#define PG8_LDB(dst, b, h) do { _Pragma("unroll") for (int n = 0; n < 2; ++n) _Pragma("unroll") for (int k = 0; k < 2; ++k) dst[n][k] = *(const LAS bf16x8*)(lds + PG8_SB(b, h) + boff + n * 2048 + k * 1024); } while (0)
#define PG8_MMA(ai, bj, At, Bt) do { __builtin_amdgcn_s_setprio(1); _Pragma("unroll") for (int m = 0; m < 4; ++m) _Pragma("unroll") for (int n = 0; n < 2; ++n) _Pragma("unroll") for (int k = 0; k < 2; ++k) \
        acc[ai][bj][m][n] = __builtin_amdgcn_mfma_f32_16x16x32_bf16(Bt[n][k], At[m][k], acc[ai][bj][m][n], 0, 0, 0); __builtin_amdgcn_s_setprio(0); } while (0)
#define PG8_WAIT_V(n) asm volatile("s_waitcnt vmcnt(" #n ")" ::: "memory")
#define PG8_WAIT_L(n) asm volatile("s_waitcnt lgkmcnt(" #n ")" ::: "memory")
#define PG8_BAR __builtin_amdgcn_s_barrier()
#define PG8_SCHED __builtin_amdgcn_sched_barrier(0)
    Unit cur, nxt; int ui = 0;
    if (!S.next(0, cur)) return;
    cur.pidx = 0;
    f32x4 acc[2][2][4][2];
#pragma unroll
    for (int a = 0; a < 2; ++a)
#pragma unroll
        for (int b = 0; b < 2; ++b)
#pragma unroll
            for (int m = 0; m < 4; ++m)
#pragma unroll
                for (int n = 0; n < 2; ++n) acc[a][b][m][n] = (f32x4){0.f, 0.f, 0.f, 0.f};
    bf16x8 At[4][2], B0[2][2], B1[2][2];
    const char* cA = unitA<KIND>(g, cur.pm, cur.pn, tstepA); const char* cB = unitB<KIND>(g, cur.pm, cur.pn, tstepB);
    PG8_STAGE(PG8_SB(0, 0), cB, voffB); PG8_STAGE(PG8_SB(0, 1), cB + hstepB, voffB); PG8_STAGE(PG8_SA(0, 0), cA, voffA); PG8_STAGE(PG8_SA(0, 1), cA + hstepA, voffA);
    if (wr == 1) PG8_BAR;
    PG8_WAIT_V(2); PG8_BAR;
    PG8_STAGE(PG8_SB(1, 0), cB + kstep, voffB); PG8_STAGE(PG8_SA(1, 0), cA + kstepA, voffA); PG8_STAGE(PG8_SB(1, 1), cB + hstepB + kstep, voffB);
    PG8_WAIT_V(6); PG8_BAR;
    for (;;) {
        const bool has_next = S.next(ui + 1, nxt);
        nxt.pidx = (has_next && nxt.pm != cur.pm) ? cur.pidx + 1 : cur.pidx;
        const char* nA = has_next ? unitA<KIND>(g, nxt.pm, nxt.pn, tstepA) : cA; const char* nB = has_next ? unitB<KIND>(g, nxt.pm, nxt.pn, tstepB) : cB;
        for (int t = 0; t < nt; t += 2) {
            const bool last = (t == nt - 2);
            const char* a1 = cA + (size_t)(t + 1) * kstepA;
            const char* a2 = last ? nA : cA + (size_t)(t + 2) * kstepA; const char* b2 = last ? nB : cB + (size_t)(t + 2) * kstep;
            const char* a3 = a2 + kstepA; const char* b3 = b2 + kstep;
            PG8_LDB(B0, 0, 0); PG8_LDB(B1, 0, 1); PG8_SCHED; PG8_LDA(At, 0, 0); PG8_STAGE(PG8_SA(1, 1), a1 + hstepA, voffA);
            PG8_WAIT_V(8); PG8_WAIT_L(0); PG8_BAR; PG8_MMA(0, 0, At, B0); PG8_MMA(0, 1, At, B1); PG8_BAR; PG8_SCHED;
            PG8_LDA(At, 0, 1); PG8_STAGE(PG8_SB(0, 0), b2, voffB); PG8_STAGE(PG8_SB(0, 1), b2 + hstepB, voffB); PG8_STAGE(PG8_SA(0, 0), a2, voffA);
            PG8_WAIT_V(8); PG8_WAIT_L(0); PG8_BAR; PG8_MMA(1, 0, At, B0); PG8_MMA(1, 1, At, B1); PG8_BAR; PG8_SCHED;
            PG8_LDB(B0, 1, 0); PG8_LDB(B1, 1, 1); PG8_SCHED; PG8_LDA(At, 1, 0); PG8_STAGE(PG8_SA(0, 1), a2 + hstepA, voffA);
            PG8_WAIT_V(8); PG8_WAIT_L(0); PG8_BAR; PG8_MMA(0, 0, At, B0); PG8_MMA(0, 1, At, B1); PG8_BAR; PG8_SCHED;
            PG8_LDA(At, 1, 1); PG8_STAGE(PG8_SB(1, 0), b3, voffB); PG8_STAGE(PG8_SB(1, 1), b3 + hstepB, voffB); PG8_STAGE(PG8_SA(1, 0), a3, voffA);
            PG8_WAIT_V(8); PG8_WAIT_L(0); PG8_BAR; PG8_MMA(1, 0, At, B0); PG8_MMA(1, 1, At, B1); PG8_BAR; PG8_SCHED;
        }
        if (wr == 0) PG8_BAR;
        E(acc, cur, wr, wc, fr, fq);
        if (!has_next) break;
#pragma unroll
        for (int a = 0; a < 2; ++a)
#pragma unroll
            for (int b = 0; b < 2; ++b)
#pragma unroll
                for (int m = 0; m < 4; ++m)
#pragma unroll
                    for (int n = 0; n < 2; ++n) acc[a][b][m][n] = (f32x4){0.f, 0.f, 0.f, 0.f};
        cur = nxt; cA = nA; cB = nB; ++ui;
        if (wr == 1) PG8_BAR;
    }
    PG8_WAIT_V(0);
    PG8_BAR;
#undef PG8_SA
#undef PG8_SB
#undef PG8_STAGE
#undef PG8_LDA
#undef PG8_LDB
#undef PG8_MMA
#undef PG8_WAIT_V
#undef PG8_WAIT_L
#undef PG8_BAR
#undef PG8_SCHED
}
}

struct MatDesc { const float* src; int ldw, K, N; bf16_t* dst; int ldt; const float* ks; const float* ns; };

__device__ __forceinline__ void transpose_item(const MatDesc& d, LAS float* scr, int item, int lane) {
    const int nblk = d.N / 32, kb = item / nblk, nb = item % nblk, k0 = 64 * kb, n0 = 32 * nb;
    const int n4 = lane & 7, rr = lane >> 3;
    f32x4 nsv = (f32x4){1.f, 1.f, 1.f, 1.f};
    if (d.ns) nsv = *(const f32x4*)(d.ns + n0 + 4 * n4);
    f32x4 v[8];
#pragma unroll
    for (int j = 0; j < 8; ++j) v[j] = *(const f32x4*)(d.src + (size_t)(k0 + rr + 8 * j) * d.ldw + n0 + 4 * n4);
#pragma unroll
    for (int j = 0; j < 8; ++j) { const int kk = rr + 8 * j; f32x4 w = v[j] * nsv; if (d.ks) w = w * d.ks[k0 + kk];
        scr[kk * 33 + 4 * n4 + 0] = w[0]; scr[kk * 33 + 4 * n4 + 1] = w[1]; scr[kk * 33 + 4 * n4 + 2] = w[2]; scr[kk * 33 + 4 * n4 + 3] = w[3]; }
    asm volatile("s_waitcnt lgkmcnt(0)" ::: "memory");
    const int c = lane & 7;
#pragma unroll
    for (int j = 0; j < 4; ++j) { const int n = (lane >> 3) + 8 * j; const LAS float* s = scr + (8 * c) * 33 + n;
        u32x4 o; o.x = cvt_pk_bf16(s[0 * 33], s[1 * 33]); o.y = cvt_pk_bf16(s[2 * 33], s[3 * 33]); o.z = cvt_pk_bf16(s[4 * 33], s[5 * 33]); o.w = cvt_pk_bf16(s[6 * 33], s[7 * 33]);
        *(u32x4*)(d.dst + (size_t)(n0 + n) * d.ldt + k0 + 8 * c) = o; }
    asm volatile("s_waitcnt lgkmcnt(0)" ::: "memory");
}

enum { I_X = 0, I_MEM, I_G_MIX, I_G_MEM, I_G_MEMKV, I_G_FFN, I_G_FINAL, I_POOL_W, I_POOL_SCALE, I_SGU_WIN, I_SGU_LNG, I_SGU_LNB, I_SGU_WS, I_SGU_BS, I_SGU_WOUT, I_WQ, I_WKV, I_WO, I_W1, I_W2 };

__device__ __forceinline__ MatDesc get_mat(const Params& P, int id) {
    MatDesc d; d.ks = nullptr; d.ns = nullptr;
    unsigned char* ws = P.ws;
    if (id < 24) {
        const int L = id / 6, t = id % 6;
        if (t == 0)      { d.src = P.in[I_WQ] + (size_t)L * D * D; d.ldw = D; d.K = D; d.N = D; d.dst = (bf16_t*)(ws + WS_WQ) + (size_t)L * D * D; d.ldt = D; d.ks = P.in[I_G_MEM] + L * D; }
        else if (t == 1) { d.src = P.in[I_WKV] + (size_t)L * D * 2 * D; d.ldw = 2 * D; d.K = D; d.N = D; d.dst = (bf16_t*)(ws + WS_WK) + (size_t)L * D * D; d.ldt = D; d.ks = P.in[I_G_MEMKV] + L * D; }
        else if (t == 2) { d.src = P.in[I_WKV] + (size_t)L * D * 2 * D + D; d.ldw = 2 * D; d.K = D; d.N = D; d.dst = (bf16_t*)(ws + WS_WV) + (size_t)L * D * D; d.ldt = D; d.ks = P.in[I_G_MEMKV] + L * D; }
        else if (t == 3) { d.src = P.in[I_WO] + (size_t)L * D * D; d.ldw = D; d.K = D; d.N = D; d.dst = (bf16_t*)(ws + WS_WO) + (size_t)L * D * D; d.ldt = D; }
        else if (t == 4) { d.src = P.in[I_W1] + (size_t)L * D * FF; d.ldw = FF; d.K = D; d.N = FF; d.dst = (bf16_t*)(ws + WS_W1) + (size_t)L * D * FF; d.ldt = D; d.ks = P.in[I_G_FFN] + L * D; }
        else             { d.src = P.in[I_W2] + (size_t)L * D * FF; d.ldw = D; d.K = FF; d.N = D; d.dst = (bf16_t*)(ws + WS_W2) + (size_t)L * D * FF; d.ldt = FF; }
    } else if (id < 28) {
        const int j = (id - 24) >> 1, t = (id - 24) & 1;
        if (t == 0) { d.src = P.in[I_SGU_WIN] + (size_t)j * D * 2 * D; d.ldw = 2 * D; d.K = D; d.N = 2 * D; d.dst = (bf16_t*)(ws + WS_WIN) + (size_t)j * D * 2 * D; d.ldt = D; d.ks = P.in[I_G_MIX] + (2 * j + 1) * D; }
        else        { d.src = P.in[I_SGU_WOUT] + (size_t)j * D * D; d.ldw = D; d.K = D; d.N = D; d.dst = (bf16_t*)(ws + WS_WOUT) + (size_t)j * D * D; d.ldt = D; }
    } else {
        const int jg = id - 28, j = jg >> 2, g = jg & 3;
        d.src = P.in[I_POOL_W] + (size_t)jg * 256 * 256; d.ldw = 256; d.K = 256; d.N = 256; d.dst = (bf16_t*)(ws + WS_PW) + (size_t)jg * 256 * 256; d.ldt = 256;
        d.ks = P.in[I_G_MIX] + (2 * j) * D + g * 256; d.ns = P.in[I_POOL_SCALE] + j * D + g * 256;
    }
    return d;
}
__device__ __forceinline__ int mat_items(int id) {
    if (id < 24) { const int t = id % 6; return (t == 0) ? 0 : ((t >= 4) ? 2048 : 512); }
    if (id < 28) return ((id - 24) & 1) ? 512 : 1024;
    return 32;
}

__device__ __forceinline__ void prologue_phase(const Params& P, LAS unsigned char* lds, int G) {
    int tid_ = tid_now(); asm volatile("" : "+v"(tid_));
    const int tid = tid_, lane = tid & 63, wave = __builtin_amdgcn_readfirstlane(tid >> 6);
    LAS float* scr = (LAS float*)(lds + wave * 16384);
    const int gw = blockIdx.x * 8 + wave, NGW = G * 8;
    constexpr int NITEMS = 4 * (3 * 512 + 2 * 2048) + 2 * (1024 + 512) + 8 * 32;
    for (int it = gw; it < NITEMS; it += NGW) {
        int r = it, id = 0;
        for (; id < 36; ++id) { const int n = mat_items(id); if (r < n) break; r -= n; }
        const MatDesc d = get_mat(P, id);
        transpose_item(d, scr, r, lane);
    }
    { const float* wq = P.in[I_WQ]; const float* gq = P.in[I_G_MEM]; bf16_t* wqb = (bf16_t*)(P.ws + WS_WQ);
      for (int r = gw; r < DEPTH * D; r += NGW) { const float gk = gq[r]; const f32x4* xr = (const f32x4*)(wq + (size_t)r * D) + lane; u32x2* o = (u32x2*)(wqb + (size_t)r * D) + lane;
#pragma unroll
        for (int j = 0; j < 4; ++j) { const f32x4 v = xr[64 * j] * gk; u32x2 w; w.x = cvt_pk_bf16(v[0], v[1]); w.y = cvt_pk_bf16(v[2], v[3]); o[64 * j] = w; } } }
    const float* mem = P.in[I_MEM]; bf16_t* memb = (bf16_t*)(P.ws + WS_MEMB); float* rstd_mem = (float*)(P.ws + WS_RSTDMEM);
    for (int r = gw; r < MR; r += NGW) {
        const f32x4* xr = (const f32x4*)(mem + (size_t)r * D) + lane; f32x4 v[4]; float s = 0.f;
#pragma unroll
        for (int j = 0; j < 4; ++j) { v[j] = xr[64 * j]; s += (v[j][0] * v[j][0] + v[j][1] * v[j][1]) + (v[j][2] * v[j][2] + v[j][3] * v[j][3]); }
        s = wave_sum(s, lane);
        if (lane == 0) rstd_mem[r] = 1.0f / sqrtf(s * (1.0f / D) + EPS);
        u32x2* o = (u32x2*)(memb + (size_t)r * D) + lane;
#pragma unroll
        for (int j = 0; j < 4; ++j) { u32x2 w; w.x = cvt_pk_bf16(v[j][0], v[j][1]); w.y = cvt_pk_bf16(v[j][2], v[j][3]); o[64 * j] = w; }
    }
    const float* x = P.in[I_X]; float* ssq0 = (float*)(P.ws + WS_SSQ0);
    for (int r = gw; r < M; r += 2 * NGW) {
        const int r1 = (r + NGW < M) ? r + NGW : r;
        f32x4 va[4], vb[4];
#pragma unroll
        for (int j = 0; j < 4; ++j) { va[j] = ((const f32x4*)(x + (size_t)r * D) + lane)[64 * j]; vb[j] = ((const f32x4*)(x + (size_t)r1 * D) + lane)[64 * j]; }
        float s = 0.f, t = 0.f;
#pragma unroll
        for (int j = 0; j < 4; ++j) { s += (va[j][0] * va[j][0] + va[j][1] * va[j][1]) + (va[j][2] * va[j][2] + va[j][3] * va[j][3]); t += (vb[j][0] * vb[j][0] + vb[j][1] * vb[j][1]) + (vb[j][2] * vb[j][2] + vb[j][3] * vb[j][3]); }
        s = wave_sum(s, lane); t = wave_sum(t, lane);
        if (lane < 16) { ssq0[(size_t)r * 16 + lane] = (lane == 0) ? s : 0.f; if (r1 != r) ssq0[(size_t)r1 * 16 + lane] = (lane == 0) ? t : 0.f; }
    }
}

template <int W>
__device__ __forceinline__ void pool_block(const f32x2 (&prev)[16], const f32x2 (&cur)[16], bool seq_start, bf16_t* outp  ) {
#pragma unroll
    for (int i = 0; i < 16; ++i) {
        f32x2 s = cur[i];
#pragma unroll
        for (int j = 1; j < W; ++j) { s += (i - j >= 0) ? cur[(i - j) & 15] : prev[(16 + i - j) & 15]; }
        float inv = 1.0f / (float)W;
        if (i < W - 1 && seq_start) inv = 1.0f / (float)(i + 1);
        const f32x2 o = s * inv - cur[i];
        *(unsigned*)(outp + (size_t)i * D) = cvt_pk_bf16(o[0], o[1]);
    }
}
template <bool F32IN> __device__ __forceinline__ f32x2 pool_ld(const void* x, size_t idx) {
    if (F32IN) return *(const f32x2*)((const float*)x + idx);
    const unsigned r = *(const unsigned*)((const bf16_t*)x + idx); return (f32x2){__uint_as_float(r << 16), __uint_as_float(r & 0xffff0000u)};
}
template <bool F32IN>
__device__ __forceinline__ void pool_a_phase(LAS unsigned char* lds, const void* x, const float* ssq, bf16_t* PA, int G) {
    LAS float* rs = (LAS float*)lds;
    int tid_ = tid_now(); asm volatile("" : "+v"(tid_));
    const int tid = tid_, ch = 2 * tid, group = __builtin_amdgcn_readfirstlane(tid >> 7);
    for (int chunk = blockIdx.x; chunk < M / 64; chunk += G) {
        const int t0 = chunk * 64; const bool sstart = (t0 & (SEQ - 1)) == 0;
        __syncthreads();
        if (tid < 80) {
            float r = 0.f;
            if (!(sstart && tid < 16)) { const f32x4* p = (const f32x4*)(ssq + (size_t)(t0 - 16 + tid) * 16); const f32x4 a = p[0], b = p[1], c = p[2], d = p[3];
                const float s = (((a[0] + a[1]) + (a[2] + a[3])) + ((b[0] + b[1]) + (b[2] + b[3]))) + (((c[0] + c[1]) + (c[2] + c[3])) + ((d[0] + d[1]) + (d[2] + d[3])));
                r = 1.0f / sqrtf(s * (1.0f / D) + EPS); }
            rs[tid] = r;
        }
        __syncthreads();
        f32x2 prev[16], cur[16];
        if (sstart) {
#pragma unroll
            for (int i = 0; i < 16; ++i) prev[i] = (f32x2){0.f, 0.f};
        } else {
#pragma unroll
            for (int i = 0; i < 16; ++i) prev[i] = pool_ld<F32IN>(x, (size_t)(t0 - 16 + i) * D + ch) * rs[i];
        }
        for (int blk = 0; blk < 4; ++blk) {
#pragma unroll
            for (int i = 0; i < 16; ++i) cur[i] = pool_ld<F32IN>(x, (size_t)(t0 + blk * 16 + i) * D + ch) * rs[16 + blk * 16 + i];
            bf16_t* outp = PA + (size_t)(t0 + blk * 16) * D + ch;
            const bool ss = sstart && blk == 0;
            if (group == 0) pool_block<2>(prev, cur, ss, outp);
            else if (group == 1) pool_block<4>(prev, cur, ss, outp);
            else if (group == 2) pool_block<8>(prev, cur, ss, outp);
            else pool_block<16>(prev, cur, ss, outp);
#pragma unroll
            for (int i = 0; i < 16; ++i) prev[i] = cur[i];
        }
    }
}

__device__ __forceinline__ void sgu_spatial_phase(LAS unsigned char* lds, const bf16_t* Z, const float* vstat, const float* wsf, const float* bsf, const float* lng, const float* lnb, bf16_t* T1, int G) {
    constexpr int APITCH = 272;
    LAS unsigned char* Aimg = lds;
    LAS unsigned char* VT = lds + 34816;
    LAS float* mu = (LAS float*)(lds + 34816 + 67584); LAS float* rsd = mu + 128;
    int tid_ = tid_now(); asm volatile("" : "+v"(tid_));
    const int tid = tid_, lane = tid & 63, wave = __builtin_amdgcn_readfirstlane(tid >> 6);
    const int g = blockIdx.x & 3;
    bool first = true;
    for (int u = blockIdx.x; u < (M / 128) * 4; u += G) {
        const int nb = u >> 2; const size_t rowb = (size_t)nb * 128;
        __syncthreads();
        if (tid < 128) {
            const f32x4* p = (const f32x4*)(vstat + (rowb + tid) * 32); float s1 = 0.f, s2 = 0.f;
#pragma unroll
            for (int i = 0; i < 4; ++i) { const f32x4 a = p[i], b = p[4 + i]; s1 += (a[0] + a[1]) + (a[2] + a[3]); s2 += (b[0] + b[1]) + (b[2] + b[3]); }
            const float m = s1 * (1.0f / D), var = s2 * (1.0f / D) - m * m;
            mu[tid] = m; rsd[tid] = 1.0f / sqrtf(fmaxf(var, 0.f) + EPS);
        }
        if (first) {
            first = false;
            const float* wg = wsf + (size_t)g * 128 * 128;
#pragma unroll
            for (int i = 0; i < 8; ++i) { const int e = (tid + 512 * i) * 4, p = e >> 7, q = e & 127; f32x4 v = *(const f32x4*)(wg + e);
                if ((p >> 6) < (q >> 6)) v = (f32x4){0.f, 0.f, 0.f, 0.f};
                u32x2 w; w.x = cvt_pk_bf16(v[0], v[1]); w.y = cvt_pk_bf16(v[2], v[3]); *(LAS u32x2*)(Aimg + p * APITCH + q * 2) = w; }
        }
        __syncthreads();
        {
            const int cp = tid & 31, c0 = 8 * cp; float gg[8], bb[8];
#pragma unroll
            for (int e = 0; e < 8; ++e) { gg[e] = lng[g * 256 + c0 + e]; bb[e] = lnb[g * 256 + c0 + e]; }
#pragma unroll 2
            for (int i = 0; i < 8; ++i) {
                const int q = (tid >> 5) + 16 * i;
                const u32x4 raw = *(const u32x4*)(Z + (rowb + q) * 2048 + 1024 + g * 256 + c0);
                const float m = mu[q], r = rsd[q];
                const unsigned wv[4] = {raw.x, raw.y, raw.z, raw.w};
#pragma unroll
                for (int e = 0; e < 8; ++e) {
                    const float v = __uint_as_float((e & 1) ? (wv[e >> 1] & 0xffff0000u) : (wv[e >> 1] << 16));
                    const float y = (v - m) * r * gg[e] + bb[e];
                    const unsigned pk = cvt_pk_bf16(y, y);
                    const int c = c0 + e, chunk = (q >> 3) ^ ((c >> 3) & 15) ^ (c & 7);
                    *(LAS unsigned short*)(VT + c * 256 + chunk * 16 + (q & 7) * 2) = (unsigned short)pk;
                }
            }
        }
        __syncthreads();
        f32x4 acc[2][8];
#pragma unroll
        for (int ct = 0; ct < 2; ++ct)
#pragma unroll
            for (int pt = 0; pt < 8; ++pt) acc[ct][pt] = (f32x4){0.f, 0.f, 0.f, 0.f};
        const int l16 = lane & 15, l4 = lane >> 4;
#pragma unroll
        for (int ks = 0; ks < 4; ++ks) {
            bf16x8 af[2], bfr[8];
#pragma unroll
            for (int ct = 0; ct < 2; ++ct) { const int c = wave * 32 + ct * 16 + l16, chunk = (4 * ks + l4) ^ ((c >> 3) & 15) ^ (c & 7); af[ct] = *(const LAS bf16x8*)(VT + c * 256 + chunk * 16); }
#pragma unroll
            for (int pt = 0; pt < 8; ++pt) bfr[pt] = *(const LAS bf16x8*)(Aimg + (pt * 16 + l16) * APITCH + (32 * ks + 8 * l4) * 2);
#pragma unroll
            for (int ct = 0; ct < 2; ++ct)
#pragma unroll
                for (int pt = 0; pt < 8; ++pt) acc[ct][pt] = __builtin_amdgcn_mfma_f32_16x16x32_bf16(af[ct], bfr[pt], acc[ct][pt], 0, 0, 0);
        }
        u32x4 uu[8];
#pragma unroll
        for (int i = 0; i < 8; ++i) { const int piece = tid + 512 * i; uu[i] = *(const u32x4*)(Z + (rowb + (piece >> 5)) * 2048 + g * 256 + (piece & 31) * 8); }
        __syncthreads();
        LAS unsigned char* SS = VT;
#pragma unroll
        for (int pt = 0; pt < 8; ++pt) {
            const int p = pt * 16 + l16; const float bsv = bsf[g * 128 + p];
#pragma unroll
            for (int ct = 0; ct < 2; ++ct) {
                const f32x4 s = acc[ct][pt] + bsv;
                u32x2 w; w.x = cvt_pk_bf16(s[0], s[1]); w.y = cvt_pk_bf16(s[2], s[3]);
                *(LAS u32x2*)(SS + p * 528 + (wave * 32 + ct * 16 + 4 * l4) * 2) = w;
            }
        }
        __syncthreads();
#pragma unroll
        for (int i = 0; i < 8; ++i) {
            const int piece = tid + 512 * i, p = piece >> 5, part = piece & 31;
            const u32x4 sv = *(const LAS u32x4*)(SS + p * 528 + part * 16);
            const unsigned ua[4] = {uu[i].x, uu[i].y, uu[i].z, uu[i].w}, sa[4] = {sv.x, sv.y, sv.z, sv.w}; unsigned r[4];
#pragma unroll
            for (int e = 0; e < 4; ++e) r[e] = cvt_pk_bf16(__uint_as_float(ua[e] << 16) * __uint_as_float(sa[e] << 16), __uint_as_float(ua[e] & 0xffff0000u) * __uint_as_float(sa[e] & 0xffff0000u));
            u32x4 w; w.x = r[0]; w.y = r[1]; w.z = r[2]; w.w = r[3];
            __builtin_nontemporal_store(w, (u32x4*)(T1 + (rowb + p) * D + g * 256 + part * 8));
        }
    }
}

__device__ __forceinline__ void final_norm_phase(const bf16_t* xb, float* out, const float* gain, int G) {
    int tid_ = tid_now(); asm volatile("" : "+v"(tid_));
    const int tid = tid_, lane = tid & 63, wave = tid >> 6, gw = blockIdx.x * 8 + wave, NGW = G * 8;
    f32x4 gv[4];
#pragma unroll
    for (int j = 0; j < 2; ++j) { gv[2 * j] = *(const f32x4*)(gain + 512 * j + 8 * lane); gv[2 * j + 1] = *(const f32x4*)(gain + 512 * j + 8 * lane + 4); }
    for (int r = gw; r < M; r += NGW) {
        f32x4 v[4]; float s = 0.f;
#pragma unroll
        for (int j = 0; j < 2; ++j) { const u32x4 q = *(const u32x4*)(xb + (size_t)r * D + 512 * j + 8 * lane);
            v[2 * j] = (f32x4){__uint_as_float(q.x << 16), __uint_as_float(q.x & 0xffff0000u), __uint_as_float(q.y << 16), __uint_as_float(q.y & 0xffff0000u)};
            v[2 * j + 1] = (f32x4){__uint_as_float(q.z << 16), __uint_as_float(q.z & 0xffff0000u), __uint_as_float(q.w << 16), __uint_as_float(q.w & 0xffff0000u)}; }
#pragma unroll
        for (int j = 0; j < 4; ++j) s += (v[j][0] * v[j][0] + v[j][1] * v[j][1]) + (v[j][2] * v[j][2] + v[j][3] * v[j][3]);
        s = wave_sum(s, lane);
        const float rs = 1.0f / sqrtf(s * (1.0f / D) + EPS);
#pragma unroll
        for (int j = 0; j < 2; ++j) { *(f32x4*)(out + (size_t)r * D + 512 * j + 8 * lane) = v[2 * j] * rs * gv[2 * j]; *(f32x4*)(out + (size_t)r * D + 512 * j + 8 * lane + 4) = v[2 * j + 1] * rs * gv[2 * j + 1]; }
    }
}

#define XB_TMO      128
#define XB_XCNT(j)  (256  + 64 * (j))
#define XB_XSUB(j)  (1280 + 64 * (j))
#define XB_XGEN(j)  (2304 + 64 * (j))
#define XB_TOP      3328
#define XB_TOPGEN   3392
#define XCD_BAR_WORDS 3456
#define XB_SPIN_CAP (1u << 20)
__device__ __forceinline__ unsigned xb_ld(unsigned* p)              { return __hip_atomic_load(p, __ATOMIC_RELAXED, __HIP_MEMORY_SCOPE_AGENT); }
__device__ __forceinline__ unsigned xb_add(unsigned* p, unsigned v) { return __hip_atomic_fetch_add(p, v, __ATOMIC_RELAXED, __HIP_MEMORY_SCOPE_AGENT); }
__device__ __forceinline__ unsigned xb_xcc_id() { return (unsigned)__builtin_amdgcn_s_getreg((3 << 11) | 20) & 0xFu; }
#define XB_SPIN(cond, bar) do { unsigned _sp = 0; while (cond) { __builtin_amdgcn_s_sleep(1); \
    if ((++_sp & 255u) == 0u) { if (xb_ld(&(bar)[XB_TMO])) break; if (_sp > XB_SPIN_CAP) { atomicAdd(&(bar)[XB_TMO], 1u); break; } } } } while (0)
struct XcdBarrier { unsigned* bar; unsigned x; volatile LAS unsigned* st; };
__device__ __forceinline__ XcdBarrier xcd_barrier_post(unsigned* bar, volatile LAS unsigned* st) {
    XcdBarrier b; b.bar = bar; b.x = xb_xcc_id(); b.st = st;
    if (tid_now() == 0) (void)xb_add(&bar[XB_XCNT(b.x)], 1u);
    return b;
}
__device__ __forceinline__ void xcd_barrier_complete(unsigned* bar, unsigned x, unsigned& nloc, unsigned& nx) {
    const unsigned G = gridDim.x * gridDim.y * gridDim.z;
    unsigned sum, cnt, mine, sp = 0u;
    for (;;) {
        sum = 0u; cnt = 0u; mine = 0u;
#pragma unroll
        for (unsigned j = 0; j < 16; ++j) { const unsigned c = xb_ld(&bar[XB_XCNT(j)]); sum += c; cnt += (c > 0u) ? 1u : 0u; mine = (j == x) ? c : mine; }
        if (sum == G) break;
        __builtin_amdgcn_s_sleep(1);
        if ((++sp & 255u) == 0u) { if (xb_ld(&bar[XB_TMO])) break; if (sp > XB_SPIN_CAP) { atomicAdd(&bar[XB_TMO], 1u); break; } }
    }
    nloc = mine > 0u ? mine : 1u; nx = cnt > 0u ? cnt : 1u;
}
__device__ __forceinline__ void xcd_barrier(const XcdBarrier& b) {
    asm volatile("s_waitcnt vmcnt(0)" ::: "memory");
    __syncthreads();
    if (tid_now() == 0) {
        unsigned* bar = b.bar;
        __builtin_amdgcn_s_waitcnt(0);
        unsigned nloc = b.st[0], nx = b.st[1];
        if (nloc == 0u) { xcd_barrier_complete(bar, b.x, nloc, nx); b.st[0] = nloc; b.st[1] = nx; }
        const unsigned old = xb_add(&bar[XB_XSUB(b.x)], 1u);
        const unsigned gen = old / nloc;
        if (old + 1u == (gen + 1u) * nloc) {
            __builtin_amdgcn_fence(__ATOMIC_RELEASE, "agent");
            asm volatile("s_waitcnt vmcnt(0)" ::: "memory");
            const unsigned og = xb_add(&bar[XB_TOP], 1u);
            const unsigned tg = og / nx;
            if (og + 1u == (tg + 1u) * nx) xb_add(&bar[XB_TOPGEN], 1u);
            else XB_SPIN(xb_ld(&bar[XB_TOPGEN]) == tg, bar);
            __builtin_amdgcn_fence(__ATOMIC_ACQUIRE, "agent");
            xb_add(&bar[XB_XGEN(b.x)], 1u);
            asm volatile("s_waitcnt vmcnt(0)" ::: "memory");
        } else {
            XB_SPIN(xb_ld(&bar[XB_XGEN(b.x)]) == gen, bar);
            __builtin_amdgcn_fence(__ATOMIC_ACQUIRE, "agent");
            asm volatile("s_waitcnt vmcnt(0)" ::: "memory");
        }
    }
    __syncthreads();
}

constexpr int NPHASES = 35;
__host__ __device__ inline bool phase_empty(int ph) { if (ph < 2 || ph >= 34) return false; const int L = (ph - 2) >> 3, k = (ph - 2) & 7; return (k == 2 && (L & 1) == 0) || k == 4; }

__global__ void __launch_bounds__(512, 2) fwd_megakernel(Params P) {
    extern __shared__ __attribute__((aligned(16))) unsigned char lds_raw[];
    LAS unsigned char* lds = (LAS unsigned char*)lds_raw;
    cg::grid_group grid = cg::this_grid();
    const int G = gridDim.x;
    typedef const Params __attribute__((address_space(4))) CParams;
    volatile LAS unsigned* MISC = (volatile LAS unsigned*)(lds + 131072 + 320);
    { const int t0 = threadIdx.x;
      if ((t0 & 63) == 0) ((volatile LAS int*)(lds + WIDTAB_OFF))[(unsigned)__builtin_amdgcn_s_getreg((5 << 11) | 4) & 63u] = t0 >> 6;
      if (t0 < 32) MISC[t0] = 0u; }
    __syncthreads();
    const int ph_lo = P.ph_lo, ph_hi = P.ph_hi;
    XcdBarrier bar; bar.bar = (unsigned*)(P.ws + WS_CTL); bar.x = 0; bar.st = MISC + 8;
    if (ph_hi - ph_lo > 1) bar = xcd_barrier_post((unsigned*)(P.ws + WS_CTL), MISC + 8);

    for (int ph = ph_lo; ph < ph_hi; ++ph) {
        const CParams* KP = (const CParams*)__builtin_amdgcn_kernarg_segment_ptr(); asm volatile("" : "+s"(KP));
        unsigned char* ws = KP->ws;
        bf16_t* T1 = (bf16_t*)(ws + WS_T1); bf16_t* ZB = (bf16_t*)(ws + WS_Z); bf16_t* HB = (bf16_t*)(ws + WS_H);
        bf16_t* XB = (bf16_t*)(ws + WS_XB); bf16_t* KVALL = (bf16_t*)(ws + WS_KVALL); bf16_t* MEMB = (bf16_t*)(ws + WS_MEMB); bf16_t* MQ = (bf16_t*)(ws + WS_MQ); bf16_t* VWO = (bf16_t*)(ws + WS_VWO);
        float* SSQ[2] = {(float*)(ws + WS_SSQ0), (float*)(ws + WS_SSQ1)};
        float* VSTAT = (float*)(ws + WS_VSTAT); float* RSTDMEM = (float*)(ws + WS_RSTDMEM);
        if (phase_empty(ph)) continue;
        if (ph == 0) {
            { Params Pl; for (int i = 0; i < 20; ++i) Pl.in[i] = KP->in[i]; Pl.out = KP->out; Pl.ws = ws; Pl.ph_lo = 0; Pl.ph_hi = 0; prologue_phase(Pl, lds, G); }
        } else if (ph == 1) {
            pg8::StaticOrder S; S.init(MR, 8192, G, (int)blockIdx.x);
            pg8::Gemm g{MEMB, (const bf16_t*)(ws + WS_WK), MR, 8192, D, D, D}; pg8::EpiAct<4> E{KVALL, 8192, nullptr, 1.f, RSTDMEM, nullptr}; pg8::gemm_phase<0>(lds, g, S, E);
        } else if (ph == 34) {
            final_norm_phase(XB, KP->out, KP->in[I_G_FINAL], G);
        } else {
            const int L = (ph - 2) >> 3, k = (ph - 2) & 7, j = L >> 1; const bool odd = (L & 1) != 0;
            if (k == 0) {
                const float* ssq_r = SSQ[(3 * L) & 1];
                if (!odd) { if (L == 0) pool_a_phase<true>(lds, KP->in[I_X], ssq_r, T1, G); else pool_a_phase<false>(lds, XB, ssq_r, T1, G); }
                else { pg8::Gemm g{XB, (const bf16_t*)(ws + WS_WIN) + (size_t)j * D * 2 * D, M, 2 * D, D, D, D}; pg8::StaticOrder S; S.init(M, 2 * D, G, (int)blockIdx.x);
                    LAS float* tab = (LAS float*)(lds + pg8::RSTD_TAB_OFF); pg8::fill_rstd_table(tab, ssq_r, S);
                    pg8::EpiAct<2> E{ZB, 2 * D, ssq_r, 1.f, nullptr, VSTAT, tab}; pg8::gemm_phase<0>(lds, g, S, E); }
                __syncthreads();
                { pg8::Gemm g{KVALL + L * 1024, (const bf16_t*)(ws + WS_WQ) + (size_t)L * D * D, 4 * MR, D, 256, 8192, D}; pg8::StaticOrder S; S.init(4 * MR, D, G, (int)blockIdx.x);
                  pg8::EpiAct<5> E{MQ, D, nullptr, QSCALE, nullptr, nullptr}; pg8::gemm_phase<3>(lds, g, S, E); }
                { pg8::Gemm g{(const bf16_t*)(ws + WS_WO) + (size_t)L * D * D, KVALL + 4096 + L * 1024, D, 4 * MR, 256, D, 8192}; pg8::StaticOrder S; S.init(D, 4 * MR, G, (int)blockIdx.x);
                  pg8::EpiAct<6> E{VWO, D, nullptr, 1.f, nullptr, nullptr}; pg8::gemm_phase<4>(lds, g, S, E); }
            } else if (k == 1 && odd) {
                sgu_spatial_phase(lds, ZB, VSTAT, KP->in[I_SGU_WS] + (size_t)j * 4 * 128 * 128, KP->in[I_SGU_BS] + j * 512, KP->in[I_SGU_LNG] + j * D, KP->in[I_SGU_LNB] + j * D, T1, G);
            } else if (k == 3) {
                pg8::Gemm g{XB, MQ, M, D, D, D, D}; pg8::StaticOrder S; S.init(M, D, G, (int)blockIdx.x);
                LAS float* tab = (LAS float*)(lds + pg8::RSTD_TAB_OFF); pg8::fill_rstd_table(tab, SSQ[(3 * L + 1) & 1], S);
                pg8::EpiSoftmax E{T1, SSQ[(3 * L + 1) & 1], (LAS float*)(lds + 131072 + 1024), tab}; pg8::gemm_phase<2>(lds, g, S, E);
            } else if (k == 6) {
                pg8::Gemm g{XB, (const bf16_t*)(ws + WS_W1) + (size_t)L * D * FF, M, FF, D, D, D}; pg8::StaticOrder S; S.init(M, FF, G, (int)blockIdx.x);
                LAS float* tab = (LAS float*)(lds + pg8::RSTD_TAB_OFF); pg8::fill_rstd_table(tab, SSQ[(3 * L + 2) & 1], S);
                pg8::EpiAct<1> E{HB, FF, SSQ[(3 * L + 2) & 1], 1.f, nullptr, nullptr, tab}; pg8::gemm_phase<0>(lds, g, S, E);
            } else {
                pg8::StaticOrder S; S.init(M, D, G, (int)blockIdx.x);
                if (k == 1) {
                    pg8::Gemm g{T1, (const bf16_t*)(ws + WS_PW) + (size_t)j * 4 * 256 * 256, M, D, 256, D, 256};
                    if (L == 0) { pg8::EpiResid<true> E{KP->in[I_X], XB, SSQ[(3 * L + 1) & 1]}; pg8::gemm_phase<1>(lds, g, S, E); }
                    else { pg8::EpiResid<false> E{nullptr, XB, SSQ[(3 * L + 1) & 1]}; pg8::gemm_phase<1>(lds, g, S, E); }
                } else if (k == 5) {
                    pg8::Gemm g{T1, VWO, M, D, D, D, D}; pg8::EpiResid<false> E{nullptr, XB, SSQ[(3 * L + 2) & 1]}; pg8::gemm_phase<2>(lds, g, S, E);
                } else {
                    pg8::Gemm g; int upd;
                    if (k == 2) { g = pg8::Gemm{T1, (const bf16_t*)(ws + WS_WOUT) + (size_t)j * D * D, M, D, D, D, D}; upd = 3 * L; }
                    else        { g = pg8::Gemm{HB, (const bf16_t*)(ws + WS_W2) + (size_t)L * D * FF, M, D, FF, 64, FF}; upd = 3 * L + 2; }
                    pg8::EpiResid<false> E{nullptr, XB, SSQ[(upd + 1) & 1]};
                    if (k == 2) pg8::gemm_phase<0>(lds, g, S, E); else pg8::gemm_phase<5>(lds, g, S, E);
                }
            }
        }
        if (ph + 1 < ph_hi) { if (ph == 0) grid.sync(); else xcd_barrier(bar); }
    }
}

extern "C" void kernel_launch(void* const* d_in, const int* in_sizes, int n_in, void* d_out, int out_size, void* d_ws, size_t ws_size, hipStream_t stream) {
    static int grid = 0;
    if (grid == 0) {
        if (n_in != 20 || in_sizes[0] != M * D || out_size != M * D || ws_size < WS_END) { fprintf(stderr, "kernel_launch: unexpected shapes (n_in %d, in0 %d, out %d, ws %zu); nothing launched\n", n_in, n_in > 0 ? in_sizes[0] : -1, out_size, ws_size); grid = -1; return; }
        int dev = 0, cus = 0, per_cu = 0;
        if (hipGetDevice(&dev) != hipSuccess || hipDeviceGetAttribute(&cus, hipDeviceAttributeMultiprocessorCount, dev) != hipSuccess) { grid = -1; return; }
        if (hipFuncSetAttribute((const void*)fwd_megakernel, hipFuncAttributeMaxDynamicSharedMemorySize, LDS_BYTES) != hipSuccess) { fprintf(stderr, "kernel_launch: hipFuncSetAttribute failed\n"); grid = -1; return; }
        if (hipOccupancyMaxActiveBlocksPerMultiprocessor(&per_cu, (const void*)fwd_megakernel, 512, LDS_BYTES) != hipSuccess || per_cu < 1) { fprintf(stderr, "kernel_launch: occupancy query gave %d\n", per_cu); per_cu = 1; }
        (void)hipGetLastError();
        grid = cus * per_cu;
        if (grid > 256) grid = 256;
        grid &= ~7;
        if (grid < 8) { grid = -1; return; }
    }
    if (grid < 0) return;
    Params p{};
    for (int i = 0; i < 20; ++i) p.in[i] = (const float*)d_in[i];
    p.out = (float*)d_out; p.ws = (unsigned char*)d_ws;
#if MK_SINGLE
    p.ph_lo = 0; p.ph_hi = NPHASES;
    if (hipMemsetAsync((char*)d_ws + WS_CTL, 0, CTL_BYTES, stream) != hipSuccess) { fprintf(stderr, "kernel_launch: memset failed\n"); return; }
    void* args[] = {&p};
    hipError_t e = hipLaunchCooperativeKernel((const void*)fwd_megakernel, dim3(grid), dim3(512), args, LDS_BYTES, stream);
    if (e != hipSuccess) fprintf(stderr, "kernel_launch: cooperative launch failed: %s (grid %d)\n", hipGetErrorString(e), grid);
#else
    for (int ph = 0; ph < NPHASES; ++ph) {
        if (phase_empty(ph)) continue;
        p.ph_lo = ph; p.ph_hi = ph + 1;
        hipLaunchKernelGGL(fwd_megakernel, dim3(grid), dim3(512), LDS_BYTES, stream, p);
    }
#endif
}
```

```cpp
#include <hip/hip_runtime.h>
#include <hip/hip_cooperative_groups.h>
#include <cstdio>
#include <cstdint>
namespace cg = cooperative_groups;

#ifndef MK_SINGLE
#define MK_SINGLE 1
#endif

#define LAS __attribute__((address_space(3)))
typedef unsigned short bf16_t;
typedef short bf16x8 __attribute__((ext_vector_type(8)));
typedef float f32x4 __attribute__((ext_vector_type(4)));
typedef float f32x2 __attribute__((ext_vector_type(2)));
typedef float f32x16 __attribute__((ext_vector_type(16)));
typedef unsigned u32x4 __attribute__((ext_vector_type(4)));
typedef unsigned u32x2 __attribute__((ext_vector_type(2)));

constexpr int D = 1024, BATCH = 16, SEQ = 4096, DEPTH = 4, FF = 4096, NMEM = 256;
constexpr int M = BATCH * SEQ;
constexpr int MR = BATCH * NMEM;
constexpr float EPS = 1e-6f;
constexpr float QSCALE = 0.0625f * 1.4426950408889634f;

constexpr size_t MiB = 1u << 20;
constexpr size_t WS_H = 0, WS_T1 = 0, WS_O = 128 * MiB, WS_Z = 256 * MiB;
constexpr size_t WS_XB = 512 * MiB;
constexpr size_t WS_KVALL = 640 * MiB, WS_MEMB = 704 * MiB;
constexpr size_t WS_SSQ0 = 712 * MiB, WS_SSQ1 = 716 * MiB, WS_VSTAT = 720 * MiB, WS_RSTDMEM = 728 * MiB;
constexpr size_t WS_CTL = 730 * MiB, CTL_BYTES = 16384;
constexpr size_t WS_WQ = 736 * MiB, WS_WO = 744 * MiB, WS_W1 = 752 * MiB, WS_W2 = 784 * MiB, WS_WK = 816 * MiB, WS_WV = 824 * MiB;
constexpr size_t WS_WIN = 832 * MiB, WS_WOUT = 840 * MiB, WS_PW = 844 * MiB;
constexpr size_t WS_MQ = 848 * MiB, WS_VWO = 880 * MiB, WS_END = 912 * MiB;

constexpr int LDS_BYTES = 147456;

struct Params {
    const float* in[20];
    float* out;
    unsigned char* ws;
    int ph_lo, ph_hi;
};

extern __shared__ __attribute__((aligned(16))) unsigned char g_lds[];
constexpr int WIDTAB_OFF = 131072 + 512;
__device__ __forceinline__ int tid_now() {
    unsigned m = ~0u; asm volatile("" : "+s"(m));
    const int lane = (int)__builtin_amdgcn_mbcnt_hi(m, __builtin_amdgcn_mbcnt_lo(m, 0u));
    const unsigned hw = (unsigned)__builtin_amdgcn_s_getreg((5 << 11) | 4) & 63u;
    const int wid = __builtin_amdgcn_readfirstlane(((volatile LAS int*)((LAS unsigned char*)g_lds + WIDTAB_OFF))[hw]);
    return wid * 64 + lane;
}
__device__ __forceinline__ unsigned cvt_pk_bf16(float lo, float hi) { unsigned r; asm volatile("v_cvt_pk_bf16_f32 %0, %1, %2" : "=v"(r) : "v"(lo), "v"(hi)); return r; }
__device__ __forceinline__ float sx(float v, int o, int lane) { return __builtin_bit_cast(float, __builtin_amdgcn_ds_bpermute((lane ^ o) << 2, __builtin_bit_cast(int, v))); }
__device__ __forceinline__ float fq_sum(float s) {
    const unsigned u = __float_as_uint(s);
    const auto r = __builtin_amdgcn_permlane16_swap(u, u, false, false);
    const float t = __uint_as_float(r[0]) + __uint_as_float(r[1]);
    const unsigned v = __float_as_uint(t);
    const auto q = __builtin_amdgcn_permlane32_swap(v, v, false, false);
    return __uint_as_float(q[0]) + __uint_as_float(q[1]);
}
__device__ __forceinline__ float fq_max(float s) {
    const unsigned u = __float_as_uint(s);
    const auto r = __builtin_amdgcn_permlane16_swap(u, u, false, false);
    const float t = fmaxf(__uint_as_float(r[0]), __uint_as_float(r[1]));
    const unsigned v = __float_as_uint(t);
    const auto q = __builtin_amdgcn_permlane32_swap(v, v, false, false);
    return fmaxf(__uint_as_float(q[0]), __uint_as_float(q[1]));
}
__device__ __forceinline__ float wave_sum(float v, int lane) {
#pragma unroll
    for (int o = 1; o < 64; o <<= 1) v += sx(v, o, lane);
    return v;
}
__device__ __forceinline__ f32x2 gelu_tanh2(f32x2 x) {
    const f32x2 u = (x * x) * 0.10294324f + 2.30220820f;
    const f32x2 z = x * u;
    f32x2 e; e.x = __builtin_amdgcn_exp2f(-z.x); e.y = __builtin_amdgcn_exp2f(-z.y);
    const f32x2 d = e + 1.0f;
    f32x2 r; r.x = __builtin_amdgcn_rcpf(d.x); r.y = __builtin_amdgcn_rcpf(d.y);
    return x * r;
}
__device__ __forceinline__ float gelu_tanh(float x) {
    const float y = 0.7978845608028654f * (x + 0.044715f * x * x * x);
    const float e = __builtin_amdgcn_exp2f(-2.0f * 1.4426950408889634f * y);
    return x * __builtin_amdgcn_rcpf(1.0f + e);
}

namespace pg8 {
constexpr int BM = 256, BK = 64, HALF = 128, HTB = HALF * BK * 2, STAGE_BYTES = 8 * HTB, NXCD = 8, WGM = 8;
__host__ __device__ __forceinline__ int lds_byte(int r, int c) { const int st = (r >> 4) * 2 + (c >> 5), rr = r & 15, cc = c & 31, ob = rr * 64 + cc * 2; return st * 1024 + (ob ^ (((ob >> 9) & 1) << 5)); }
__host__ __device__ __forceinline__ void stage_rc(int b, int& R, int& C) { const int st = b / 1024, sb = b % 1024, swz = sb ^ (((sb >> 9) & 1) << 5); R = (st >> 1) * 16 + swz / 64; C = (st & 1) * 32 + (swz % 64) / 2; }
__host__ __device__ __forceinline__ int perm32(int rho) { const int n = rho >> 4, i = rho & 15; return 8 * (i >> 2) + 4 * n + (i & 3); }

struct Unit { int pm, pn, pidx; };
struct Gemm { const bf16_t* A; const bf16_t* Bt; int M, N, K, lda, ldb; };
template <int KIND> __device__ __forceinline__ const char* unitA(const Gemm& g, int pm, int pn, size_t tstepA) {
    size_t off = (size_t)((KIND == 3) ? (pm & 15) : pm) * tstepA;
    if (KIND == 1) off += (size_t)pn * 512; if (KIND == 3) off += (size_t)(pm >> 4) * 512; if (KIND == 4) off += (size_t)(pn >> 4) * 512;
    return (const char*)g.A + off;
}
template <int KIND> __device__ __forceinline__ const char* unitB(const Gemm& g, int pm, int pn, size_t tstepB) {
    size_t off = (size_t)((KIND == 4) ? (pn & 15) : pn) * tstepB;
    if (KIND == 2) off += (size_t)(pm >> 4) * 2097152; if (KIND == 3) off += (size_t)(pm >> 4) * 512; if (KIND == 4) off += (size_t)(pn >> 4) * 512;
    return (const char*)g.Bt + off;
}

struct StaticOrder {
    int nM, nN, nwg, G, c;
    __device__ void init(int M_, int N_, int G_, int c_) { nM = M_ / BM; nN = N_ / BM; nwg = nM * nN; G = G_; c = c_; }
    __device__ bool next(int i, Unit& u) const {
        const long L = (long)i * G + c; if (L >= nwg) return false;
        int wgid = (int)L; { const int q = nwg / NXCD, r = nwg % NXCD, xcd = wgid % NXCD, off = wgid / NXCD; wgid = (xcd < r ? xcd * (q + 1) : r * (q + 1) + (xcd - r) * q) + off; }
        const int nig = WGM * nN, gid = wgid / nig, fm = gid * WGM, gsz = (nM - fm) < WGM ? (nM - fm) : WGM;
        u.pm = fm + ((wgid % nig) % gsz); u.pn = (wgid % nig) / gsz; return true;
    }
};

__device__ __forceinline__ float rstd_from_slots(const float* ssq, int row, int fq, int lane) {
    const f32x4 v = *(const f32x4*)(ssq + (size_t)row * 16 + fq * 4);
    float s = (v[0] + v[1]) + (v[2] + v[3]);
    s = fq_sum(s); (void)lane;
    return __builtin_amdgcn_rsqf(s * (1.0f / 1024.0f) + EPS);
}

constexpr int RSTD_TAB_OFF = 140288;
__device__ __forceinline__ void fill_rstd_table(LAS float* tab, const float* ssq, const StaticOrder& S) {
    int t = tid_now(); asm volatile("" : "+v"(t));
    Unit u; int d = 0, last = -1, p0 = -1, p1 = -1, p2 = -1, p3 = -1;
    for (int i = 0; S.next(i, u); ++i) if (u.pm != last) { if (d == 0) p0 = u.pm; else if (d == 1) p1 = u.pm; else if (d == 2) p2 = u.pm; else if (d == 3) p3 = u.pm; ++d; last = u.pm; }
#pragma unroll
    for (int k = 0; k < 2; ++k) {
        const int e = (t >> 8) + 2 * k, pm = (e == 0) ? p0 : (e == 1) ? p1 : (e == 2) ? p2 : p3;
        if (pm >= 0) { const f32x4* p = (const f32x4*)(ssq + (size_t)(pm * BM + (t & 255)) * 16); const f32x4 a = p[0], b = p[1], c = p[2], dd = p[3];
            const float s = (((a[0] + a[1]) + (a[2] + a[3])) + ((b[0] + b[1]) + (b[2] + b[3]))) + (((c[0] + c[1]) + (c[2] + c[3])) + ((dd[0] + dd[1]) + (dd[2] + dd[3])));
            tab[e * 256 + (t & 255)] = __builtin_amdgcn_rsqf(s * (1.0f / 1024.0f) + EPS); }
    }
    __syncthreads();
}
template <int MODE> struct EpiAct {
    bf16_t* O; int ldc; const float* ssq; float scale; const float* rvec; float* vstat; LAS float* tab;
    __device__ __forceinline__ void operator()(const f32x4 (&acc)[2][2][4][2], const Unit& u, int, int, int, int) const {
        int t_ = tid_now(); asm volatile("" : "+v"(t_));
        const int wid_ = __builtin_amdgcn_readfirstlane(t_ >> 6), wr = wid_ >> 2, wc = wid_ & 3, fr = t_ & 15, fq = (t_ & 63) >> 4;
        const int row0 = u.pm * BM + wr * 64 + fr, col0 = u.pn * BM + wc * 32 + 8 * fq;
        f32x4 cs[2][2];
        if (MODE == 3) {
#pragma unroll
            for (int bj = 0; bj < 2; ++bj) { cs[bj][0] = *(const f32x4*)(rvec + col0 + bj * HALF); cs[bj][1] = *(const f32x4*)(rvec + col0 + bj * HALF + 4); }
        }
#pragma unroll
        for (int ai = 0; ai < 2; ++ai)
#pragma unroll
            for (int m = 0; m < 4; ++m) {
                const int row = row0 + ai * HALF + m * 16;
                float rs = 1.f;
                if (MODE == 0 || MODE == 1 || MODE == 2) rs = (tab != nullptr && u.pidx < 4) ? tab[u.pidx * 256 + (row - u.pm * BM)] : rstd_from_slots(ssq, row, fq, fq * 16 + fr);
                if (MODE == 0) rs *= scale;
                if (MODE == 4) rs = rvec[row];
                bf16_t* rowp = O + (size_t)row * ldc + col0;
                if (MODE == 5) { const int rl = row - u.pm * BM; rowp = O + ((size_t)(u.pm & 15) << 20) + (size_t)((u.pm >> 4) * 256 + rl) * 1024 + col0; rs = scale; }
                if (MODE == 6) { rowp = O + ((size_t)(u.pn & 15) << 20) + (size_t)row * 1024 + (u.pn >> 4) * 256 + (col0 - u.pn * BM); }
                float s1 = 0.f, s2 = 0.f;
#pragma unroll
                for (int bj = 0; bj < 2; ++bj) {
                    f32x4 v0 = acc[ai][bj][m][0] * rs, v1 = acc[ai][bj][m][1] * rs;
                    if (MODE == 3) { v0 = acc[ai][bj][m][0] * cs[bj][0]; v1 = acc[ai][bj][m][1] * cs[bj][1]; }
                    if (MODE == 1) {
#pragma unroll
                        for (int j = 0; j < 4; ++j) { const float a = v0[j] > 0.f ? v0[j] : 0.f, b = v1[j] > 0.f ? v1[j] : 0.f; v0[j] = a * a; v1[j] = b * b; }
                    }
                    if (MODE == 2) {
#pragma unroll
                        for (int j = 0; j < 4; j += 2) { const f32x2 a = gelu_tanh2((f32x2){v0[j], v0[j + 1]}), b = gelu_tanh2((f32x2){v1[j], v1[j + 1]}); v0[j] = a.x; v0[j + 1] = a.y; v1[j] = b.x; v1[j + 1] = b.y; }
#pragma unroll
                        for (int j = 0; j < 4; ++j) { s1 += v0[j] + v1[j]; s2 += v0[j] * v0[j] + v1[j] * v1[j]; }
                    }
                    u32x4 w; w.x = cvt_pk_bf16(v0[0], v0[1]); w.y = cvt_pk_bf16(v0[2], v0[3]); w.z = cvt_pk_bf16(v1[0], v1[1]); w.w = cvt_pk_bf16(v1[2], v1[3]);
                    bf16_t* sp = rowp + bj * HALF;
                    if (MODE == 1) { const int col = col0 + bj * HALF; sp = O + (((size_t)(u.pm * (ldc >> 6) + (col >> 6)) * BM + (row - u.pm * BM)) << 6) + (col & 63); }
                    __builtin_nontemporal_store(w, (u32x4*)sp);
                }
                if (MODE == 2) {
                    s1 = fq_sum(s1); s2 = fq_sum(s2);
                    if (u.pn >= 4 && fq == 0) { vstat[(size_t)row * 32 + (u.pn - 4) * 4 + wc] = s1; vstat[(size_t)row * 32 + 16 + (u.pn - 4) * 4 + wc] = s2; }
                }
            }
    }
};
struct EpiSoftmax {
    bf16_t* O; const float* ssq; LAS float* red; LAS float* tab;
    __device__ __forceinline__ void operator()(f32x4 (&acc)[2][2][4][2], const Unit& u, int, int, int, int) const {
        int t_ = tid_now(); asm volatile("" : "+v"(t_));
        const int wid_ = __builtin_amdgcn_readfirstlane(t_ >> 6), wr = wid_ >> 2, wc = wid_ & 3, fr = t_ & 15, fq = (t_ & 63) >> 4;
        const int row0 = u.pm * BM + wr * 64 + fr, col0 = u.pn * BM + wc * 32 + 8 * fq, lane = fq * 16 + fr;
#pragma unroll
        for (int ai = 0; ai < 2; ++ai)
#pragma unroll
            for (int m = 0; m < 4; ++m) {
                const int rl = ai * HALF + wr * 64 + m * 16 + fr;
                const float rs = (tab != nullptr && u.pidx < 4) ? tab[u.pidx * 256 + rl] : rstd_from_slots(ssq, u.pm * BM + rl, fq, lane);
                float mx = -3.0e38f;
#pragma unroll
                for (int bj = 0; bj < 2; ++bj)
#pragma unroll
                    for (int n = 0; n < 2; ++n) { acc[ai][bj][m][n] = acc[ai][bj][m][n] * rs;
#pragma unroll
                        for (int j = 0; j < 4; ++j) mx = fmaxf(mx, acc[ai][bj][m][n][j]); }
                mx = fq_max(mx);
                if (fq == 0) red[rl * 4 + wc] = mx;
            }
        asm volatile("s_waitcnt lgkmcnt(0)" ::: "memory"); __builtin_amdgcn_s_barrier(); asm volatile("" ::: "memory");
#pragma unroll
        for (int ai = 0; ai < 2; ++ai)
#pragma unroll
            for (int m = 0; m < 4; ++m) {
                const int rl = ai * HALF + wr * 64 + m * 16 + fr;
                const f32x4 r4 = *(const LAS f32x4*)(red + rl * 4);
                const float mx = fmaxf(fmaxf(r4[0], r4[1]), fmaxf(r4[2], r4[3]));
                float sm = 0.f;
#pragma unroll
                for (int bj = 0; bj < 2; ++bj)
#pragma unroll
                    for (int n = 0; n < 2; ++n)
#pragma unroll
                        for (int j = 0; j < 4; ++j) { const float e = __builtin_amdgcn_exp2f(acc[ai][bj][m][n][j] - mx); acc[ai][bj][m][n][j] = e; sm += e; }
                sm = fq_sum(sm);
                if (fq == 0) red[1024 + rl * 4 + wc] = sm;
            }
        asm volatile("s_waitcnt lgkmcnt(0)" ::: "memory"); __builtin_amdgcn_s_barrier(); asm volatile("" ::: "memory");
#pragma unroll
        for (int ai = 0; ai < 2; ++ai)
#pragma unroll
            for (int m = 0; m < 4; ++m) {
                const int rl = ai * HALF + wr * 64 + m * 16 + fr;
                const f32x4 r4 = *(const LAS f32x4*)(red + 1024 + rl * 4);
                const float inv = 1.0f / ((r4[0] + r4[1]) + (r4[2] + r4[3]));
                bf16_t* rowp = O + (size_t)(row0 + ai * HALF + m * 16) * D + col0;
#pragma unroll
                for (int bj = 0; bj < 2; ++bj) {
                    const f32x4 v0 = acc[ai][bj][m][0] * inv, v1 = acc[ai][bj][m][1] * inv;
                    u32x4 w; w.x = cvt_pk_bf16(v0[0], v0[1]); w.y = cvt_pk_bf16(v0[2], v0[3]); w.z = cvt_pk_bf16(v1[0], v1[1]); w.w = cvt_pk_bf16(v1[2], v1[3]);
                    __builtin_nontemporal_store(w, (u32x4*)(rowp + bj * HALF));
                }
            }
    }
};
template <bool F32IN> struct EpiResid {
    const float* xin; bf16_t* xb; float* ssq;
    __device__ __forceinline__ void operator()(const f32x4 (&acc)[2][2][4][2], const Unit& u, int, int, int, int) const {
        int t_ = tid_now(); asm volatile("" : "+v"(t_));
        const int wid_ = __builtin_amdgcn_readfirstlane(t_ >> 6), wr = wid_ >> 2, wc = wid_ & 3, fr = t_ & 15, fq = (t_ & 63) >> 4;
        const int row0 = u.pm * BM + wr * 64 + fr, col0 = u.pn * BM + wc * 32 + 8 * fq;
#pragma unroll
        for (int ai = 0; ai < 2; ++ai)
#pragma unroll
            for (int m = 0; m < 4; ++m) {
                const int row = row0 + ai * HALF + m * 16; const size_t off = (size_t)row * D + col0;
                float ss = 0.f;
#pragma unroll
                for (int bj = 0; bj < 2; ++bj) {
                    f32x4 a0, a1;
                    if (F32IN) { a0 = *(const f32x4*)(xin + off + bj * HALF); a1 = *(const f32x4*)(xin + off + bj * HALF + 4); }
                    else { const u32x4 r = *(const u32x4*)(xb + off + bj * HALF);
                        a0 = (f32x4){__uint_as_float(r.x << 16), __uint_as_float(r.x & 0xffff0000u), __uint_as_float(r.y << 16), __uint_as_float(r.y & 0xffff0000u)};
                        a1 = (f32x4){__uint_as_float(r.z << 16), __uint_as_float(r.z & 0xffff0000u), __uint_as_float(r.w << 16), __uint_as_float(r.w & 0xffff0000u)}; }
                    const f32x4 v0 = a0 + acc[ai][bj][m][0], v1 = a1 + acc[ai][bj][m][1];
                    u32x4 w; w.x = cvt_pk_bf16(v0[0], v0[1]); w.y = cvt_pk_bf16(v0[2], v0[3]); w.z = cvt_pk_bf16(v1[0], v1[1]); w.w = cvt_pk_bf16(v1[2], v1[3]);
                    __builtin_nontemporal_store(w, (u32x4*)(xb + off + bj * HALF));
                    const unsigned ww[4] = {w.x, w.y, w.z, w.w};
#pragma unroll
                    for (int j = 0; j < 4; ++j) { const float lo = __uint_as_float(ww[j] << 16), hi = __uint_as_float(ww[j] & 0xffff0000u); ss += lo * lo + hi * hi; }
                }
                ss = fq_sum(ss);
                if (fq == 0) ssq[(size_t)row * 16 + u.pn * 4 + wc] = ss;
                asm volatile("" ::: "memory");
            }
    }
};

template <int KIND, class Epi>
__device__ __forceinline__ void gemm_phase(LAS unsigned char* lds, const Gemm g, const StaticOrder& S, const Epi& E) {
    int tid_ = tid_now(); asm volatile("" : "+v"(tid_));
    const int tid = tid_, wid = __builtin_amdgcn_readfirstlane(tid >> 6), lane = tid & 63, wr = wid >> 2, wc = wid & 3, fr = lane & 15, fq = lane >> 4;
    const int nt = g.K / BK;
    unsigned voffA[2], voffB[2];
#pragma unroll
    for (int i = 0; i < 2; ++i) { int R, C; stage_rc(tid * 16 + i * 8192, R, C); const int Rb = (R & ~31) + perm32(R & 31);
        voffA[i] = (unsigned)(R * g.lda + C) * 2u; voffB[i] = (unsigned)(Rb * g.ldb + C) * 2u; }
    const size_t kstep = (size_t)(BK * 2), kstepA = (KIND == 5) ? (size_t)(BM * BK * 2) : kstep;
    const size_t hstepA = (size_t)HALF * g.lda * 2, hstepB = (size_t)HALF * g.ldb * 2;
    const size_t tstepA = (KIND == 5) ? (size_t)g.K * BM * 2 : 2 * hstepA, tstepB = 2 * hstepB;
    const unsigned ldsw = (unsigned)wid * 1024u;
    const int aoff = lds_byte(wr * 64 + fr, fq * 8), boff = lds_byte(wc * 32 + fr, fq * 8);
#define PG8_SA(b, h) (((b) * 2 + (h)) * HTB)
#define PG8_SB(b, h) ((4 + (b) * 2 + (h)) * HTB)
#define PG8_STAGE(bufoff, gbase, voff) do { _Pragma("unroll") for (int _i = 0; _i < 2; ++_i) \
        __builtin_amdgcn_global_load_lds((const unsigned*)((const char*)(gbase) + (voff)[_i]), (LAS unsigned*)(lds + (bufoff) + ldsw + _i * 8192), 16, 0, 0); } while (0)
#define PG8_LDA(dst, b, h) do { _Pragma("unroll") for (int m = 0; m < 4; ++m) _Pragma("unroll") for (int k = 0; k < 2; ++k) dst[m][k] = *(const LAS bf16x8*)(lds + PG8_SA(b, h) + aoff + m * 2048 + k * 1024); } while (0)
#define PG8_LDB(dst, b, h) do { _Pragma("unroll") for (int n = 0; n < 2; ++n) _Pragma("unroll") for (int k = 0; k < 2; ++k) dst[n][k] = *(const LAS bf16x8*)(lds + PG8_SB(b, h) + boff + n * 2048 + k * 1024); } while (0)
#define PG8_MMA(ai, bj, At, Bt) do { __builtin_amdgcn_s_setprio(1); _Pragma("unroll") for (int m = 0; m < 4; ++m) _Pragma("unroll") for (int n = 0; n < 2; ++n) _Pragma("unroll") for (int k = 0; k < 2; ++k) \
        acc[ai][bj][m][n] = __builtin_amdgcn_mfma_f32_16x16x32_bf16(Bt[n][k], At[m][k], acc[ai][bj][m][n], 0, 0, 0); __builtin_amdgcn_s_setprio(0); } while (0)
#define PG8_WAIT_V(n) asm volatile("s_waitcnt vmcnt(" #n ")" ::: "memory")
#define PG8_WAIT_L(n) asm volatile("s_waitcnt lgkmcnt(" #n ")" ::: "memory")
#define PG8_BAR __builtin_amdgcn_s_barrier()
#define PG8_SCHED __builtin_amdgcn_sched_barrier(0)
    Unit cur, nxt; int ui = 0;
    if (!S.next(0, cur)) return;
    cur.pidx = 0;
    f32x4 acc[2][2][4][2];
#pragma unroll
    for (int a = 0; a < 2; ++a)
#pragma unroll
        for (int b = 0; b < 2; ++b)
#pragma unroll
            for (int m = 0; m < 4; ++m)
#pragma unroll
                for (int n = 0; n < 2; ++n) acc[a][b][m][n] = (f32x4){0.f, 0.f, 0.f, 0.f};
    bf16x8 At[4][2], B0[2][2], B1[2][2];
    const char* cA = unitA<KIND>(g, cur.pm, cur.pn, tstepA); const char* cB = unitB<KIND>(g, cur.pm, cur.pn, tstepB);
    PG8_STAGE(PG8_SB(0, 0), cB, voffB); PG8_STAGE(PG8_SB(0, 1), cB + hstepB, voffB); PG8_STAGE(PG8_SA(0, 0), cA, voffA); PG8_STAGE(PG8_SA(0, 1), cA + hstepA, voffA);
    if (wr == 1) PG8_BAR;
    PG8_WAIT_V(2); PG8_BAR;
    PG8_STAGE(PG8_SB(1, 0), cB + kstep, voffB); PG8_STAGE(PG8_SA(1, 0), cA + kstepA, voffA); PG8_STAGE(PG8_SB(1, 1), cB + hstepB + kstep, voffB);
    PG8_WAIT_V(6); PG8_BAR;
    for (;;) {
        const bool has_next = S.next(ui + 1, nxt);
        nxt.pidx = (has_next && nxt.pm != cur.pm) ? cur.pidx + 1 : cur.pidx;
        const char* nA = has_next ? unitA<KIND>(g, nxt.pm, nxt.pn, tstepA) : cA; const char* nB = has_next ? unitB<KIND>(g, nxt.pm, nxt.pn, tstepB) : cB;
        for (int t = 0; t < nt; t += 2) {
            const bool last = (t == nt - 2);
            const char* a1 = cA + (size_t)(t + 1) * kstepA;
            const char* a2 = last ? nA : cA + (size_t)(t + 2) * kstepA; const char* b2 = last ? nB : cB + (size_t)(t + 2) * kstep;
            const char* a3 = a2 + kstepA; const char* b3 = b2 + kstep;
            PG8_LDB(B0, 0, 0); PG8_LDB(B1, 0, 1); PG8_SCHED; PG8_LDA(At, 0, 0); PG8_STAGE(PG8_SA(1, 1), a1 + hstepA, voffA);
            PG8_WAIT_V(8); PG8_WAIT_L(0); PG8_BAR; PG8_MMA(0, 0, At, B0); PG8_MMA(0, 1, At, B1); PG8_BAR; PG8_SCHED;
            PG8_LDA(At, 0, 1); PG8_STAGE(PG8_SB(0, 0), b2, voffB); PG8_STAGE(PG8_SB(0, 1), b2 + hstepB, voffB); PG8_STAGE(PG8_SA(0, 0), a2, voffA);
            PG8_WAIT_V(8); PG8_WAIT_L(0); PG8_BAR; PG8_MMA(1, 0, At, B0); PG8_MMA(1, 1, At, B1); PG8_BAR; PG8_SCHED;
            PG8_LDB(B0, 1, 0); PG8_LDB(B1, 1, 1); PG8_SCHED; PG8_LDA(At, 1, 0); PG8_STAGE(PG8_SA(0, 1), a2 + hstepA, voffA);
            PG8_WAIT_V(8); PG8_WAIT_L(0); PG8_BAR; PG8_MMA(0, 0, At, B0); PG8_MMA(0, 1, At, B1); PG8_BAR; PG8_SCHED;
            PG8_LDA(At, 1, 1); PG8_STAGE(PG8_SB(1, 0), b3, voffB); PG8_STAGE(PG8_SB(1, 1), b3 + hstepB, voffB); PG8_STAGE(PG8_SA(1, 0), a3, voffA);
            PG8_WAIT_V(8); PG8_WAIT_L(0); PG8_BAR; PG8_MMA(1, 0, At, B0); PG8_MMA(1, 1, At, B1); PG8_BAR; PG8_SCHED;
        }
        if (wr == 0) PG8_BAR;
        E(acc, cur, wr, wc, fr, fq);
        if (!has_next) break;
#pragma unroll
        for (int a = 0; a < 2; ++a)
#pragma unroll
            for (int b = 0; b < 2; ++b)
#pragma unroll
                for (int m = 0; m < 4; ++m)
#pragma unroll
                    for (int n = 0; n < 2; ++n) acc[a][b][m][n] = (f32x4){0.f, 0.f, 0.f, 0.f};
        cur = nxt; cA = nA; cB = nB; ++ui;
        if (wr == 1) PG8_BAR;
    }
    PG8_WAIT_V(0);
    PG8_BAR;
#undef PG8_SA
#undef PG8_SB
#undef PG8_STAGE
#undef PG8_LDA
#undef PG8_LDB
#undef PG8_MMA
#undef PG8_WAIT_V
#undef PG8_WAIT_L
#undef PG8_BAR
#undef PG8_SCHED
}
}

struct MatDesc { const float* src; int ldw, K, N; bf16_t* dst; int ldt; const float* ks; const float* ns; };

__device__ __forceinline__ void transpose_item(const MatDesc& d, LAS float* scr, int item, int lane) {
    const int nblk = d.N / 32, kb = item / nblk, nb = item % nblk, k0 = 64 * kb, n0 = 32 * nb;
    const int n4 = lane & 7, rr = lane >> 3;
    f32x4 nsv = (f32x4){1.f, 1.f, 1.f, 1.f};
    if (d.ns) nsv = *(const f32x4*)(d.ns + n0 + 4 * n4);
    f32x4 v[8];
#pragma unroll
    for (int j = 0; j < 8; ++j) v[j] = *(const f32x4*)(d.src + (size_t)(k0 + rr + 8 * j) * d.ldw + n0 + 4 * n4);
#pragma unroll
    for (int j = 0; j < 8; ++j) { const int kk = rr + 8 * j; f32x4 w = v[j] * nsv; if (d.ks) w = w * d.ks[k0 + kk];
        scr[kk * 33 + 4 * n4 + 0] = w[0]; scr[kk * 33 + 4 * n4 + 1] = w[1]; scr[kk * 33 + 4 * n4 + 2] = w[2]; scr[kk * 33 + 4 * n4 + 3] = w[3]; }
    asm volatile("s_waitcnt lgkmcnt(0)" ::: "memory");
    const int c = lane & 7;
#pragma unroll
    for (int j = 0; j < 4; ++j) { const int n = (lane >> 3) + 8 * j; const LAS float* s = scr + (8 * c) * 33 + n;
        u32x4 o; o.x = cvt_pk_bf16(s[0 * 33], s[1 * 33]); o.y = cvt_pk_bf16(s[2 * 33], s[3 * 33]); o.z = cvt_pk_bf16(s[4 * 33], s[5 * 33]); o.w = cvt_pk_bf16(s[6 * 33], s[7 * 33]);
        *(u32x4*)(d.dst + (size_t)(n0 + n) * d.ldt + k0 + 8 * c) = o; }
    asm volatile("s_waitcnt lgkmcnt(0)" ::: "memory");
}

enum { I_X = 0, I_MEM, I_G_MIX, I_G_MEM, I_G_MEMKV, I_G_FFN, I_G_FINAL, I_POOL_W, I_POOL_SCALE, I_SGU_WIN, I_SGU_LNG, I_SGU_LNB, I_SGU_WS, I_SGU_BS, I_SGU_WOUT, I_WQ, I_WKV, I_WO, I_W1, I_W2 };

__device__ __forceinline__ MatDesc get_mat(const Params& P, int id) {
    MatDesc d; d.ks = nullptr; d.ns = nullptr;
    unsigned char* ws = P.ws;
    if (id < 24) {
        const int L = id / 6, t = id % 6;
        if (t == 0)      { d.src = P.in[I_WQ] + (size_t)L * D * D; d.ldw = D; d.K = D; d.N = D; d.dst = (bf16_t*)(ws + WS_WQ) + (size_t)L * D * D; d.ldt = D; d.ks = P.in[I_G_MEM] + L * D; }
        else if (t == 1) { d.src = P.in[I_WKV] + (size_t)L * D * 2 * D; d.ldw = 2 * D; d.K = D; d.N = D; d.dst = (bf16_t*)(ws + WS_WK) + (size_t)L * D * D; d.ldt = D; d.ks = P.in[I_G_MEMKV] + L * D; }
        else if (t == 2) { d.src = P.in[I_WKV] + (size_t)L * D * 2 * D + D; d.ldw = 2 * D; d.K = D; d.N = D; d.dst = (bf16_t*)(ws + WS_WV) + (size_t)L * D * D; d.ldt = D; d.ks = P.in[I_G_MEMKV] + L * D; }
        else if (t == 3) { d.src = P.in[I_WO] + (size_t)L * D * D; d.ldw = D; d.K = D; d.N = D; d.dst = (bf16_t*)(ws + WS_WO) + (size_t)L * D * D; d.ldt = D; }
        else if (t == 4) { d.src = P.in[I_W1] + (size_t)L * D * FF; d.ldw = FF; d.K = D; d.N = FF; d.dst = (bf16_t*)(ws + WS_W1) + (size_t)L * D * FF; d.ldt = D; d.ks = P.in[I_G_FFN] + L * D; }
        else             { d.src = P.in[I_W2] + (size_t)L * D * FF; d.ldw = D; d.K = FF; d.N = D; d.dst = (bf16_t*)(ws + WS_W2) + (size_t)L * D * FF; d.ldt = FF; }
    } else if (id < 28) {
        const int j = (id - 24) >> 1, t = (id - 24) & 1;
        if (t == 0) { d.src = P.in[I_SGU_WIN] + (size_t)j * D * 2 * D; d.ldw = 2 * D; d.K = D; d.N = 2 * D; d.dst = (bf16_t*)(ws + WS_WIN) + (size_t)j * D * 2 * D; d.ldt = D; d.ks = P.in[I_G_MIX] + (2 * j + 1) * D; }
        else        { d.src = P.in[I_SGU_WOUT] + (size_t)j * D * D; d.ldw = D; d.K = D; d.N = D; d.dst = (bf16_t*)(ws + WS_WOUT) + (size_t)j * D * D; d.ldt = D; }
    } else {
        const int jg = id - 28, j = jg >> 2, g = jg & 3;
        d.src = P.in[I_POOL_W] + (size_t)jg * 256 * 256; d.ldw = 256; d.K = 256; d.N = 256; d.dst = (bf16_t*)(ws + WS_PW) + (size_t)jg * 256 * 256; d.ldt = 256;
        d.ks = P.in[I_G_MIX] + (2 * j) * D + g * 256; d.ns = P.in[I_POOL_SCALE] + j * D + g * 256;
    }
    return d;
}
__device__ __forceinline__ int mat_items(int id) {
    if (id < 24) { const int t = id % 6; return (t == 0) ? 0 : ((t >= 4) ? 2048 : 512); }
    if (id < 28) return ((id - 24) & 1) ? 512 : 1024;
    return 32;
}

__device__ __forceinline__ void prologue_phase(const Params& P, LAS unsigned char* lds, int G) {
    int tid_ = tid_now(); asm volatile("" : "+v"(tid_));
    const int tid = tid_, lane = tid & 63, wave = __builtin_amdgcn_readfirstlane(tid >> 6);
    LAS float* scr = (LAS float*)(lds + wave * 16384);
    const int gw = blockIdx.x * 8 + wave, NGW = G * 8;
    constexpr int NITEMS = 4 * (3 * 512 + 2 * 2048) + 2 * (1024 + 512) + 8 * 32;
    for (int it = gw; it < NITEMS; it += NGW) {
        int r = it, id = 0;
        for (; id < 36; ++id) { const int n = mat_items(id); if (r < n) break; r -= n; }
        const MatDesc d = get_mat(P, id);
        transpose_item(d, scr, r, lane);
    }
    { const float* wq = P.in[I_WQ]; const float* gq = P.in[I_G_MEM]; bf16_t* wqb = (bf16_t*)(P.ws + WS_WQ);
      for (int r = gw; r < DEPTH * D; r += NGW) { const float gk = gq[r]; const f32x4* xr = (const f32x4*)(wq + (size_t)r * D) + lane; u32x2* o = (u32x2*)(wqb + (size_t)r * D) + lane;
#pragma unroll
        for (int j = 0; j < 4; ++j) { const f32x4 v = xr[64 * j] * gk; u32x2 w; w.x = cvt_pk_bf16(v[0], v[1]); w.y = cvt_pk_bf16(v[2], v[3]); o[64 * j] = w; } } }
    const float* mem = P.in[I_MEM]; bf16_t* memb = (bf16_t*)(P.ws + WS_MEMB); float* rstd_mem = (float*)(P.ws + WS_RSTDMEM);
    for (int r = gw; r < MR; r += NGW) {
        const f32x4* xr = (const f32x4*)(mem + (size_t)r * D) + lane; f32x4 v[4]; float s = 0.f;
#pragma unroll
        for (int j = 0; j < 4; ++j) { v[j] = xr[64 * j]; s += (v[j][0] * v[j][0] + v[j][1] * v[j][1]) + (v[j][2] * v[j][2] + v[j][3] * v[j][3]); }
        s = wave_sum(s, lane);
        if (lane == 0) rstd_mem[r] = 1.0f / sqrtf(s * (1.0f / D) + EPS);
        u32x2* o = (u32x2*)(memb + (size_t)r * D) + lane;
#pragma unroll
        for (int j = 0; j < 4; ++j) { u32x2 w; w.x = cvt_pk_bf16(v[j][0], v[j][1]); w.y = cvt_pk_bf16(v[j][2], v[j][3]); o[64 * j] = w; }
    }
    const float* x = P.in[I_X]; float* ssq0 = (float*)(P.ws + WS_SSQ0);
    for (int r = gw; r < M; r += 2 * NGW) {
        const int r1 = (r + NGW < M) ? r + NGW : r;
        f32x4 va[4], vb[4];
#pragma unroll
        for (int j = 0; j < 4; ++j) { va[j] = ((const f32x4*)(x + (size_t)r * D) + lane)[64 * j]; vb[j] = ((const f32x4*)(x + (size_t)r1 * D) + lane)[64 * j]; }
        float s = 0.f, t = 0.f;
#pragma unroll
        for (int j = 0; j < 4; ++j) { s += (va[j][0] * va[j][0] + va[j][1] * va[j][1]) + (va[j][2] * va[j][2] + va[j][3] * va[j][3]); t += (vb[j][0] * vb[j][0] + vb[j][1] * vb[j][1]) + (vb[j][2] * vb[j][2] + vb[j][3] * vb[j][3]); }
        s = wave_sum(s, lane); t = wave_sum(t, lane);
        if (lane < 16) { ssq0[(size_t)r * 16 + lane] = (lane == 0) ? s : 0.f; if (r1 != r) ssq0[(size_t)r1 * 16 + lane] = (lane == 0) ? t : 0.f; }
    }
}

template <int W>
__device__ __forceinline__ void pool_block(const f32x2 (&prev)[16], const f32x2 (&cur)[16], bool seq_start, bf16_t* outp  ) {
#pragma unroll
    for (int i = 0; i < 16; ++i) {
        f32x2 s = cur[i];
#pragma unroll
        for (int j = 1; j < W; ++j) { s += (i - j >= 0) ? cur[(i - j) & 15] : prev[(16 + i - j) & 15]; }
        float inv = 1.0f / (float)W;
        if (i < W - 1 && seq_start) inv = 1.0f / (float)(i + 1);
        const f32x2 o = s * inv - cur[i];
        *(unsigned*)(outp + (size_t)i * D) = cvt_pk_bf16(o[0], o[1]);
    }
}
template <bool F32IN> __device__ __forceinline__ f32x2 pool_ld(const void* x, size_t idx) {
    if (F32IN) return *(const f32x2*)((const float*)x + idx);
    const unsigned r = *(const unsigned*)((const bf16_t*)x + idx); return (f32x2){__uint_as_float(r << 16), __uint_as_float(r & 0xffff0000u)};
}
template <bool F32IN>
__device__ __forceinline__ void pool_a_phase(LAS unsigned char* lds, const void* x, const float* ssq, bf16_t* PA, int G) {
    LAS float* rs = (LAS float*)lds;
    int tid_ = tid_now(); asm volatile("" : "+v"(tid_));
    const int tid = tid_, ch = 2 * tid, group = __builtin_amdgcn_readfirstlane(tid >> 7);
    for (int chunk = blockIdx.x; chunk < M / 64; chunk += G) {
        const int t0 = chunk * 64; const bool sstart = (t0 & (SEQ - 1)) == 0;
        __syncthreads();
        if (tid < 80) {
            float r = 0.f;
            if (!(sstart && tid < 16)) { const f32x4* p = (const f32x4*)(ssq + (size_t)(t0 - 16 + tid) * 16); const f32x4 a = p[0], b = p[1], c = p[2], d = p[3];
                const float s = (((a[0] + a[1]) + (a[2] + a[3])) + ((b[0] + b[1]) + (b[2] + b[3]))) + (((c[0] + c[1]) + (c[2] + c[3])) + ((d[0] + d[1]) + (d[2] + d[3])));
                r = 1.0f / sqrtf(s * (1.0f / D) + EPS); }
            rs[tid] = r;
        }
        __syncthreads();
        f32x2 prev[16], cur[16];
        if (sstart) {
#pragma unroll
            for (int i = 0; i < 16; ++i) prev[i] = (f32x2){0.f, 0.f};
        } else {
#pragma unroll
            for (int i = 0; i < 16; ++i) prev[i] = pool_ld<F32IN>(x, (size_t)(t0 - 16 + i) * D + ch) * rs[i];
        }
        for (int blk = 0; blk < 4; ++blk) {
#pragma unroll
            for (int i = 0; i < 16; ++i) cur[i] = pool_ld<F32IN>(x, (size_t)(t0 + blk * 16 + i) * D + ch) * rs[16 + blk * 16 + i];
            bf16_t* outp = PA + (size_t)(t0 + blk * 16) * D + ch;
            const bool ss = sstart && blk == 0;
            if (group == 0) pool_block<2>(prev, cur, ss, outp);
            else if (group == 1) pool_block<4>(prev, cur, ss, outp);
            else if (group == 2) pool_block<8>(prev, cur, ss, outp);
            else pool_block<16>(prev, cur, ss, outp);
#pragma unroll
            for (int i = 0; i < 16; ++i) prev[i] = cur[i];
        }
    }
}

__device__ __forceinline__ void sgu_spatial_phase(LAS unsigned char* lds, const bf16_t* Z, const float* vstat, const float* wsf, const float* bsf, const float* lng, const float* lnb, bf16_t* T1, int G) {
    constexpr int APITCH = 272;
    LAS unsigned char* Aimg = lds;
    LAS unsigned char* VT = lds + 34816;
    LAS float* mu = (LAS float*)(lds + 34816 + 67584); LAS float* rsd = mu + 128;
    int tid_ = tid_now(); asm volatile("" : "+v"(tid_));
    const int tid = tid_, lane = tid & 63, wave = __builtin_amdgcn_readfirstlane(tid >> 6);
    const int g = blockIdx.x & 3;
    bool first = true;
    for (int u = blockIdx.x; u < (M / 128) * 4; u += G) {
        const int nb = u >> 2; const size_t rowb = (size_t)nb * 128;
        __syncthreads();
        if (tid < 128) {
            const f32x4* p = (const f32x4*)(vstat + (rowb + tid) * 32); float s1 = 0.f, s2 = 0.f;
#pragma unroll
            for (int i = 0; i < 4; ++i) { const f32x4 a = p[i], b = p[4 + i]; s1 += (a[0] + a[1]) + (a[2] + a[3]); s2 += (b[0] + b[1]) + (b[2] + b[3]); }
            const float m = s1 * (1.0f / D), var = s2 * (1.0f / D) - m * m;
            mu[tid] = m; rsd[tid] = 1.0f / sqrtf(fmaxf(var, 0.f) + EPS);
        }
        if (first) {
            first = false;
            const float* wg = wsf + (size_t)g * 128 * 128;
#pragma unroll
            for (int i = 0; i < 8; ++i) { const int e = (tid + 512 * i) * 4, p = e >> 7, q = e & 127; f32x4 v = *(const f32x4*)(wg + e);
                if ((p >> 6) < (q >> 6)) v = (f32x4){0.f, 0.f, 0.f, 0.f};
                u32x2 w; w.x = cvt_pk_bf16(v[0], v[1]); w.y = cvt_pk_bf16(v[2], v[3]); *(LAS u32x2*)(Aimg + p * APITCH + q * 2) = w; }
        }
        __syncthreads();
        {
            const int cp = tid & 31, c0 = 8 * cp; float gg[8], bb[8];
#pragma unroll
            for (int e = 0; e < 8; ++e) { gg[e] = lng[g * 256 + c0 + e]; bb[e] = lnb[g * 256 + c0 + e]; }
#pragma unroll 2
            for (int i = 0; i < 8; ++i) {
                const int q = (tid >> 5) + 16 * i;
                const u32x4 raw = *(const u32x4*)(Z + (rowb + q) * 2048 + 1024 + g * 256 + c0);
                const float m = mu[q], r = rsd[q];
                const unsigned wv[4] = {raw.x, raw.y, raw.z, raw.w};
#pragma unroll
                for (int e = 0; e < 8; ++e) {
                    const float v = __uint_as_float((e & 1) ? (wv[e >> 1] & 0xffff0000u) : (wv[e >> 1] << 16));
                    const float y = (v - m) * r * gg[e] + bb[e];
                    const unsigned pk = cvt_pk_bf16(y, y);
                    const int c = c0 + e, chunk = (q >> 3) ^ ((c >> 3) & 15) ^ (c & 7);
                    *(LAS unsigned short*)(VT + c * 256 + chunk * 16 + (q & 7) * 2) = (unsigned short)pk;
                }
            }
        }
        __syncthreads();
        f32x4 acc[2][8];
#pragma unroll
        for (int ct = 0; ct < 2; ++ct)
#pragma unroll
            for (int pt = 0; pt < 8; ++pt) acc[ct][pt] = (f32x4){0.f, 0.f, 0.f, 0.f};
        const int l16 = lane & 15, l4 = lane >> 4;
#pragma unroll
        for (int ks = 0; ks < 4; ++ks) {
            bf16x8 af[2], bfr[8];
#pragma unroll
            for (int ct = 0; ct < 2; ++ct) { const int c = wave * 32 + ct * 16 + l16, chunk = (4 * ks + l4) ^ ((c >> 3) & 15) ^ (c & 7); af[ct] = *(const LAS bf16x8*)(VT + c * 256 + chunk * 16); }
#pragma unroll
            for (int pt = 0; pt < 8; ++pt) bfr[pt] = *(const LAS bf16x8*)(Aimg + (pt * 16 + l16) * APITCH + (32 * ks + 8 * l4) * 2);
#pragma unroll
            for (int ct = 0; ct < 2; ++ct)
#pragma unroll
                for (int pt = 0; pt < 8; ++pt) acc[ct][pt] = __builtin_amdgcn_mfma_f32_16x16x32_bf16(af[ct], bfr[pt], acc[ct][pt], 0, 0, 0);
        }
        u32x4 uu[8];
#pragma unroll
        for (int i = 0; i < 8; ++i) { const int piece = tid + 512 * i; uu[i] = *(const u32x4*)(Z + (rowb + (piece >> 5)) * 2048 + g * 256 + (piece & 31) * 8); }
        __syncthreads();
        LAS unsigned char* SS = VT;
#pragma unroll
        for (int pt = 0; pt < 8; ++pt) {
            const int p = pt * 16 + l16; const float bsv = bsf[g * 128 + p];
#pragma unroll
            for (int ct = 0; ct < 2; ++ct) {
                const f32x4 s = acc[ct][pt] + bsv;
                u32x2 w; w.x = cvt_pk_bf16(s[0], s[1]); w.y = cvt_pk_bf16(s[2], s[3]);
                *(LAS u32x2*)(SS + p * 528 + (wave * 32 + ct * 16 + 4 * l4) * 2) = w;
            }
        }
        __syncthreads();
#pragma unroll
        for (int i = 0; i < 8; ++i) {
            const int piece = tid + 512 * i, p = piece >> 5, part = piece & 31;
            const u32x4 sv = *(const LAS u32x4*)(SS + p * 528 + part * 16);
            const unsigned ua[4] = {uu[i].x, uu[i].y, uu[i].z, uu[i].w}, sa[4] = {sv.x, sv.y, sv.z, sv.w}; unsigned r[4];
#pragma unroll
            for (int e = 0; e < 4; ++e) r[e] = cvt_pk_bf16(__uint_as_float(ua[e] << 16) * __uint_as_float(sa[e] << 16), __uint_as_float(ua[e] & 0xffff0000u) * __uint_as_float(sa[e] & 0xffff0000u));
            u32x4 w; w.x = r[0]; w.y = r[1]; w.z = r[2]; w.w = r[3];
            __builtin_nontemporal_store(w, (u32x4*)(T1 + (rowb + p) * D + g * 256 + part * 8));
        }
    }
}

__device__ __forceinline__ void final_norm_phase(const bf16_t* xb, float* out, const float* gain, int G) {
    int tid_ = tid_now(); asm volatile("" : "+v"(tid_));
    const int tid = tid_, lane = tid & 63, wave = tid >> 6, gw = blockIdx.x * 8 + wave, NGW = G * 8;
    f32x4 gv[4];
#pragma unroll
    for (int j = 0; j < 2; ++j) { gv[2 * j] = *(const f32x4*)(gain + 512 * j + 8 * lane); gv[2 * j + 1] = *(const f32x4*)(gain + 512 * j + 8 * lane + 4); }
    for (int r = gw; r < M; r += NGW) {
        f32x4 v[4]; float s = 0.f;
#pragma unroll
        for (int j = 0; j < 2; ++j) { const u32x4 q = *(const u32x4*)(xb + (size_t)r * D + 512 * j + 8 * lane);
            v[2 * j] = (f32x4){__uint_as_float(q.x << 16), __uint_as_float(q.x & 0xffff0000u), __uint_as_float(q.y << 16), __uint_as_float(q.y & 0xffff0000u)};
            v[2 * j + 1] = (f32x4){__uint_as_float(q.z << 16), __uint_as_float(q.z & 0xffff0000u), __uint_as_float(q.w << 16), __uint_as_float(q.w & 0xffff0000u)}; }
#pragma unroll
        for (int j = 0; j < 4; ++j) s += (v[j][0] * v[j][0] + v[j][1] * v[j][1]) + (v[j][2] * v[j][2] + v[j][3] * v[j][3]);
        s = wave_sum(s, lane);
        const float rs = 1.0f / sqrtf(s * (1.0f / D) + EPS);
#pragma unroll
        for (int j = 0; j < 2; ++j) { *(f32x4*)(out + (size_t)r * D + 512 * j + 8 * lane) = v[2 * j] * rs * gv[2 * j]; *(f32x4*)(out + (size_t)r * D + 512 * j + 8 * lane + 4) = v[2 * j + 1] * rs * gv[2 * j + 1]; }
    }
}

#define XB_TMO      128
#define XB_XCNT(j)  (256  + 64 * (j))
#define XB_XSUB(j)  (1280 + 64 * (j))
#define XB_XGEN(j)  (2304 + 64 * (j))
#define XB_TOP      3328
#define XB_TOPGEN   3392
#define XCD_BAR_WORDS 3456
#define XB_SPIN_CAP (1u << 20)
__device__ __forceinline__ unsigned xb_ld(unsigned* p)              { return __hip_atomic_load(p, __ATOMIC_RELAXED, __HIP_MEMORY_SCOPE_AGENT); }
__device__ __forceinline__ unsigned xb_add(unsigned* p, unsigned v) { return __hip_atomic_fetch_add(p, v, __ATOMIC_RELAXED, __HIP_MEMORY_SCOPE_AGENT); }
__device__ __forceinline__ unsigned xb_xcc_id() { return (unsigned)__builtin_amdgcn_s_getreg((3 << 11) | 20) & 0xFu; }
#define XB_SPIN(cond, bar) do { unsigned _sp = 0; while (cond) { __builtin_amdgcn_s_sleep(1); \
    if ((++_sp & 255u) == 0u) { if (xb_ld(&(bar)[XB_TMO])) break; if (_sp > XB_SPIN_CAP) { atomicAdd(&(bar)[XB_TMO], 1u); break; } } } } while (0)
struct XcdBarrier { unsigned* bar; unsigned x; volatile LAS unsigned* st; };
__device__ __forceinline__ XcdBarrier xcd_barrier_post(unsigned* bar, volatile LAS unsigned* st) {
    XcdBarrier b; b.bar = bar; b.x = xb_xcc_id(); b.st = st;
    if (tid_now() == 0) (void)xb_add(&bar[XB_XCNT(b.x)], 1u);
    return b;
}
__device__ __forceinline__ void xcd_barrier_complete(unsigned* bar, unsigned x, unsigned& nloc, unsigned& nx) {
    const unsigned G = gridDim.x * gridDim.y * gridDim.z;
    unsigned sum, cnt, mine, sp = 0u;
    for (;;) {
        sum = 0u; cnt = 0u; mine = 0u;
#pragma unroll
        for (unsigned j = 0; j < 16; ++j) { const unsigned c = xb_ld(&bar[XB_XCNT(j)]); sum += c; cnt += (c > 0u) ? 1u : 0u; mine = (j == x) ? c : mine; }
        if (sum == G) break;
        __builtin_amdgcn_s_sleep(1);
        if ((++sp & 255u) == 0u) { if (xb_ld(&bar[XB_TMO])) break; if (sp > XB_SPIN_CAP) { atomicAdd(&bar[XB_TMO], 1u); break; } }
    }
    nloc = mine > 0u ? mine : 1u; nx = cnt > 0u ? cnt : 1u;
}
__device__ __forceinline__ void xcd_barrier(const XcdBarrier& b) {
    asm volatile("s_waitcnt vmcnt(0)" ::: "memory");
    __syncthreads();
    if (tid_now() == 0) {
        unsigned* bar = b.bar;
        __builtin_amdgcn_s_waitcnt(0);
        unsigned nloc = b.st[0], nx = b.st[1];
        if (nloc == 0u) { xcd_barrier_complete(bar, b.x, nloc, nx); b.st[0] = nloc; b.st[1] = nx; }
        const unsigned old = xb_add(&bar[XB_XSUB(b.x)], 1u);
        const unsigned gen = old / nloc;
        if (old + 1u == (gen + 1u) * nloc) {
            __builtin_amdgcn_fence(__ATOMIC_RELEASE, "agent");
            asm volatile("s_waitcnt vmcnt(0)" ::: "memory");
            const unsigned og = xb_add(&bar[XB_TOP], 1u);
            const unsigned tg = og / nx;
            if (og + 1u == (tg + 1u) * nx) xb_add(&bar[XB_TOPGEN], 1u);
            else XB_SPIN(xb_ld(&bar[XB_TOPGEN]) == tg, bar);
            __builtin_amdgcn_fence(__ATOMIC_ACQUIRE, "agent");
            xb_add(&bar[XB_XGEN(b.x)], 1u);
            asm volatile("s_waitcnt vmcnt(0)" ::: "memory");
        } else {
            XB_SPIN(xb_ld(&bar[XB_XGEN(b.x)]) == gen, bar);
            __builtin_amdgcn_fence(__ATOMIC_ACQUIRE, "agent");
            asm volatile("s_waitcnt vmcnt(0)" ::: "memory");
        }
    }
    __syncthreads();
}

constexpr int NPHASES = 35;
__host__ __device__ inline bool phase_empty(int ph) { if (ph < 2 || ph >= 34) return false; const int L = (ph - 2) >> 3, k = (ph - 2) & 7; return (k == 2 && (L & 1) == 0) || k == 4; }

__global__ void __launch_bounds__(512, 2) fwd_megakernel(Params P) {
    extern __shared__ __attribute__((aligned(16))) unsigned char lds_raw[];
    LAS unsigned char* lds = (LAS unsigned char*)lds_raw;
    cg::grid_group grid = cg::this_grid();
    const int G = gridDim.x;
    typedef const Params __attribute__((address_space(4))) CParams;
    volatile LAS unsigned* MISC = (volatile LAS unsigned*)(lds + 131072 + 320);
    { const int t0 = threadIdx.x;
      if ((t0 & 63) == 0) ((volatile LAS int*)(lds + WIDTAB_OFF))[(unsigned)__builtin_amdgcn_s_getreg((5 << 11) | 4) & 63u] = t0 >> 6;
      if (t0 < 32) MISC[t0] = 0u; }
    __syncthreads();
    const int ph_lo = P.ph_lo, ph_hi = P.ph_hi;
    XcdBarrier bar; bar.bar = (unsigned*)(P.ws + WS_CTL); bar.x = 0; bar.st = MISC + 8;
    if (ph_hi - ph_lo > 1) bar = xcd_barrier_post((unsigned*)(P.ws + WS_CTL), MISC + 8);

    for (int ph = ph_lo; ph < ph_hi; ++ph) {
        const CParams* KP = (const CParams*)__builtin_amdgcn_kernarg_segment_ptr(); asm volatile("" : "+s"(KP));
        unsigned char* ws = KP->ws;
        bf16_t* T1 = (bf16_t*)(ws + WS_T1); bf16_t* ZB = (bf16_t*)(ws + WS_Z); bf16_t* HB = (bf16_t*)(ws + WS_H);
        bf16_t* XB = (bf16_t*)(ws + WS_XB); bf16_t* KVALL = (bf16_t*)(ws + WS_KVALL); bf16_t* MEMB = (bf16_t*)(ws + WS_MEMB); bf16_t* MQ = (bf16_t*)(ws + WS_MQ); bf16_t* VWO = (bf16_t*)(ws + WS_VWO);
        float* SSQ[2] = {(float*)(ws + WS_SSQ0), (float*)(ws + WS_SSQ1)};
        float* VSTAT = (float*)(ws + WS_VSTAT); float* RSTDMEM = (float*)(ws + WS_RSTDMEM);
        if (phase_empty(ph)) continue;
        if (ph == 0) {
            { Params Pl; for (int i = 0; i < 20; ++i) Pl.in[i] = KP->in[i]; Pl.out = KP->out; Pl.ws = ws; Pl.ph_lo = 0; Pl.ph_hi = 0; prologue_phase(Pl, lds, G); }
        } else if (ph == 1) {
            pg8::StaticOrder S; S.init(MR, 8192, G, (int)blockIdx.x);
            pg8::Gemm g{MEMB, (const bf16_t*)(ws + WS_WK), MR, 8192, D, D, D}; pg8::EpiAct<4> E{KVALL, 8192, nullptr, 1.f, RSTDMEM, nullptr}; pg8::gemm_phase<0>(lds, g, S, E);
        } else if (ph == 34) {
            final_norm_phase(XB, KP->out, KP->in[I_G_FINAL], G);
        } else {
            const int L = (ph - 2) >> 3, k = (ph - 2) & 7, j = L >> 1; const bool odd = (L & 1) != 0;
            if (k == 0) {
                const float* ssq_r = SSQ[(3 * L) & 1];
                if (!odd) { if (L == 0) pool_a_phase<true>(lds, KP->in[I_X], ssq_r, T1, G); else pool_a_phase<false>(lds, XB, ssq_r, T1, G); }
                else { pg8::Gemm g{XB, (const bf16_t*)(ws + WS_WIN) + (size_t)j * D * 2 * D, M, 2 * D, D, D, D}; pg8::StaticOrder S; S.init(M, 2 * D, G, (int)blockIdx.x);
                    LAS float* tab = (LAS float*)(lds + pg8::RSTD_TAB_OFF); pg8::fill_rstd_table(tab, ssq_r, S);
                    pg8::EpiAct<2> E{ZB, 2 * D, ssq_r, 1.f, nullptr, VSTAT, tab}; pg8::gemm_phase<0>(lds, g, S, E); }
                __syncthreads();
                { pg8::Gemm g{KVALL + L * 1024, (const bf16_t*)(ws + WS_WQ) + (size_t)L * D * D, 4 * MR, D, 256, 8192, D}; pg8::StaticOrder S; S.init(4 * MR, D, G, (int)blockIdx.x);
                  pg8::EpiAct<5> E{MQ, D, nullptr, QSCALE, nullptr, nullptr}; pg8::gemm_phase<3>(lds, g, S, E); }
                { pg8::Gemm g{(const bf16_t*)(ws + WS_WO) + (size_t)L * D * D, KVALL + 4096 + L * 1024, D, 4 * MR, 256, D, 8192}; pg8::StaticOrder S; S.init(D, 4 * MR, G, (int)blockIdx.x);
                  pg8::EpiAct<6> E{VWO, D, nullptr, 1.f, nullptr, nullptr}; pg8::gemm_phase<4>(lds, g, S, E); }
            } else if (k == 1 && odd) {
                sgu_spatial_phase(lds, ZB, VSTAT, KP->in[I_SGU_WS] + (size_t)j * 4 * 128 * 128, KP->in[I_SGU_BS] + j * 512, KP->in[I_SGU_LNG] + j * D, KP->in[I_SGU_LNB] + j * D, T1, G);
            } else if (k == 3) {
                pg8::Gemm g{XB, MQ, M, D, D, D, D}; pg8::StaticOrder S; S.init(M, D, G, (int)blockIdx.x);
                LAS float* tab = (LAS float*)(lds + pg8::RSTD_TAB_OFF); pg8::fill_rstd_table(tab, SSQ[(3 * L + 1) & 1], S);
                pg8::EpiSoftmax E{T1, SSQ[(3 * L + 1) & 1], (LAS float*)(lds + 131072 + 1024), tab}; pg8::gemm_phase<2>(lds, g, S, E);
            } else if (k == 6) {
                pg8::Gemm g{XB, (const bf16_t*)(ws + WS_W1) + (size_t)L * D * FF, M, FF, D, D, D}; pg8::StaticOrder S; S.init(M, FF, G, (int)blockIdx.x);
                LAS float* tab = (LAS float*)(lds + pg8::RSTD_TAB_OFF); pg8::fill_rstd_table(tab, SSQ[(3 * L + 2) & 1], S);
                pg8::EpiAct<1> E{HB, FF, SSQ[(3 * L + 2) & 1], 1.f, nullptr, nullptr, tab}; pg8::gemm_phase<0>(lds, g, S, E);
            } else {
                pg8::StaticOrder S; S.init(M, D, G, (int)blockIdx.x);
                if (k == 1) {
                    pg8::Gemm g{T1, (const bf16_t*)(ws + WS_PW) + (size_t)j * 4 * 256 * 256, M, D, 256, D, 256};
                    if (L == 0) { pg8::EpiResid<true> E{KP->in[I_X], XB, SSQ[(3 * L + 1) & 1]}; pg8::gemm_phase<1>(lds, g, S, E); }
                    else { pg8::EpiResid<false> E{nullptr, XB, SSQ[(3 * L + 1) & 1]}; pg8::gemm_phase<1>(lds, g, S, E); }
                } else if (k == 5) {
                    pg8::Gemm g{T1, VWO, M, D, D, D, D}; pg8::EpiResid<false> E{nullptr, XB, SSQ[(3 * L + 2) & 1]}; pg8::gemm_phase<2>(lds, g, S, E);
                } else {
                    pg8::Gemm g; int upd;
                    if (k == 2) { g = pg8::Gemm{T1, (const bf16_t*)(ws + WS_WOUT) + (size_t)j * D * D, M, D, D, D, D}; upd = 3 * L; }
                    else        { g = pg8::Gemm{HB, (const bf16_t*)(ws + WS_W2) + (size_t)L * D * FF, M, D, FF, 64, FF}; upd = 3 * L + 2; }
                    pg8::EpiResid<false> E{nullptr, XB, SSQ[(upd + 1) & 1]};
                    if (k == 2) pg8::gemm_phase<0>(lds, g, S, E); else pg8::gemm_phase<5>(lds, g, S, E);
                }
            }
        }
        if (ph + 1 < ph_hi) { if (ph == 0) grid.sync(); else xcd_barrier(bar); }
    }
}

extern "C" void kernel_launch(void* const* d_in, const int* in_sizes, int n_in, void* d_out, int out_size, void* d_ws, size_t ws_size, hipStream_t stream) {
    static int grid = 0;
    if (grid == 0) {
        if (n_in != 20 || in_sizes[0] != M * D || out_size != M * D || ws_size < WS_END) { fprintf(stderr, "kernel_launch: unexpected shapes (n_in %d, in0 %d, out %d, ws %zu); nothing launched\n", n_in, n_in > 0 ? in_sizes[0] : -1, out_size, ws_size); grid = -1; return; }
        int dev = 0, cus = 0, per_cu = 0;
        if (hipGetDevice(&dev) != hipSuccess || hipDeviceGetAttribute(&cus, hipDeviceAttributeMultiprocessorCount, dev) != hipSuccess) { grid = -1; return; }
        if (hipFuncSetAttribute((const void*)fwd_megakernel, hipFuncAttributeMaxDynamicSharedMemorySize, LDS_BYTES) != hipSuccess) { fprintf(stderr, "kernel_launch: hipFuncSetAttribute failed\n"); grid = -1; return; }
        if (hipOccupancyMaxActiveBlocksPerMultiprocessor(&per_cu, (const void*)fwd_megakernel, 512, LDS_BYTES) != hipSuccess || per_cu < 1) { fprintf(stderr, "kernel_launch: occupancy query gave %d\n", per_cu); per_cu = 1; }
        (void)hipGetLastError();
        grid = cus * per_cu;
        if (grid > 256) grid = 256;
        grid &= ~7;
        if (grid < 8) { grid = -1; return; }
    }
    if (grid < 0) return;
    Params p{};
    for (int i = 0; i < 20; ++i) p.in[i] = (const float*)d_in[i];
    p.out = (float*)d_out; p.ws = (unsigned char*)d_ws;
#if MK_SINGLE
    p.ph_lo = 0; p.ph_hi = NPHASES;
    if (hipMemsetAsync((char*)d_ws + WS_CTL, 0, CTL_BYTES, stream) != hipSuccess) { fprintf(stderr, "kernel_launch: memset failed\n"); return; }
    void* args[] = {&p};
    hipError_t e = hipLaunchCooperativeKernel((const void*)fwd_megakernel, dim3(grid), dim3(512), args, LDS_BYTES, stream);
    if (e != hipSuccess) fprintf(stderr, "kernel_launch: cooperative launch failed: %s (grid %d)\n", hipGetErrorString(e), grid);
#else
    for (int ph = 0; ph < NPHASES; ++ph) {
        if (phase_empty(ph)) continue;
        p.ph_lo = ph; p.ph_hi = ph + 1;
        hipLaunchKernelGGL(fwd_megakernel, dim3(grid), dim3(512), LDS_BYTES, stream, p);
    }
#endif
}
```
